# Optimizing an MI355X kernel written in HIP

```python
import math
import jax, jax.numpy as jnp
from jax import lax
import numpy as np

D_MODEL = 2048
BATCH = 2
SEQ = 4096
DEPTH = 4
DEC_BATCH = 1
DEC_SEQ = 16384
PAST_LEN = 128

N_ATTN_LAYERS = (DEPTH + 1) // 2
N_RWKV_LAYERS = DEPTH // 2

MLA_HEADS = 8
MLA_Q_RANK = 512
MLA_KV_RANK = 512
MLA_NOPE_DIM = 128
MLA_ROPE_DIM = 64
MLA_V_DIM = 128
ROPE_BASE = 10000.0
Q_BLOCK = 128

DIL_HEADS = 8
DIL_HEAD_DIM = 128
DIL_PATTERNS = ((128, 1), (512, 4), (2048, 16))
DIL_BLOCK = 64

N_BUCKETS = 32
T5_MAX_DISTANCE = 1024

IN_WIDTHS = (MLA_Q_RANK, MLA_KV_RANK, MLA_ROPE_DIM,
             DIL_HEADS * DIL_HEAD_DIM, DIL_HEADS * DIL_HEAD_DIM, DIL_HEADS * DIL_HEAD_DIM)
IN_DIM = sum(IN_WIDTHS)
MIX_WIDTH = MLA_HEADS * MLA_V_DIM + DIL_HEADS * DIL_HEAD_DIM

RWKV_HEAD = 64
RWKV_HEADS = D_MODEL // RWKV_HEAD
RWKV_DECAY_LORA = 96
RWKV_A_LORA = 96
RWKV_GATE_LORA = 256
RWKV_LN_EPS = 64e-5

FFN_HIDDEN = ((8 * D_MODEL + 3 * 256 - 1) // (3 * 256)) * 256

NORM_EPS = 1e-6
NEG_INF = -1e30

kernel_name = "hybrid_mla_dilated_rwkv7_encoder"


def rms_norm(x, g):
    xf = x.astype(jnp.float32)
    y = xf * lax.rsqrt(jnp.mean(xf * xf, axis=-1, keepdims=True) + NORM_EPS)
    return (y * g.astype(jnp.float32)).astype(x.dtype)


def t5_bucket(rel):
    half = N_BUCKETS // 2
    max_exact = half // 2
    bucket = jnp.where(rel > 0, half, 0)
    n = jnp.abs(rel)
    nf = jnp.maximum(n, 1).astype(jnp.float32)
    large = max_exact + (jnp.log(nf / max_exact) / math.log(T5_MAX_DISTANCE / max_exact)
                         * (half - max_exact)).astype(jnp.int32)
    large = jnp.minimum(large, half - 1)
    return bucket + jnp.where(n < max_exact, n, large)


def rope_tables(S):
    inv = ROPE_BASE ** (-jnp.arange(0, MLA_ROPE_DIM, 2, dtype=jnp.float32) / MLA_ROPE_DIM)
    ang = jnp.arange(S, dtype=jnp.float32)[:, None] * inv[None, :]
    return jnp.cos(ang), jnp.sin(ang)


def apply_rope(x, cos, sin):
    half = x.shape[-1] // 2
    x1 = x[..., :half].astype(jnp.float32)
    x2 = x[..., half:].astype(jnp.float32)
    return jnp.concatenate([x1 * cos - x2 * sin, x2 * cos + x1 * sin], axis=-1).astype(x.dtype)


def mla_attention(c_q, c_kv, k_rope, q_norm, kv_norm, w_uq, w_ukv):
    B, S, _ = c_q.shape
    H = MLA_HEADS
    q = (rms_norm(c_q, q_norm) @ w_uq).reshape(B, S, H, MLA_NOPE_DIM + MLA_ROPE_DIM)
    kv = (rms_norm(c_kv, kv_norm) @ w_ukv).reshape(B, S, H, MLA_NOPE_DIM + MLA_V_DIM)
    cos, sin = rope_tables(S)
    q_nope = q[..., :MLA_NOPE_DIM]
    q_rope = apply_rope(q[..., MLA_NOPE_DIM:], cos[:, None, :], sin[:, None, :])
    k_nope = kv[..., :MLA_NOPE_DIM]
    v = kv[..., MLA_NOPE_DIM:]
    k_rope = apply_rope(k_rope, cos, sin)
    scale = (MLA_NOPE_DIM + MLA_ROPE_DIM) ** -0.5
    nq = S // Q_BLOCK

    def to_blocks(t):
        return jnp.swapaxes(t.reshape(B, nq, Q_BLOCK, H, t.shape[-1]), 0, 1)

    def attend(blk):
        qn, qr = blk
        s = (jnp.einsum('bqhd,bkhd->bhqk', qn, k_nope)
             + jnp.einsum('bqhd,bkd->bhqk', qr, k_rope)).astype(jnp.float32) * scale
        p = jax.nn.softmax(s, axis=-1)
        return jnp.einsum('bhqk,bkhd->bqhd', p.astype(v.dtype), v)

    o = lax.map(attend, (to_blocks(q_nope), to_blocks(q_rope)))
    return jnp.swapaxes(o, 0, 1).reshape(B, S, H * MLA_V_DIM)


def dilated_attention(q, k, v, rel_bias):
    Bsz, S, H, dh = q.shape
    BLK = DIL_BLOCK
    scale = dh ** -0.5
    outs, lses = [], []
    for window, dil in DIL_PATTERNS:
        half = window // (2 * dil)
        L = S // dil
        nb = -(-L // BLK)
        Lp = nb * BLK
        G = Bsz * dil

        def to_sub(t):
            return t.reshape(Bsz, L, dil, H, dh).transpose(0, 2, 1, 3, 4).reshape(G, L, H, dh)

        def key_windows(t):
            tp = jnp.pad(to_sub(t), ((0, 0), (BLK, Lp - L + BLK), (0, 0), (0, 0)))
            tp = tp.reshape(G, nb + 2, BLK, H, dh)
            return jnp.concatenate([tp[:, :-2], tp[:, 1:-1], tp[:, 2:]], axis=2)

        qs = jnp.pad(to_sub(q), ((0, 0), (0, Lp - L), (0, 0), (0, 0))).reshape(G, nb, BLK, H, dh)
        kw = key_windows(k)
        vw = key_windows(v)
        kpos = jnp.arange(Lp + 2 * BLK) - BLK
        kvalid = ((kpos >= 0) & (kpos < L)).reshape(nb + 2, BLK)
        kvalid = jnp.concatenate([kvalid[:-2], kvalid[1:-1], kvalid[2:]], axis=1)
        rel = jnp.arange(3 * BLK)[None, :] - BLK - jnp.arange(BLK)[:, None]
        mask = (jnp.abs(rel) <= half)[None] & kvalid[:, None, :]
        bias = rel_bias[t5_bucket(rel * dil)].transpose(2, 0, 1).astype(jnp.float32)
        s = jnp.einsum('gnqhd,gnkhd->gnhqk', qs, kw).astype(jnp.float32) * scale + bias[None, None]
        s = jnp.where(mask[None, :, None], s, NEG_INF)
        m = jnp.max(s, axis=-1, keepdims=True)
        e = jnp.exp(s - m)
        den = jnp.sum(e, axis=-1)
        o = jnp.einsum('gnhqk,gnkhd->gnqhd', e.astype(v.dtype), vw).astype(jnp.float32)
        o = o / jnp.swapaxes(den, 2, 3)[..., None]
        lse = jnp.swapaxes(m[..., 0] + jnp.log(den), 2, 3)
        o = o.reshape(G, Lp, H, dh)[:, :L].reshape(Bsz, dil, L, H, dh)
        outs.append(o.transpose(0, 2, 1, 3, 4).reshape(Bsz, S, H, dh))
        lse = lse.reshape(G, Lp, H)[:, :L].reshape(Bsz, dil, L, H)
        lses.append(lse.transpose(0, 2, 1, 3).reshape(Bsz, S, H))
    wts = jax.nn.softmax(jnp.stack(lses), axis=0)
    o = jnp.sum(wts[..., None] * jnp.stack(outs), axis=0)
    return o.reshape(Bsz, S, H * dh).astype(q.dtype)


def hybrid_attention(h, w_in, q_norm, kv_norm, w_uq, w_ukv, w_out, rel_bias):
    B, S, _ = h.shape
    z = h @ w_in
    cuts = []
    acc = 0
    for wdt in IN_WIDTHS[:-1]:
        acc += wdt
        cuts.append(acc)
    c_q, c_kv, k_r, q_b, k_b, v_b = jnp.split(z, cuts, axis=-1)
    a_out = mla_attention(c_q, c_kv, k_r, q_norm, kv_norm, w_uq, w_ukv)
    heads = lambda t: t.reshape(B, S, DIL_HEADS, DIL_HEAD_DIM)
    b_out = dilated_attention(heads(q_b), heads(k_b), heads(v_b), rel_bias)
    return jnp.concatenate([a_out, b_out], axis=-1) @ w_out


def wkv7_scan(r, w, k, v, a, b, reverse):
    Bsz, S, H, N = r.shape

    def step(state, inp):
        r_t, w_t, k_t, v_t, a_t, b_t = inp
        sa = jnp.einsum('bhvk,bhk->bhv', state, a_t)
        state = (state * w_t[:, :, None, :] + sa[..., None] * b_t[:, :, None, :]
                 + v_t[..., None] * k_t[:, :, None, :])
        return state, jnp.einsum('bhvk,bhk->bhv', state, r_t)

    seq_major = tuple(jnp.swapaxes(t, 0, 1) for t in (r, w, k, v, a, b))
    state0 = jnp.zeros((Bsz, H, N, N), jnp.float32)
    _, ys = lax.scan(step, state0, seq_major, reverse=reverse)
    return jnp.swapaxes(ys, 0, 1)


def rwkv7_time_mix(x, mu, w_r, w_k, w_v, w_o, w0, w1, w2, a0, a1, a2, g1, g2,
                   k_k, k_a, r_k, ln_w, ln_b):
    B, S, D = x.shape
    H, N = RWKV_HEADS, RWKV_HEAD
    zero = jnp.zeros_like(x[:, :1])
    x_prev = jnp.concatenate([zero, x[:, :-1]], axis=1)
    x_next = jnp.concatenate([x[:, 1:], zero], axis=1)
    xx = 0.5 * (x_prev + x_next) - x
    xr, xw, xk, xv, xa, xg = (x + xx * mu[i] for i in range(6))
    r = xr @ w_r
    k = xk @ w_k
    v = xv @ w_v
    g = jax.nn.sigmoid(xg @ g1) @ g2
    heads = lambda t: t.reshape(B, S, H, N).astype(jnp.float32)
    kk = heads(k * k_k)
    kk = kk * lax.rsqrt(jnp.sum(kk * kk, axis=-1, keepdims=True) + 1e-12)
    rh = heads(r)
    vh = heads(v)
    ys = []
    for d in range(2):
        w_log = -jax.nn.softplus(-(w0[d] + jnp.tanh(xw @ w1[d]) @ w2[d])) - 0.5
        decay = jnp.exp(-jnp.exp(heads(w_log)))
        a = jax.nn.sigmoid(a0[d] + (xa @ a1[d]) @ a2[d])
        kd = heads(k * (1 + (a - 1) * k_a))
        ys.append(wkv7_scan(rh, decay, kd, vh, -kk, kk * heads(a), reverse=(d == 1)))
    y = ys[0] + ys[1]
    mean = jnp.mean(y, axis=-1, keepdims=True)
    var = jnp.mean(jnp.square(y - mean), axis=-1, keepdims=True)
    y = ((y - mean) * lax.rsqrt(var + RWKV_LN_EPS)).reshape(B, S, D)
    y = y * ln_w.astype(jnp.float32) + ln_b.astype(jnp.float32)
    bonus = jnp.sum(rh * heads(k) * r_k.astype(jnp.float32), axis=-1, keepdims=True) * vh
    y = y + bonus.reshape(B, S, D)
    return (y * g.astype(jnp.float32)).astype(x.dtype) @ w_o


def swiglu(h, w_gate, w_up, w_down):
    return (jax.nn.silu(h @ w_gate) * (h @ w_up)) @ w_down


def trunk(x, p):
    for layer in range(DEPTH):
        i = layer // 2
        g = p["norm_g"][layer]
        h = rms_norm(x, g[0])
        if layer % 2 == 0:
            mix = hybrid_attention(h, p["at_w_in"][i], p["at_q_norm"][i], p["at_kv_norm"][i],
                                   p["at_w_uq"][i], p["at_w_ukv"][i], p["at_w_out"][i],
                                   p["rel_bias"])
        else:
            mix = rwkv7_time_mix(h, p["rw_mu"][i], p["rw_w_r"][i], p["rw_w_k"][i], p["rw_w_v"][i],
                                 p["rw_w_o"][i], p["rw_w0"][i], p["rw_w1"][i], p["rw_w2"][i],
                                 p["rw_a0"][i], p["rw_a1"][i], p["rw_a2"][i], p["rw_g1"][i],
                                 p["rw_g2"][i], p["rw_k_k"][i], p["rw_k_a"][i], p["rw_r_k"][i],
                                 p["rw_ln_w"][i], p["rw_ln_b"][i])
        x = x + rms_norm(mix, g[1])
        h = rms_norm(x, g[2])
        x = x + rms_norm(swiglu(h, p["ffn_w_gate"][layer], p["ffn_w_up"][layer],
                                p["ffn_w_down"][layer]), g[3])
    return x


def setup_inputs(seed: int = 0) -> dict:
    key = jax.random.key(seed)
    ks = iter(jax.random.split(key, 48))
    nrm = lambda shape, scale: scale * jax.random.normal(next(ks), shape, jnp.float32)
    D, F = D_MODEL, FFN_HIDDEN
    NA, NR = N_ATTN_LAYERS, N_RWKV_LAYERS
    H, N = RWKV_HEADS, RWKV_HEAD
    return {
        "x_prompt": nrm((BATCH, SEQ, D), 1.0),
        "x_sample": nrm((DEC_BATCH, DEC_SEQ, D), 1.0),
        "norm_g": 1.0 + nrm((DEPTH, 4, D), 0.05),
        "rel_bias": nrm((N_BUCKETS, DIL_HEADS), 0.5),
        "at_w_in": nrm((NA, D, IN_DIM), D ** -0.5),
        "at_q_norm": 1.0 + nrm((NA, MLA_Q_RANK), 0.05),
        "at_kv_norm": 1.0 + nrm((NA, MLA_KV_RANK), 0.05),
        "at_w_uq": nrm((NA, MLA_Q_RANK, MLA_HEADS * (MLA_NOPE_DIM + MLA_ROPE_DIM)), MLA_Q_RANK ** -0.5),
        "at_w_ukv": nrm((NA, MLA_KV_RANK, MLA_HEADS * (MLA_NOPE_DIM + MLA_V_DIM)), MLA_KV_RANK ** -0.5),
        "at_w_out": nrm((NA, MIX_WIDTH, D), MIX_WIDTH ** -0.5),
        "rw_mu": jax.random.uniform(next(ks), (NR, 6, D), jnp.float32),
        "rw_w_r": nrm((NR, D, D), D ** -0.5),
        "rw_w_k": nrm((NR, D, D), D ** -0.5),
        "rw_w_v": nrm((NR, D, D), D ** -0.5),
        "rw_w_o": nrm((NR, D, D), D ** -0.5),
        "rw_w0": nrm((NR, 2, D), 1.0) - 2.5,
        "rw_w1": nrm((NR, 2, D, RWKV_DECAY_LORA), D ** -0.5),
        "rw_w2": nrm((NR, 2, RWKV_DECAY_LORA, D), 0.1 * RWKV_DECAY_LORA ** -0.5),
        "rw_a0": nrm((NR, 2, D), 0.3),
        "rw_a1": nrm((NR, 2, D, RWKV_A_LORA), D ** -0.5),
        "rw_a2": nrm((NR, 2, RWKV_A_LORA, D), 0.3 * RWKV_A_LORA ** -0.5),
        "rw_g1": nrm((NR, D, RWKV_GATE_LORA), D ** -0.5),
        "rw_g2": nrm((NR, RWKV_GATE_LORA, D), RWKV_GATE_LORA ** -0.5),
        "rw_k_k": 0.85 + nrm((NR, D), 0.05),
        "rw_k_a": 1.0 + nrm((NR, D), 0.05),
        "rw_r_k": nrm((NR, H, N), 0.1),
        "rw_ln_w": 1.0 + nrm((NR, D), 0.05),
        "rw_ln_b": nrm((NR, D), 0.02),
        "ffn_w_gate": nrm((DEPTH, D, F), D ** -0.5),
        "ffn_w_up": nrm((DEPTH, D, F), D ** -0.5),
        "ffn_w_down": nrm((DEPTH, F, D), F ** -0.5),
    }


def reference(x_prompt, x_sample, norm_g, rel_bias, at_w_in, at_q_norm, at_kv_norm, at_w_uq,
              at_w_ukv, at_w_out, rw_mu, rw_w_r, rw_w_k, rw_w_v, rw_w_o, rw_w0, rw_w1, rw_w2,
              rw_a0, rw_a1, rw_a2, rw_g1, rw_g2, rw_k_k, rw_k_a, rw_r_k, rw_ln_w, rw_ln_b,
              ffn_w_gate, ffn_w_up, ffn_w_down):
    params = {
        "norm_g": norm_g, "rel_bias": rel_bias,
        "at_w_in": at_w_in, "at_q_norm": at_q_norm, "at_kv_norm": at_kv_norm,
        "at_w_uq": at_w_uq, "at_w_ukv": at_w_ukv, "at_w_out": at_w_out,
        "rw_mu": rw_mu, "rw_w_r": rw_w_r, "rw_w_k": rw_w_k, "rw_w_v": rw_w_v, "rw_w_o": rw_w_o,
        "rw_w0": rw_w0, "rw_w1": rw_w1, "rw_w2": rw_w2,
        "rw_a0": rw_a0, "rw_a1": rw_a1, "rw_a2": rw_a2,
        "rw_g1": rw_g1, "rw_g2": rw_g2, "rw_k_k": rw_k_k, "rw_k_a": rw_k_a, "rw_r_k": rw_r_k,
        "rw_ln_w": rw_ln_w, "rw_ln_b": rw_ln_b,
        "ffn_w_gate": ffn_w_gate, "ffn_w_up": ffn_w_up, "ffn_w_down": ffn_w_down,
    }
    y_prompt = trunk(x_prompt, params)
    y_sample = trunk(x_sample, params)
    return (y_prompt, y_sample)
```

```cpp
#include <hip/hip_runtime.h>
#include <hip/hip_cooperative_groups.h>
#include <cstdio>
#include <cstdint>
namespace cg = cooperative_groups;
__device__ __forceinline__ int tidx() { int t = threadIdx.x; asm volatile("" : "+v"(t)); return t; }
namespace pg8 {
#define PG8_LAS __attribute__((address_space(3)))
typedef unsigned short bf16_t;
typedef short bf16x8 __attribute__((ext_vector_type(8)));
typedef float f32x4 __attribute__((ext_vector_type(4)));
typedef unsigned u32x4 __attribute__((ext_vector_type(4)));
constexpr int BM = 256, BK = 64, HALF = 128, HTB = HALF * BK * 2  , STAGE_BYTES = 8 * HTB, NXCD = 8, WGM = 8;

__host__ __device__ __forceinline__ int lds_byte(int r, int c) { const int st = (r >> 4) * 2 + (c >> 5), rr = r & 15, cc = c & 31, ob = rr * 64 + cc * 2; return st * 1024 + (ob ^ (((ob >> 9) & 1) << 5)); }
__host__ __device__ __forceinline__ void stage_rc(int b, int& R, int& C) { const int st = b / 1024, sb = b % 1024, swz = sb ^ (((sb >> 9) & 1) << 5); R = (st >> 1) * 16 + swz / 64; C = (st & 1) * 32 + (swz % 64) / 2; }
__host__ __device__ __forceinline__ int perm32(int rho) { const int n = rho >> 4, i = rho & 15; return 8 * (i >> 2) + 4 * n + (i & 3); }

struct Unit { int pm, pn; };
struct Gemm { const bf16_t* A; const bf16_t* Bt; int M, N, K; };

struct StaticOrder {
    int nM, nN, nwg, G, c;
    __host__ __device__ void init(int M, int N, int G_, int c_) { nM = M / BM; nN = N / BM; nwg = nM * nN; G = G_; c = c_; }
    __host__ __device__ bool next(int i, Unit& u) const {
        const long L = (long)i * G + c; if (L >= nwg) return false;
        int wgid = (int)L; { const int q = nwg / NXCD, r = nwg % NXCD, xcd = wgid % NXCD, off = wgid / NXCD; wgid = (xcd < r ? xcd * (q + 1) : r * (q + 1) + (xcd - r) * q) + off; }
        const int nig = WGM * nN, gid = wgid / nig, fm = gid * WGM, gsz = (nM - fm) < WGM ? (nM - fm) : WGM;
        u.pm = fm + ((wgid % nig) % gsz); u.pn = (wgid % nig) / gsz; return true;
    }
    __device__ __forceinline__ void a_ready(const Unit&) const {}
    __device__ __forceinline__ void done(const Unit&) const {}
};
__device__ __forceinline__ unsigned cvt_pk_bf16(float lo, float hi) { unsigned r; asm volatile("v_cvt_pk_bf16_f32 %0, %1, %2" : "=v"(r) : "v"(lo), "v"(hi)); return r; }
typedef float f32x2 __attribute__((ext_vector_type(2)));
template <class Epi, class Sched, bool STAMP = false>
__device__ __forceinline__ void gemm_phase(PG8_LAS unsigned char* lds, const Gemm g, const Sched& S, const Epi& E, unsigned long long* stamps) {
    const int tid = tidx(), wid = __builtin_amdgcn_readfirstlane(tid >> 6), lane = tid & 63, wr = wid >> 2, wc = wid & 3, fr = lane & 15, fq = lane >> 4;
    const int K = g.K, nt = K / BK;
    int ts_lo = 0, ts_hi = 0, nts = 0; const unsigned long long rt_entry = STAMP ? (unsigned long long)wall_clock64() : 0ull;
#define PG8_STAMP() do { if (STAMP && wid == 0 && nts < 64) { const unsigned long long _c = (unsigned long long)clock64(); \
        ts_lo = (lane == nts) ? (int)(unsigned)_c : ts_lo; ts_hi = (lane == nts) ? (int)(unsigned)(_c >> 32) : ts_hi; ++nts; } } while (0)
    PG8_STAMP();
    unsigned voffA[2], voffB[2];
#pragma unroll
    for (int i = 0; i < 2; ++i) { int R, C; stage_rc(tid * 16 + i * 8192, R, C); const int Rb = Epi::PERM ? ((R & ~31) + perm32(R & 31)) : R;
        voffA[i] = (unsigned)(R * K + C) * 2u; voffB[i] = (unsigned)(Rb * K + C) * 2u; }
    const size_t kstep = (size_t)(BK * 2);
    const size_t hstep = (size_t)HALF * K * 2;
    const size_t tstep = 2 * hstep;
    const unsigned ldsw = (unsigned)wid * 1024u;
    const int aoff = lds_byte(wr * 64 + fr, fq * 8), boff = lds_byte(wc * 32 + fr, fq * 8);
#define PG8_SA(b, h) (((b) * 2 + (h)) * HTB)
#define PG8_SB(b, h) ((4 + (b) * 2 + (h)) * HTB)
#define PG8_STAGE(bufoff, gbase, voff) do { _Pragma("unroll") for (int _i = 0; _i < 2; ++_i) \
        __builtin_amdgcn_global_load_lds((const unsigned*)((const char*)(gbase) + (voff)[_i]), (PG8_LAS unsigned*)(lds + (bufoff) + ldsw + _i * 8192), 16, 0, 0); } while (0)
#define PG8_LDA(dst, b, h) do { _Pragma("unroll") for (int m = 0; m < 4; ++m) _Pragma("unroll") for (int k = 0; k < 2; ++k) dst[m][k] = *(const PG8_LAS bf16x8*)(lds + PG8_SA(b, h) + aoff + m * 2048 + k * 1024); } while (0)
#define PG8_LDB(dst, b, h) do { _Pragma("unroll") for (int n = 0; n < 2; ++n) _Pragma("unroll") for (int k = 0; k < 2; ++k) dst[n][k] = *(const PG8_LAS bf16x8*)(lds + PG8_SB(b, h) + boff + n * 2048 + k * 1024); } while (0)
#define PG8_MMA(ai, bj, At, Bt) do { __builtin_amdgcn_s_setprio(1); _Pragma("unroll") for (int m = 0; m < 4; ++m) _Pragma("unroll") for (int n = 0; n < 2; ++n) _Pragma("unroll") for (int k = 0; k < 2; ++k) \
        acc[ai][bj][m][n] = __builtin_amdgcn_mfma_f32_16x16x32_bf16(Bt[n][k], At[m][k], acc[ai][bj][m][n], 0, 0, 0); __builtin_amdgcn_s_setprio(0); } while (0)
#define PG8_WAIT_V(n) asm volatile("s_waitcnt vmcnt(" #n ")" ::: "memory")
#define PG8_WAIT_L(n) asm volatile("s_waitcnt lgkmcnt(" #n ")" ::: "memory")
#define PG8_BAR __builtin_amdgcn_s_barrier()
#define PG8_SCHED __builtin_amdgcn_sched_barrier(0)
    Unit cur, nxt; int ui = 0;
    if (!S.next(0, cur)) return;
    f32x4 acc[2][2][4][2];
#pragma unroll
    for (int a = 0; a < 2; ++a)
#pragma unroll
        for (int b = 0; b < 2; ++b)
#pragma unroll
            for (int m = 0; m < 4; ++m)
#pragma unroll
                for (int n = 0; n < 2; ++n) acc[a][b][m][n] = (f32x4){0.f, 0.f, 0.f, 0.f};
    bf16x8 At[4][2], B0[2][2], B1[2][2];
    const char* cA = (const char*)g.A + (size_t)cur.pm * tstep; const char* cB = (const char*)g.Bt + (size_t)cur.pn * tstep;
    S.a_ready(cur);
    PG8_STAGE(PG8_SB(0, 0), cB, voffB); PG8_STAGE(PG8_SA(0, 0), cA, voffA); PG8_STAGE(PG8_SB(0, 1), cB + hstep, voffB); PG8_STAGE(PG8_SA(0, 1), cA + hstep, voffA);
    if (wr == 1) PG8_BAR;
    PG8_WAIT_V(4); PG8_BAR;
    PG8_STAGE(PG8_SB(1, 0), cB + kstep, voffB); PG8_STAGE(PG8_SA(1, 0), cA + kstep, voffA); PG8_STAGE(PG8_SB(1, 1), cB + hstep + kstep, voffB);
    PG8_WAIT_V(6); PG8_BAR;
    PG8_STAMP();
    for (;;) {
        const bool has_next = S.next(ui + 1, nxt);
        const char* nA = has_next ? (const char*)g.A + (size_t)nxt.pm * tstep : cA; const char* nB = has_next ? (const char*)g.Bt + (size_t)nxt.pn * tstep : cB;
        for (int t = 0; t < nt; t += 2) {
            const bool last = (t == nt - 2);
            const char* a1 = cA + (size_t)(t + 1) * kstep;
            const char* a2 = last ? nA : cA + (size_t)(t + 2) * kstep; const char* b2 = last ? nB : cB + (size_t)(t + 2) * kstep;
            const char* a3 = a2 + kstep; const char* b3 = b2 + kstep;
            if (last && has_next) S.a_ready(nxt);
            PG8_LDB(B0, 0, 0); PG8_SCHED; PG8_LDA(At, 0, 0); PG8_STAGE(PG8_SA(1, 1), a1 + hstep, voffA);
            PG8_WAIT_L(8); PG8_BAR; PG8_WAIT_L(0); PG8_MMA(0, 0, At, B0); PG8_BAR; PG8_SCHED;
            PG8_LDB(B1, 0, 1); PG8_STAGE(PG8_SB(0, 0), b2, voffB);
            PG8_BAR; PG8_WAIT_L(0); PG8_MMA(0, 1, At, B1); PG8_BAR;
            PG8_LDA(At, 0, 1); PG8_STAGE(PG8_SA(0, 0), a2, voffA);
            PG8_BAR; PG8_WAIT_L(0); PG8_MMA(1, 0, At, B0); PG8_BAR; PG8_SCHED;
            PG8_STAGE(PG8_SB(0, 1), b2 + hstep, voffB);
            PG8_WAIT_V(6); PG8_BAR; PG8_MMA(1, 1, At, B1); PG8_BAR;
            PG8_LDB(B0, 1, 0); PG8_SCHED; PG8_LDA(At, 1, 0); PG8_STAGE(PG8_SA(0, 1), a2 + hstep, voffA);
            PG8_WAIT_L(8); PG8_BAR; PG8_WAIT_L(0); PG8_MMA(0, 0, At, B0); PG8_BAR; PG8_SCHED;
            PG8_LDB(B1, 1, 1); PG8_STAGE(PG8_SB(1, 0), b3, voffB);
            PG8_BAR; PG8_WAIT_L(0); PG8_MMA(0, 1, At, B1); PG8_BAR;
            PG8_LDA(At, 1, 1); PG8_STAGE(PG8_SA(1, 0), a3, voffA);
            PG8_BAR; PG8_WAIT_L(0); PG8_MMA(1, 0, At, B0); PG8_BAR; PG8_SCHED;
            PG8_STAGE(PG8_SB(1, 1), b3 + hstep, voffB);
            PG8_WAIT_V(6); PG8_BAR; PG8_MMA(1, 1, At, B1); PG8_BAR;
        }
        PG8_STAMP();
        if constexpr (!Epi::AFTER_DRAIN) { E(acc, cur, wr, wc, fr, fq); S.done(cur); }
        PG8_STAMP();
        if (!has_next) break;
#pragma unroll
        for (int a = 0; a < 2; ++a)
#pragma unroll
            for (int b = 0; b < 2; ++b)
#pragma unroll
                for (int m = 0; m < 4; ++m)
#pragma unroll
                    for (int n = 0; n < 2; ++n) acc[a][b][m][n] = (f32x4){0.f, 0.f, 0.f, 0.f};
        cur = nxt; cA = nA; cB = nB; ++ui;
    }
    PG8_WAIT_V(0);
    if (wr == 0) PG8_BAR;
    PG8_BAR;
    if constexpr (Epi::AFTER_DRAIN) { E.fused(acc, cur, wr, wc, fr, fq, lds, wid, lane); S.done(cur); }
    PG8_STAMP();
    if (STAMP && wid == 0) { stamps[lane] = lane < nts ? (((unsigned long long)(unsigned)ts_hi << 32) | (unsigned)ts_lo) : 0ull;
        if (lane == 62) stamps[62] = rt_entry; if (lane == 63) stamps[63] = (unsigned long long)wall_clock64(); }
#undef PG8_STAMP
#undef PG8_SA
#undef PG8_SB
#undef PG8_STAGE
#undef PG8_LDA
#undef PG8_LDB
#undef PG8_MMA
#undef PG8_WAIT_V
#undef PG8_WAIT_L
#undef PG8_BAR
#undef PG8_SCHED
}
}
namespace pg8 {
__device__ __forceinline__ float fsig(float x) { return __builtin_amdgcn_rcpf(1.f + __expf(-x)); }
__device__ __forceinline__ float ftanh(float x) { return 1.f - 2.f * __builtin_amdgcn_rcpf(1.f + __expf(2.f * x)); }
__device__ __forceinline__ int seq_start(int t) { return t < 4096 ? 0 : (t < 8192 ? 4096 : 8192); }

struct EpiF32 {
    static constexpr bool PERM = false, AFTER_DRAIN = false;
    float* C; int ldc;
    __device__ __forceinline__ void operator()(const f32x4 (&acc)[2][2][4][2], const Unit& u, int wr, int wc, int fr, int fq) const {
        const int row0 = u.pm * BM + wr * 64 + fr, col0 = u.pn * BM + wc * 32 + 4 * fq;
#pragma unroll
        for (int ai = 0; ai < 2; ++ai)
#pragma unroll
            for (int m = 0; m < 4; ++m) { float* rowp = C + (size_t)(row0 + ai * HALF + m * 16) * ldc + col0;
#pragma unroll
                for (int bj = 0; bj < 2; ++bj)
#pragma unroll
                    for (int n = 0; n < 2; ++n) *(f32x4*)(rowp + bj * HALF + n * 16) = acc[ai][bj][m][n]; }
    }
};
template <int ACT> struct EpiB {
    static constexpr bool PERM = true, AFTER_DRAIN = false;
    bf16_t* O; int ldc; const float* bias; const float* rs;
    __device__ __forceinline__ f32x4 actf(f32x4 v) const {
#pragma unroll
        for (int j = 0; j < 4; ++j) {
            if (ACT == 1) v[j] = 0.5f + 0.5f * ftanh(0.5f * v[j]);
            if (ACT == 2) v[j] = ftanh(v[j]);
            if (ACT == 3) v[j] = 0.6065306597f * fsig(v[j]); }
        return v; }
    __device__ __forceinline__ void operator()(const f32x4 (&acc)[2][2][4][2], const Unit& u, int wr, int wc, int fr, int fq) const {
        const int row0 = u.pm * BM + wr * 64 + fr; const int col0 = u.pn * BM + wc * 32 + 8 * fq;
#pragma unroll
        for (int bj = 0; bj < 2; ++bj) {
#pragma unroll
            for (int ai = 0; ai < 2; ++ai)
#pragma unroll
                for (int m = 0; m < 4; ++m) { const int row = row0 + ai * HALF + m * 16; const float s = rs ? rs[row] : 1.f;
                    f32x4 v0 = acc[ai][bj][m][0] * s; if (bias) v0 += *(const f32x4*)(bias + col0 + bj * HALF); v0 = actf(v0);
                    u32x4 w; w.x = cvt_pk_bf16(v0[0], v0[1]); w.y = cvt_pk_bf16(v0[2], v0[3]);
                    f32x4 v1 = acc[ai][bj][m][1] * s; if (bias) v1 += *(const f32x4*)(bias + col0 + bj * HALF + 4); v1 = actf(v1);
                    w.z = cvt_pk_bf16(v1[0], v1[1]); w.w = cvt_pk_bf16(v1[2], v1[3]);
                    *(u32x4*)(O + (size_t)row * ldc + col0 + bj * HALF) = w; __builtin_amdgcn_sched_barrier(0); } }
    }
};
struct EpiIn {
    static constexpr bool PERM = true, AFTER_DRAIN = false;
    bf16_t *cq, *ckv, *qb, *kb, *vb, *kr; const float* rs; const float* cs; const float* sn;
    __device__ __forceinline__ void operator()(const f32x4 (&acc)[2][2][4][2], const Unit& u, int wr, int wc, int fr, int fq) const {
        const int row0 = u.pm * BM + wr * 64 + fr; const int pn = u.pn;
        if (pn < 16) {
            bf16_t* base; int ldc, colt;
            if (pn < 2) { base = cq; ldc = 512; colt = pn * 256; } else if (pn < 4) { base = ckv; ldc = 512; colt = (pn - 2) * 256; }
            else if (pn < 8) { base = qb; ldc = 1024; colt = (pn - 4) * 256; } else if (pn < 12) { base = kb; ldc = 1024; colt = (pn - 8) * 256; }
            else { base = vb; ldc = 1024; colt = (pn - 12) * 256; }
            const int col0 = colt + wc * 32 + 8 * fq;
#pragma unroll
            for (int ai = 0; ai < 2; ++ai)
#pragma unroll
                for (int m = 0; m < 4; ++m) { const int row = row0 + ai * HALF + m * 16; const float s = rs[row];
                    bf16_t* rowp = base + (size_t)row * ldc + col0;
#pragma unroll
                    for (int bj = 0; bj < 2; ++bj) { const f32x4 v0 = acc[ai][bj][m][0] * s, v1 = acc[ai][bj][m][1] * s;
                        u32x4 w; w.x = cvt_pk_bf16(v0[0], v0[1]); w.y = cvt_pk_bf16(v0[2], v0[3]); w.z = cvt_pk_bf16(v1[0], v1[1]); w.w = cvt_pk_bf16(v1[2], v1[3]);
                        *(u32x4*)(rowp + bj * HALF) = w; } }
        } else if (wc < 2) {
            const int q = wc * 4 + fq;
#pragma unroll
            for (int ai = 0; ai < 2; ++ai)
#pragma unroll
                for (int m = 0; m < 4; ++m) { const int row = row0 + ai * HALF + m * 16; const float s = rs[row]; const int pos = row - seq_start(row);
                    const f32x4 c = *(const f32x4*)(cs + (size_t)pos * 32 + 4 * q), sv = *(const f32x4*)(sn + (size_t)pos * 32 + 4 * q);
                    const f32x4 x1 = acc[ai][0][m][0] * s, x2 = acc[ai][0][m][1] * s;
                    const f32x4 y1 = x1 * c - x2 * sv, y2 = x2 * c + x1 * sv;
                    u32x4 w; w.x = cvt_pk_bf16(y1[0], y1[1]); w.y = cvt_pk_bf16(y1[2], y1[3]); w.z = cvt_pk_bf16(y2[0], y2[1]); w.w = cvt_pk_bf16(y2[2], y2[3]);
                    *(u32x4*)(kr + (size_t)row * 64 + 8 * q) = w; }
        }
    }
};
struct EpiUQ {
    static constexpr bool PERM = true, AFTER_DRAIN = false;
    bf16_t* O; const float* rs; const float* cs; const float* sn;
    __device__ __forceinline__ void operator()(const f32x4 (&acc)[2][2][4][2], const Unit& u, int wr, int wc, int fr, int fq) const {
        const int row0 = u.pm * BM + wr * 64 + fr; const int col0 = u.pn * BM + wc * 32 + 8 * fq;
        const int q = (wc & 1) * 4 + fq;
#pragma unroll
        for (int ai = 0; ai < 2; ++ai)
#pragma unroll
            for (int m = 0; m < 4; ++m) { const int row = row0 + ai * HALF + m * 16; const float s = rs[row]; const int pos = row - seq_start(row);
                bf16_t* rowp = O + (size_t)row * 1536 + col0;
#pragma unroll
                for (int bj = 0; bj < 2; ++bj) { f32x4 v0 = acc[ai][bj][m][0] * s, v1 = acc[ai][bj][m][1] * s;
                    const int blk = u.pn * 4 + bj * 2 + (wc >> 1);
                    if (blk % 3 == 2) {
                        const f32x4 c = *(const f32x4*)(cs + (size_t)pos * 32 + 4 * q), sv = *(const f32x4*)(sn + (size_t)pos * 32 + 4 * q);
                        const f32x4 y1 = v0 * c - v1 * sv, y2 = v1 * c + v0 * sv; v0 = y1; v1 = y2; }
                    u32x4 w; w.x = cvt_pk_bf16(v0[0], v0[1]); w.y = cvt_pk_bf16(v0[2], v0[3]); w.z = cvt_pk_bf16(v1[0], v1[1]); w.w = cvt_pk_bf16(v1[2], v1[3]);
                    *(u32x4*)(rowp + bj * HALF) = w; } __builtin_amdgcn_sched_barrier(0); }
    }
};
struct EpiSwi {
    static constexpr bool PERM = true, AFTER_DRAIN = false;
    bf16_t* O; const float* rs;
    __device__ __forceinline__ void operator()(const f32x4 (&acc)[2][2][4][2], const Unit& u, int wr, int wc, int fr, int fq) const {
        const int row0 = u.pm * BM + wr * 64 + fr; const int col0 = u.pn * 128 + wc * 16 + 4 * fq;
#pragma unroll
        for (int ai = 0; ai < 2; ++ai)
#pragma unroll
            for (int m = 0; m < 4; ++m) { const int row = row0 + ai * HALF + m * 16; const float s = rs[row];
                bf16_t* rowp = O + (size_t)row * 5632 + col0;
#pragma unroll
                for (int bj = 0; bj < 2; ++bj) { const f32x4 g = acc[ai][bj][m][0] * s, up = acc[ai][bj][m][1] * s; f32x4 o;
#pragma unroll
                    for (int j = 0; j < 4; ++j) o[j] = g[j] * fsig(g[j]) * up[j];
                    uint2 w; w.x = cvt_pk_bf16(o[0], o[1]); w.y = cvt_pk_bf16(o[2], o[3]);
                    *(uint2*)(rowp + bj * 64) = w; } }
    }
};
}
namespace at {
using pg8::bf16_t; using pg8::bf16x8; using pg8::u32x4;
typedef short s16x4 __attribute__((ext_vector_type(4)));
typedef float f32x16 __attribute__((ext_vector_type(16)));
constexpr int NW = 8, QBLK = 32, KVBLK = 64;
constexpr int SHM_V = KVBLK * 128 * 2, SHM_K = KVBLK * 128 * 2, SHM_R = KVBLK * 64 * 2;
constexpr int OFF_V = 0, OFF_K = 2 * SHM_V, OFF_R = OFF_K + 2 * SHM_K, OFF_WS = OFF_R + 2 * SHM_R, OFF_BIAS = OFF_WS + NW * 64 * 4, OFF_QR = OFF_BIAS + 1024, ATT_LDS = OFF_QR + 256 * 128;
#define KSWZ(row, colB) ((row) * 256 + ((colB) ^ (((row) & 7) << 4)))
#define RSWZ(row, colB) ((row) * 128 + ((colB) ^ (((row) & 7) << 4)))
#define SBAR() __builtin_amdgcn_sched_barrier(0)
__device__ __forceinline__ int crow(int r, int hi) { return (r & 3) + 8 * (r >> 2) + 4 * hi; }
__device__ __forceinline__ unsigned cvtpk(float lo, float hi) { unsigned r; asm volatile("v_cvt_pk_bf16_f32 %0, %1, %2" : "=v"(r) : "v"(lo), "v"(hi)); return r; }
__device__ __forceinline__ bf16x8 ld8(const bf16_t* p) { return *reinterpret_cast<const bf16x8*>(p); }

__device__ __forceinline__ void partialSM(f32x16& p0, f32x16& p1, float& m_reg, float& mn, float& alpha, const float C, const float thr) {
  float pmax = p0[0];
#pragma unroll
  for (int r = 1; r < 16; ++r) pmax = fmaxf(pmax, p0[r]);
#pragma unroll
  for (int r = 0; r < 16; ++r) pmax = fmaxf(pmax, p1[r]);
  { auto rr = __builtin_amdgcn_permlane32_swap(__float_as_uint(pmax), __float_as_uint(pmax), false, false);
    pmax = fmaxf(__uint_as_float(rr[0]), __uint_as_float(rr[1])); }
  if (__builtin_expect(__all(pmax - m_reg <= thr), 1)) { mn = m_reg; alpha = 1.f; }
  else { mn = fmaxf(m_reg, pmax); alpha = __builtin_amdgcn_exp2f((m_reg - mn) * C); m_reg = mn; }
  const float mnC = -mn * C;
#pragma unroll
  for (int r = 0; r < 16; ++r) p0[r] = fmaf(p0[r], C, mnC);
#pragma unroll
  for (int r = 0; r < 16; ++r) p1[r] = fmaf(p1[r], C, mnC);
#pragma unroll
  for (int r = 0; r < 16; ++r) p0[r] = __builtin_amdgcn_exp2f(p0[r]);
}
__device__ __forceinline__ void finishSM(f32x16& p0, f32x16& p1, float alpha, float& l_reg, bf16x8& pa0, bf16x8& pa1, bf16x8& pa2, bf16x8& pa3) {
#pragma unroll
  for (int r = 0; r < 16; ++r) p1[r] = __builtin_amdgcn_exp2f(p1[r]);
  float ps = 0;
#pragma unroll
  for (int r = 0; r < 16; ++r) ps += p0[r];
#pragma unroll
  for (int r = 0; r < 16; ++r) ps += p1[r];
  { auto rr = __builtin_amdgcn_permlane32_swap(__float_as_uint(ps), __float_as_uint(ps), false, false);
    ps = __uint_as_float(rr[0]) + __uint_as_float(rr[1]); }
  l_reg = l_reg * alpha + ps;
#define PK4(P, BASE, OUT) do { unsigned a0 = cvtpk(P[BASE + 0], P[BASE + 1]), a1 = cvtpk(P[BASE + 2], P[BASE + 3]);   \
    unsigned b0 = cvtpk(P[BASE + 4], P[BASE + 5]), b1 = cvtpk(P[BASE + 6], P[BASE + 7]);                              \
    auto r0 = __builtin_amdgcn_permlane32_swap(a0, b0, false, false); auto r1 = __builtin_amdgcn_permlane32_swap(a1, b1, false, false); \
    u32x4 w = {r0[0], r1[0], r0[1], r1[1]}; OUT = *reinterpret_cast<bf16x8*>(&w); } while (0)
  PK4(p0, 0, pa0); PK4(p0, 8, pa1); PK4(p1, 0, pa2); PK4(p1, 8, pa3);
#undef PK4
}
template <int NQD>
__device__ __forceinline__ void qkt(f32x16& p0, f32x16& p1, const char* Ks, const char* Rs, const bf16x8* qr, const char* Qrs, int qrow, int r32, int hi) {
  p0 = f32x16{}; p1 = f32x16{};
#pragma unroll
  for (int d0 = 0; d0 < 8; ++d0) { const int cb = (d0 * 16 + hi * 8) * 2;
    bf16x8 b0 = *reinterpret_cast<const bf16x8*>(Ks + KSWZ(r32, cb));
    bf16x8 b1 = *reinterpret_cast<const bf16x8*>(Ks + KSWZ(32 + r32, cb));
    p0 = __builtin_amdgcn_mfma_f32_32x32x16_bf16(b0, qr[d0], p0, 0, 0, 0);
    p1 = __builtin_amdgcn_mfma_f32_32x32x16_bf16(b1, qr[d0], p1, 0, 0, 0); }
  if constexpr (NQD > 8) {
#pragma unroll
    for (int d0 = 8; d0 < NQD; ++d0) { const int cb = ((d0 - 8) * 16 + hi * 8) * 2;
      bf16x8 b0 = *reinterpret_cast<const bf16x8*>(Rs + RSWZ(r32, cb));
      bf16x8 b1 = *reinterpret_cast<const bf16x8*>(Rs + RSWZ(32 + r32, cb));
      const bf16x8 qv = *reinterpret_cast<const bf16x8*>(Qrs + RSWZ(qrow, cb));
      p0 = __builtin_amdgcn_mfma_f32_32x32x16_bf16(b0, qv, p0, 0, 0, 0);
      p1 = __builtin_amdgcn_mfma_f32_32x32x16_bf16(b1, qv, p1, 0, 0, 0); }
  }
}
__device__ __forceinline__ int v_st(int k, int c) { const int kk = (k & ~0xC) | ((k & 4) << 1) | ((k & 8) >> 1); return ((kk >> 3) * 4 + (c >> 5)) * 512 + ((kk & 7) * 32 + (c & 31)) * 2; }
__device__ __forceinline__ int v_rd_base(int lane) { return ((lane & 3) << 3) | (((lane >> 2) & 3) << 6) | (((lane >> 4) & 1) << 5) | (((lane >> 5) & 1) << 8); }
constexpr int v_rd_off(int d0, int ks, int half) { return d0 * 512 + ks * 4096 + half * 2048; }
template <int OFF> __device__ __forceinline__ s16x4 tr_read(int vb) {
  s16x4 r; asm volatile("ds_read_b64_tr_b16 %0, %1 offset:%2" : "=&v"(r) : "v"(vb), "i"(OFF) : "memory"); return r;
}
template <int D0> __device__ __forceinline__ void pv_one(f32x16& od, int vb, bf16x8 pa0, bf16x8 pa1, bf16x8 pa2, bf16x8 pa3) {
  const s16x4 l0 = tr_read<v_rd_off(D0, 0, 0)>(vb), h0 = tr_read<v_rd_off(D0, 0, 1)>(vb), l1 = tr_read<v_rd_off(D0, 1, 0)>(vb), h1 = tr_read<v_rd_off(D0, 1, 1)>(vb);
  const s16x4 l2 = tr_read<v_rd_off(D0, 2, 0)>(vb), h2 = tr_read<v_rd_off(D0, 2, 1)>(vb), l3 = tr_read<v_rd_off(D0, 3, 0)>(vb), h3 = tr_read<v_rd_off(D0, 3, 1)>(vb);
  asm volatile("s_waitcnt lgkmcnt(0)" ::: "memory"); SBAR();
#define PK(L, H) (bf16x8){L[0], L[1], L[2], L[3], H[0], H[1], H[2], H[3]}
  od = __builtin_amdgcn_mfma_f32_32x32x16_bf16(pa0, PK(l0, h0), od, 0, 0, 0);
  od = __builtin_amdgcn_mfma_f32_32x32x16_bf16(pa1, PK(l1, h1), od, 0, 0, 0);
  od = __builtin_amdgcn_mfma_f32_32x32x16_bf16(pa2, PK(l2, h2), od, 0, 0, 0);
  od = __builtin_amdgcn_mfma_f32_32x32x16_bf16(pa3, PK(l3, h3), od, 0, 0, 0);
#undef PK
}
__device__ __forceinline__ void pv_d0(f32x16* o, int vb, bf16x8 pa0, bf16x8 pa1, bf16x8 pa2, bf16x8 pa3) {
  pv_one<0>(o[0], vb, pa0, pa1, pa2, pa3); pv_one<1>(o[1], vb, pa0, pa1, pa2, pa3); pv_one<2>(o[2], vb, pa0, pa1, pa2, pa3); pv_one<3>(o[3], vb, pa0, pa1, pa2, pa3);
}

struct Args {
  const bf16_t* Q;
  const bf16_t* K;
  const bf16_t* Kr;
  const bf16_t* V;
  bf16_t* O;
  float* lse; long ldlse;
  int nt;
  int kb0, L;
  const float* biasG;
  float C, thr;
};

template <int NQD, bool DIL, long LDQ, long LDK, long LDO>
__device__ __forceinline__ void attn_body(const Args& A, char* lds) {
  const int tid = tidx(), wid = tid >> 6, lane = tid & 63, r32 = lane & 31, hi = lane >> 5;
  char* V_lds = lds + OFF_V; char* K_lds = lds + OFF_K; char* R_lds = lds + OFF_R;
  float* ws = (float*)(lds + OFF_WS) + wid * 64; float* li_l = ws; float* al_l = ws + 32;
  float* biasL = (float*)(lds + OFF_BIAS);
  char* Qr_lds = lds + OFF_QR;
  float m_reg = -1e30f, l_reg = 0; f32x16 o[4] = {}; bf16x8 qr[8];
  const bf16_t* Qw = A.Q + (long)(wid * QBLK + r32) * LDQ + hi * 8;
#pragma unroll
  for (int d0 = 0; d0 < 8; ++d0) qr[d0] = ld8(Qw + d0 * 16);
  if constexpr (NQD > 8) {
#pragma unroll
    for (int d0 = 8; d0 < NQD; ++d0) *(bf16x8*)(Qr_lds + RSWZ(wid * 32 + r32, ((d0 - 8) * 16 + hi * 8) * 2)) = ld8(Qw + d0 * 16);
  }
  if constexpr (DIL) { if (tid < 129) biasL[tid] = A.biasG[tid]; }
  const int sr = tid >> 4, sc = (tid & 15) * 8, vst0 = v_st(sr, sc), vst1 = v_st(32 + sr, sc);
  const int rr_ = tid >> 3, rc_ = (tid & 7) * 8;
  const int vb0 = (int)(uintptr_t)V_lds + v_rd_base(lane);
  bf16x8 vs0, vs1, ks0, ks1, rs0;
  const int Lm1 = A.L - 1;
#define SLOAD(i) do { long ra, rb; if constexpr (DIL) { int a_ = A.kb0 + (i) * 64 + sr, b_ = a_ + 32; a_ = a_ < 0 ? 0 : (a_ > Lm1 ? Lm1 : a_); b_ = b_ < 0 ? 0 : (b_ > Lm1 ? Lm1 : b_); ra = a_; rb = b_; } \
      else { ra = (i) * 64 + sr; rb = ra + 32; } \
    vs0 = ld8(A.V + ra * LDK + sc); vs1 = ld8(A.V + rb * LDK + sc); ks0 = ld8(A.K + ra * LDK + sc); ks1 = ld8(A.K + rb * LDK + sc); \
    if constexpr (NQD > 8) rs0 = ld8(A.Kr + (long)((i) * 64 + rr_) * 64 + rc_); } while (0)
#define SWRITE(b) do { *(bf16x8*)(V_lds + (b) * SHM_V + vst0) = vs0; *(bf16x8*)(V_lds + (b) * SHM_V + vst1) = vs1; const int kc = sc * 2; \
    *(bf16x8*)(K_lds + (b) * SHM_K + KSWZ(sr, kc)) = ks0; *(bf16x8*)(K_lds + (b) * SHM_K + KSWZ(32 + sr, kc)) = ks1; \
    if constexpr (NQD > 8) *(bf16x8*)(R_lds + (b) * SHM_R + RSWZ(rr_, rc_ * 2)) = rs0; } while (0)
#define SWAIT() asm volatile("s_waitcnt vmcnt(0)" ::: "memory")
#define RESC(a) do { if (__any((a) < 1.f)) { if (hi == 0) al_l[r32] = (a); asm volatile("s_waitcnt lgkmcnt(0)" ::: "memory"); \
    _Pragma("unroll") for (int d = 0; d < 4; ++d) _Pragma("unroll") for (int r = 0; r < 16; ++r) o[d][r] *= al_l[crow(r, hi)]; } } while (0)
#define MASK(P0, P1, i) do { if constexpr (DIL) { const int relb = 64 * ((i) - 1) - (wid * 32 + r32); const int kpb = A.kb0 + 64 * (i); \
    _Pragma("unroll") for (int r = 0; r < 16; ++r) { const int key = crow(r, hi); \
      { const int rel = relb + key, kp = kpb + key; const bool ok = rel >= -64 && rel <= 64 && kp >= 0 && kp <= Lm1; const int ix = ok ? rel + 64 : 0; P0[r] = ok ? fmaf(P0[r], A.C, biasL[ix]) : -1e30f; } \
      { const int rel = relb + key + 32, kp = kpb + key + 32; const bool ok = rel >= -64 && rel <= 64 && kp >= 0 && kp <= Lm1; const int ix = ok ? rel + 64 : 0; P1[r] = ok ? fmaf(P1[r], A.C, biasL[ix]) : -1e30f; } } } } while (0)
  const float Csm = DIL ? 1.f : A.C; const float thr = A.thr;
  f32x16 pA0, pA1; float mnA, alA; bf16x8 pa0, pa1, pa2, pa3; const int NT = A.nt;
  {
    SLOAD(0); SWAIT(); SWRITE(0); __syncthreads();
    for (int i = 0; i < NT; ++i) {
      if constexpr (!DIL) { if (i + 1 < NT) SLOAD(i + 1); }
      SBAR();
      qkt<NQD>(pA0, pA1, K_lds + (i & 1) * SHM_K, R_lds + (i & 1) * SHM_R, qr, Qr_lds, wid * 32 + r32, r32, hi); MASK(pA0, pA1, i); partialSM(pA0, pA1, m_reg, mnA, alA, Csm, thr);
      RESC(alA);
      finishSM(pA0, pA1, alA, l_reg, pa0, pa1, pa2, pa3); SBAR();
      pv_d0(o, vb0 + (i & 1) * SHM_V, pa0, pa1, pa2, pa3);
      if (i + 1 < NT) { if constexpr (DIL) SLOAD(i + 1); SWAIT(); SWRITE((i + 1) & 1); }
      __syncthreads();
    }
  }
  if (hi == 0) li_l[r32] = l_reg; asm volatile("s_waitcnt lgkmcnt(0)" ::: "memory");
  if constexpr (DIL) { if (hi == 0) A.lse[(long)(wid * QBLK + r32) * A.ldlse] = m_reg + __log2f(l_reg); }
  float rli[16];
#pragma unroll
  for (int r = 0; r < 16; ++r) rli[r] = __builtin_amdgcn_rcpf(li_l[crow(r, hi)]);
  bf16_t* Ow = A.O + (long)(wid * QBLK) * LDO;
#pragma unroll
  for (int r = 0; r < 16; ++r) { const int orow = crow(r, hi);
#pragma unroll
    for (int d0 = 0; d0 < 4; ++d0) { const float v = o[d0][r] * rli[r]; Ow[(long)orow * LDO + d0 * 32 + r32] = (bf16_t)(cvtpk(v, v) & 0xffffu); } }
  __syncthreads();
#undef SLOAD
#undef SWRITE
#undef SWAIT
#undef RESC
#undef MASK
}
}
using pg8::bf16_t; using pg8::bf16x8; using pg8::f32x4; using pg8::u32x4;
constexpr int T = 24576, DM = 2048, FH = 5632, NTHR = 512;
constexpr size_t MiB = 1048576;
constexpr size_t O_WM = 0, O_SM = 40 * MiB, O_RF = 104 * MiB, O_RA = 200 * MiB, O_RB = 296 * MiB, O_RC = 392 * MiB, O_RD = 488 * MiB, O_RE = 584 * MiB, O_RX = 680 * MiB,
                 O_RG = 776 * MiB, O_RH = 872 * MiB, WS_END = 968 * MiB;
constexpr size_t S_RINV = O_SM, S_RINVQ = S_RINV + 131072, S_RINVKV = S_RINVQ + 131072, S_LSE = S_RINVKV + 131072  , S_COS = S_LSE + 2359296  ,
                 S_SIN = S_COS + 2 * MiB, S_BIAS = S_SIN + 2 * MiB  , S_GL = S_BIAS + 16384  , S_WL = S_GL + 12 * MiB, S_AL = S_WL + 12 * MiB, S_END = S_AL + 12 * MiB;
static_assert(S_END <= O_RF, "small region overflow");
constexpr int LDS_BYTES = 131072;
static_assert(at::ATT_LDS <= LDS_BYTES, "attention LDS");

struct Params {
  const float *xp, *xs, *norm_g, *rel_bias, *w_in, *q_norm, *kv_norm, *w_uq, *w_ukv, *w_out, *mu, *w_r, *w_k, *w_v, *w_o, *w0, *w1, *w2, *a0, *a1, *a2, *g1, *g2, *k_k, *k_a, *r_k, *ln_w, *ln_b,
              *w_gate, *w_up, *w_down;
  float* out; unsigned char* ws; int ph_lo, ph_hi;
};

__device__ __forceinline__ float bf2f(bf16_t b) { return __uint_as_float(((unsigned)b) << 16); }
__device__ __forceinline__ bf16_t f2bf(float f) { unsigned u = __float_as_uint(f); u += 0x7FFFu + ((u >> 16) & 1u); return (bf16_t)(u >> 16); }
__device__ __forceinline__ float wave_sum(float x) {
#pragma unroll
  for (int o = 32; o >= 1; o >>= 1) x += __shfl_xor(x, o);
  return x;
}
template <int CTRL> __device__ __forceinline__ float dpp_f(float x) { return __int_as_float(__builtin_amdgcn_update_dpp(0, __float_as_int(x), CTRL, 0xF, 0xF, false)); }
__device__ __forceinline__ float row16_sum(float x) { x += dpp_f<0x128>(x); x += dpp_f<0x124>(x); x += dpp_f<0x122>(x); x += dpp_f<0x121>(x); return x; }

struct WMap { const float* s0; const float* s1; const float* gain; int ld; int mode; };
__device__ __forceinline__ int rope_dim(int p) { const int q = p >> 3, w = p & 7; return w < 4 ? 4 * q + w : 32 + 4 * q + (w - 4); }
__device__ __forceinline__ float wmap_get(const WMap& m, int k, int n) {
  float g = m.gain ? m.gain[k] : 1.f;
  switch (m.mode) {
    case 0: return m.s0[(size_t)k * m.ld + n] * g;
    case 1: { int col; if (n < 1024) col = n; else if (n < 4096) col = n + 64; else if (n < 4160) col = 1024 + rope_dim(n - 4096); else return 0.f; return m.s0[(size_t)k * 4160 + col] * g; }
    case 2: { const int h = n / 192, c = n - h * 192; const int col = c < 128 ? n : h * 192 + 128 + rope_dim(c - 128); return m.s0[(size_t)k * 1536 + col] * g; }
    case 3: { const int g8 = n >> 3, w = n & 7; return (w < 4 ? m.s0[(size_t)k * FH + g8 * 4 + w] : m.s1[(size_t)k * FH + g8 * 4 + w - 4]) * g; }
    case 4: { if (n < 96) return m.s0[(size_t)k * 96 + n]; if (n < 192) return m.s1[(size_t)k * 96 + n - 96]; return 0.f; }
    default: { const int d = n >> 11, kk = k - d * 96; if (kk < 0 || kk >= 96) return 0.f; return (d ? m.s1 : m.s0)[(size_t)kk * 2048 + (n & 2047)]; }
  }
}
__device__ __forceinline__ void convert_T(const WMap& m, bf16_t* dst, int N, int K, float* tile  ) {
  const int tid = tidx(), ntn = N >> 6, ntk = K >> 6, nt = ntn * ntk;
  for (int t = blockIdx.x; t < nt; t += gridDim.x) {
    const int n0 = (t % ntn) << 6, k0 = (t / ntn) << 6;
    { const int j = tid & 63, i0 = tid >> 6;
#pragma unroll
      for (int kk = 0; kk < 8; ++kk) { const int kl = i0 * 8 + kk; tile[kl * 65 + j] = wmap_get(m, k0 + kl, n0 + j); } }
    __syncthreads();
    { const int nl = tid >> 3, kc = (tid & 7) * 8; float v[8];
#pragma unroll
      for (int e = 0; e < 8; ++e) v[e] = tile[(kc + e) * 65 + nl];
      u32x4 w; w.x = pg8::cvt_pk_bf16(v[0], v[1]); w.y = pg8::cvt_pk_bf16(v[2], v[3]); w.z = pg8::cvt_pk_bf16(v[4], v[5]); w.w = pg8::cvt_pk_bf16(v[6], v[7]);
      *(u32x4*)(dst + (size_t)(n0 + nl) * K + k0 + kc) = w; }
    __syncthreads();
  }
}
__device__ __forceinline__ void convert_attn_weights(const Params& p, int i, int layer, float* tile) {
  bf16_t* W = (bf16_t*)(p.ws + O_WM);
  { WMap m{p.w_in + (size_t)i * 2048 * 4160, nullptr, p.norm_g + (size_t)(layer * 4 + 0) * DM, 4160, 1}; convert_T(m, W, 4352, 2048, tile); }
  { WMap m{p.w_uq + (size_t)i * 512 * 1536, nullptr, p.q_norm + (size_t)i * 512, 1536, 2}; convert_T(m, W + 8912896, 1536, 512, tile); }
  { WMap m{p.w_ukv + (size_t)i * 512 * 2048, nullptr, p.kv_norm + (size_t)i * 512, 2048, 0}; convert_T(m, W + 8912896 + 786432, 2048, 512, tile); }
  { WMap m{p.w_out + (size_t)i * 2048 * 2048, nullptr, nullptr, 2048, 0}; convert_T(m, W + 8912896 + 786432 + 1048576, 2048, 2048, tile); }
}
constexpr size_t WA_IN = 0, WA_UQ = 8912896, WA_UKV = WA_UQ + 786432, WA_OUT = WA_UKV + 1048576;
constexpr size_t WR_R = 0, WR_K = 4194304, WR_V = 2 * 4194304, WR_O = 3 * 4194304, WR_W1 = 4 * 4194304, WR_A1 = WR_W1 + 524288, WR_G1 = WR_A1 + 524288, WR_G2 = WR_G1 + 524288,
                 WR_W2 = WR_G2 + 524288, WR_A2 = WR_W2 + 1048576;
static_assert((WR_A2 + 1048576) * 2 == 40 * MiB, "rwkv weights size");
__device__ __forceinline__ void convert_rwkv_weights(const Params& p, int i, float* tile) {
  bf16_t* W = (bf16_t*)(p.ws + O_WM); const size_t DD = (size_t)DM * DM;
  { WMap m{p.w_r + i * DD, nullptr, nullptr, 2048, 0}; convert_T(m, W + WR_R, 2048, 2048, tile); }
  { WMap m{p.w_k + i * DD, nullptr, nullptr, 2048, 0}; convert_T(m, W + WR_K, 2048, 2048, tile); }
  { WMap m{p.w_v + i * DD, nullptr, nullptr, 2048, 0}; convert_T(m, W + WR_V, 2048, 2048, tile); }
  { WMap m{p.w_o + i * DD, nullptr, nullptr, 2048, 0}; convert_T(m, W + WR_O, 2048, 2048, tile); }
  { WMap m{p.w1 + (size_t)(i * 2) * 2048 * 96, p.w1 + (size_t)(i * 2 + 1) * 2048 * 96, nullptr, 96, 4}; convert_T(m, W + WR_W1, 256, 2048, tile); }
  { WMap m{p.a1 + (size_t)(i * 2) * 2048 * 96, p.a1 + (size_t)(i * 2 + 1) * 2048 * 96, nullptr, 96, 4}; convert_T(m, W + WR_A1, 256, 2048, tile); }
  { WMap m{p.g1 + (size_t)i * 2048 * 256, nullptr, nullptr, 256, 0}; convert_T(m, W + WR_G1, 256, 2048, tile); }
  { WMap m{p.g2 + (size_t)i * 256 * 2048, nullptr, nullptr, 2048, 0}; convert_T(m, W + WR_G2, 2048, 256, tile); }
  { WMap m{p.w2 + (size_t)(i * 2) * 96 * 2048, p.w2 + (size_t)(i * 2 + 1) * 96 * 2048, nullptr, 2048, 5}; convert_T(m, W + WR_W2, 4096, 256, tile); }
  { WMap m{p.a2 + (size_t)(i * 2) * 96 * 2048, p.a2 + (size_t)(i * 2 + 1) * 96 * 2048, nullptr, 2048, 5}; convert_T(m, W + WR_A2, 4096, 256, tile); }
}
constexpr size_t WF_GU = 0, WF_DN = (size_t)11264 * 2048;
__device__ __forceinline__ void convert_ffn_weights(const Params& p, int layer, float* tile) {
  bf16_t* W = (bf16_t*)(p.ws + O_RF); const size_t DF = (size_t)DM * FH;
  { WMap m{p.w_gate + layer * DF, p.w_up + layer * DF, p.norm_g + (size_t)(layer * 4 + 2) * DM, FH, 3}; convert_T(m, W + WF_GU, 11264, 2048, tile); }
  { WMap m{p.w_down + layer * DF, nullptr, nullptr, 2048, 0}; convert_T(m, W + WF_DN, 2048, 5632, tile); }
}
__device__ __forceinline__ void convert_mixer_weights(const Params& p, int layer, float* tile) { if (layer & 1) convert_rwkv_weights(p, layer >> 1, tile); else convert_attn_weights(p, layer >> 1, layer, tile); }

__device__ __forceinline__ void resid_phase(const Params& p, const float* mix, const float* g) {
  const int lane = tidx() & 63, gw = blockIdx.x * 8 + (tidx() >> 6), nw = gridDim.x * 8;
  bf16_t* xb = (bf16_t*)(p.ws + O_RC); float* rinv = (float*)(p.ws + S_RINV);
  for (int t = gw; t < T; t += nw) {
    float* xr = p.out + (size_t)t * DM; f32x4 xv[8];
    if (mix) {
      const float* mr = mix + (size_t)t * DM; f32x4 mv[8]; float ss = 0;
#pragma unroll
      for (int i = 0; i < 8; ++i) { mv[i] = *(const f32x4*)(mr + i * 256 + lane * 4); ss += mv[i][0] * mv[i][0] + mv[i][1] * mv[i][1] + mv[i][2] * mv[i][2] + mv[i][3] * mv[i][3]; }
      ss = wave_sum(ss); const float sc = rsqrtf(ss * (1.f / DM) + 1e-6f);
#pragma unroll
      for (int i = 0; i < 8; ++i) { const f32x4 gv = *(const f32x4*)(g + i * 256 + lane * 4); xv[i] = *(const f32x4*)(xr + i * 256 + lane * 4) + mv[i] * sc * gv; }
    } else {
      const float* src = t < 8192 ? p.xp + (size_t)t * DM : p.xs + (size_t)(t - 8192) * DM;
#pragma unroll
      for (int i = 0; i < 8; ++i) xv[i] = *(const f32x4*)(src + i * 256 + lane * 4);
    }
    float s2 = 0;
#pragma unroll
    for (int i = 0; i < 8; ++i) { s2 += xv[i][0] * xv[i][0] + xv[i][1] * xv[i][1] + xv[i][2] * xv[i][2] + xv[i][3] * xv[i][3];
      *(f32x4*)(xr + i * 256 + lane * 4) = xv[i];
      uint2 w; w.x = pg8::cvt_pk_bf16(xv[i][0], xv[i][1]); w.y = pg8::cvt_pk_bf16(xv[i][2], xv[i][3]); *(uint2*)(xb + (size_t)t * DM + i * 256 + lane * 4) = w; }
    s2 = wave_sum(s2); if (lane == 0) rinv[t] = rsqrtf(s2 * (1.f / DM) + 1e-6f);
  }
}
__device__ __forceinline__ void rownorm_phase(const Params& p) {
  const int lane = tidx() & 63, gw = blockIdx.x * 8 + (tidx() >> 6), nw = gridDim.x * 8;
  const bf16_t* cq = (const bf16_t*)(p.ws + O_RA); const bf16_t* ckv = cq + (size_t)T * 512;
  float* rq = (float*)(p.ws + S_RINVQ); float* rkv = (float*)(p.ws + S_RINVKV);
  for (int t = gw; t < 2 * T; t += nw) { const int tt = t >= T ? t - T : t; const bf16_t* src = (t >= T ? ckv : cq) + (size_t)tt * 512 + lane * 8;
    const bf16x8 v = *(const bf16x8*)src; float ss = 0;
#pragma unroll
    for (int e = 0; e < 8; ++e) { const float f = bf2f((bf16_t)v[e]); ss += f * f; }
    ss = wave_sum(ss); if (lane == 0) (t >= T ? rkv : rq)[tt] = rsqrtf(ss * (1.f / 512) + 1e-6f); }
}
__device__ __forceinline__ void mix_phase(const Params& p, const float* g0, const float* mu  , int sel0, int sel1, int sel2) {
  const int lane = tidx() & 63, gw = blockIdx.x * 8 + (tidx() >> 6), nw = gridDim.x * 8;
  const float* rinv = (const float*)(p.ws + S_RINV);
  bf16_t* m0 = (bf16_t*)(p.ws + O_RD); bf16_t* m1 = (bf16_t*)(p.ws + O_RE); bf16_t* m2 = (bf16_t*)(p.ws + O_RX);
  for (int t = gw; t < T; t += nw) {
    const int s0 = pg8::seq_start(t), len = s0 == 8192 ? 16384 : 4096; const bool hasp = t > s0, hasn = t < s0 + len - 1;
    const float rc = rinv[t], rp = hasp ? rinv[t - 1] : 0.f, rn = hasn ? rinv[t + 1] : 0.f;
    const float* xc = p.out + (size_t)t * DM; const float* xpv = hasp ? xc - DM : xc; const float* xnv = hasn ? xc + DM : xc;
#pragma unroll 2
    for (int i = 0; i < 8; ++i) { const int c = i * 256 + lane * 4;
      const f32x4 gv = *(const f32x4*)(g0 + c); const f32x4 h = *(const f32x4*)(xc + c) * rc * gv, hp = *(const f32x4*)(xpv + c) * rp * gv, hn = *(const f32x4*)(xnv + c) * rn * gv;
      const f32x4 xx = (hp + hn) * 0.5f - h;
      const f32x4 a = h + xx * *(const f32x4*)(mu + sel0 * DM + c), b = h + xx * *(const f32x4*)(mu + sel1 * DM + c), d = h + xx * *(const f32x4*)(mu + sel2 * DM + c);
      uint2 w; w.x = pg8::cvt_pk_bf16(a[0], a[1]); w.y = pg8::cvt_pk_bf16(a[2], a[3]); *(uint2*)(m0 + (size_t)t * DM + c) = w;
      w.x = pg8::cvt_pk_bf16(b[0], b[1]); w.y = pg8::cvt_pk_bf16(b[2], b[3]); *(uint2*)(m1 + (size_t)t * DM + c) = w;
      w.x = pg8::cvt_pk_bf16(d[0], d[1]); w.y = pg8::cvt_pk_bf16(d[2], d[3]); *(uint2*)(m2 + (size_t)t * DM + c) = w; }
  }
}
__device__ __forceinline__ void postscan_phase(const Params& p, int i) {
  const int lane = tidx() & 63, gw = blockIdx.x * 8 + (tidx() >> 6), nw = gridDim.x * 8;
  bf16_t* y0 = (bf16_t*)(p.ws + O_RH); const bf16_t* y1 = (const bf16_t*)(p.ws + O_RF);
  const bf16_t* r = (const bf16_t*)(p.ws + O_RA); const bf16_t* k = (const bf16_t*)(p.ws + O_RB); const bf16_t* v = (const bf16_t*)(p.ws + O_RC); const bf16_t* g = (const bf16_t*)(p.ws + O_RD);
  const float* lnw = p.ln_w + (size_t)i * DM; const float* lnb = p.ln_b + (size_t)i * DM; const float* rk = p.r_k + (size_t)i * DM;
  for (int t = gw; t < T; t += nw) {
#pragma unroll 4
    for (int h = 0; h < 32; ++h) { const size_t ix = (size_t)t * DM + h * 64 + lane; const int c = h * 64 + lane;
      const float y = bf2f(y0[ix]) + bf2f(y1[ix]);
      const float mean = wave_sum(y) * (1.f / 64); const float d = y - mean; const float var = wave_sum(d * d) * (1.f / 64);
      float o = d * rsqrtf(var + 64e-5f) * lnw[c] + lnb[c];
      const float rf = bf2f(r[ix]), kf = bf2f(k[ix]), vf = bf2f(v[ix]);
      const float bonus = wave_sum(rf * kf * rk[c]) * vf;
      o = (o + bonus) * bf2f(g[ix]);
      y0[ix] = f2bf(o); }
  }
}
__device__ __forceinline__ void combine_phase(const Params& p) {
  const bf16_t* Op = (const bf16_t*)(p.ws + O_RX); const float* lse = (const float*)(p.ws + S_LSE); bf16_t* cat = (bf16_t*)(p.ws + O_RF);
  const size_t n = (size_t)T * 128;
  for (size_t it = (size_t)blockIdx.x * NTHR + tidx(); it < n; it += (size_t)gridDim.x * NTHR) {
    const int t = (int)(it >> 7), c8 = (int)(it & 127) * 8, h = c8 >> 7;
    const float l0 = lse[((size_t)0 * T + t) * 8 + h], l1 = lse[((size_t)1 * T + t) * 8 + h], l2 = lse[((size_t)2 * T + t) * 8 + h];
    const float m = fmaxf(l0, fmaxf(l1, l2)); float w0 = __builtin_amdgcn_exp2f(l0 - m), w1 = __builtin_amdgcn_exp2f(l1 - m), w2 = __builtin_amdgcn_exp2f(l2 - m);
    const float inv = 1.f / (w0 + w1 + w2); w0 *= inv; w1 *= inv; w2 *= inv;
    const bf16x8 a = *(const bf16x8*)(Op + ((size_t)0 * T + t) * 1024 + c8), b = *(const bf16x8*)(Op + ((size_t)1 * T + t) * 1024 + c8), d = *(const bf16x8*)(Op + ((size_t)2 * T + t) * 1024 + c8);
    float o[8];
#pragma unroll
    for (int e = 0; e < 8; ++e) o[e] = w0 * bf2f((bf16_t)a[e]) + w1 * bf2f((bf16_t)b[e]) + w2 * bf2f((bf16_t)d[e]);
    u32x4 w; w.x = pg8::cvt_pk_bf16(o[0], o[1]); w.y = pg8::cvt_pk_bf16(o[2], o[3]); w.z = pg8::cvt_pk_bf16(o[4], o[5]); w.w = pg8::cvt_pk_bf16(o[6], o[7]);
    *(u32x4*)(cat + (size_t)t * DM + 1024 + c8) = w;
  }
}
__device__ __forceinline__ void tables_phase(const Params& p) {
  float* cs = (float*)(p.ws + S_COS); float* sn = (float*)(p.ws + S_SIN); float* bt = (float*)(p.ws + S_BIAS);
  for (int it = blockIdx.x * NTHR + tidx(); it < 16384 * 32; it += gridDim.x * NTHR) { const int pos = it >> 5, i = it & 31;
    const float inv = __builtin_amdgcn_exp2f(-(float)i * (13.287712379549449f / 32.f)); const float ang = (float)pos * inv;
    const double rev = (double)ang * 0.15915494309189535; const float fr = (float)(rev - __builtin_rint(rev));
    cs[it] = __builtin_amdgcn_cosf(fr); sn[it] = __builtin_amdgcn_sinf(fr); }
  for (int it = blockIdx.x * NTHR + tidx(); it < 3 * 8 * 129; it += gridDim.x * NTHR) { const int pat = it / (8 * 129), rem = it - pat * 8 * 129, h = rem / 129, rl = rem - h * 129 - 64;
    const int dil = pat == 0 ? 1 : (pat == 1 ? 4 : 16); const int rel = rl * dil; const int n = rel < 0 ? -rel : rel;
    int bucket = rel > 0 ? 16 : 0;
    if (n < 8) bucket += n; else { int lg = 8 + (int)(__log2f((float)n * 0.125f) * (8.f / 7.f)); bucket += lg < 15 ? lg : 15; }
    bt[it] = p.rel_bias[bucket * 8 + h] * 1.4426950408889634f; }
}
constexpr int SCH = 32;
constexpr int SC_AM = 0, SC_B = 8192, SC_W = 16384, SC_KD = 24576, SC_R = 32768, SC_V = 40960, SC_Y = 45056, SC_BUF = 49152;
static_assert(2 * SC_BUF <= LDS_BYTES, "scan LDS");
__device__ __forceinline__ void scan_phase(const Params& p, int i, unsigned char* lds) {
  const int tid = tidx(), wid = tid >> 6, lane = tid & 63;
  const bf16_t* rB = (const bf16_t*)(p.ws + O_RA); const bf16_t* kB = (const bf16_t*)(p.ws + O_RB); const bf16_t* vB = (const bf16_t*)(p.ws + O_RC);
  const bf16_t* eB = (const bf16_t*)(p.ws + O_RD); const bf16_t* aB = (const bf16_t*)(p.ws + O_RX);
  const float* kkw = p.k_k + (size_t)i * DM; const float* kaw = p.k_a + (size_t)i * DM;
  for (int wk = blockIdx.x; wk < 256; wk += gridDim.x) {
    const int nit = wk < 128 ? 1 : 2;
    for (int q = 0; q < nit; ++q) {
      int s0, len, head, dir, half;
      if (wk < 128) { half = wk & 1; const int u = wk >> 1; dir = u & 1; head = u >> 1; s0 = 8192; len = 16384; }
      else { const int it = (wk - 128) * 2 + q; half = it & 1; const int u = it >> 1; dir = u & 1; head = (u >> 1) & 31; s0 = (u >> 6) * 4096; len = 4096; }
      bf16_t* yB = (bf16_t*)(p.ws + (dir ? O_RF : O_RH));
      const int nch = len / SCH;
      const int col = head * 64 + lane;
      const float kkc = kkw[col], kac = kaw[col];
      const float w0c = p.w0[(size_t)(i * 2 + dir) * DM + col], a0c = p.a0[(size_t)(i * 2 + dir) * DM + col];
      const int rp = lane >> 4, kq = lane & 15;
      float S0[4] = {0.f, 0.f, 0.f, 0.f}, S1[4] = {0.f, 0.f, 0.f, 0.f};
      auto fill = [&](int c, int b) {
        unsigned char* B = lds + b * SC_BUF; const int pw = wid - 4;
#pragma unroll
        for (int j = 0; j < 8; ++j) { const int sl = pw * 8 + j; const int s = c * SCH + sl; const int t = dir ? len - 1 - s : s; const size_t tok = (size_t)(s0 + t);
          const float kf = bf2f(kB[tok * DM + col]), rf = bf2f(rB[tok * DM + col]), ef = 0.6065306597f * pg8::fsig(w0c + bf2f(eB[tok * 4096 + dir * 2048 + col])), af = pg8::fsig(a0c + bf2f(aB[tok * 4096 + dir * 2048 + col]));
          const float kk = kf * kkc; float ss = row16_sum(kk * kk);
          { const int si = __float_as_int(ss); ss = __int_as_float(__builtin_amdgcn_readlane(si, 0)) + __int_as_float(__builtin_amdgcn_readlane(si, 16)) + __int_as_float(__builtin_amdgcn_readlane(si, 32)) + __int_as_float(__builtin_amdgcn_readlane(si, 48)); }
          const float kn = kk * rsqrtf(ss + 1e-12f);
          ((float*)(B + SC_AM))[sl * 64 + lane] = -kn; ((float*)(B + SC_B))[sl * 64 + lane] = kn * af; ((float*)(B + SC_W))[sl * 64 + lane] = __expf(-ef);
          ((float*)(B + SC_KD))[sl * 64 + lane] = kf * (1.f + (af - 1.f) * kac); ((float*)(B + SC_R))[sl * 64 + lane] = rf;
          if (lane < 32) ((float*)(B + SC_V))[sl * 32 + lane] = bf2f(vB[tok * DM + head * 64 + half * 32 + lane]); }
      };
      auto flush = [&](int c, int b) {
        const unsigned char* B = lds + b * SC_BUF; const int pw = wid - 4;
#pragma unroll
        for (int j = 0; j < 4; ++j) { const int sl = pw * 8 + j * 2 + (lane >> 5); const int s = c * SCH + sl; const int t = dir ? len - 1 - s : s;
          yB[(size_t)(s0 + t) * DM + head * 64 + half * 32 + (lane & 31)] = f2bf(((const float*)(B + SC_Y))[sl * 32 + (lane & 31)]); }
      };
      if (wid >= 4) fill(0, 0);
      __syncthreads();
      for (int c = 0; c < nch; ++c) {
        if (wid < 4) {
          const unsigned char* B = lds + (c & 1) * SC_BUF;
          const f32x4* pAM = (const f32x4*)(B + SC_AM) + kq; const f32x4* pB = (const f32x4*)(B + SC_B) + kq; const f32x4* pW = (const f32x4*)(B + SC_W) + kq;
          const f32x4* pKD = (const f32x4*)(B + SC_KD) + kq; const f32x4* pR = (const f32x4*)(B + SC_R) + kq;
          const float2* pV = (const float2*)(B + SC_V) + wid * 4 + rp; float2* pY = (float2*)(B + SC_Y) + wid * 4 + rp;
#pragma unroll 4
          for (int s = 0; s < SCH; ++s) {
            const f32x4 am = pAM[s * 16], bb = pB[s * 16], ww = pW[s * 16], kd = pKD[s * 16], rr = pR[s * 16]; const float2 vv = pV[s * 16];
            float sa0 = S0[0] * am[0] + S0[1] * am[1] + S0[2] * am[2] + S0[3] * am[3];
            float sa1 = S1[0] * am[0] + S1[1] * am[1] + S1[2] * am[2] + S1[3] * am[3];
            sa0 = row16_sum(sa0); sa1 = row16_sum(sa1);
            float y0 = 0.f, y1 = 0.f;
#pragma unroll
            for (int j = 0; j < 4; ++j) { S0[j] = S0[j] * ww[j] + sa0 * bb[j] + vv.x * kd[j]; S1[j] = S1[j] * ww[j] + sa1 * bb[j] + vv.y * kd[j]; y0 += S0[j] * rr[j]; y1 += S1[j] * rr[j]; }
            y0 = row16_sum(y0); y1 = row16_sum(y1);
            if (kq == 0) pY[s * 16] = make_float2(y0, y1);
          }
        } else {
          if (c + 1 < nch) fill(c + 1, (c + 1) & 1);
          if (c >= 1) flush(c - 1, (c - 1) & 1);
        }
        __syncthreads();
      }
      if (wid >= 4) flush(nch - 1, (nch - 1) & 1);
      __syncthreads();
    }
  }
}

__device__ __forceinline__ void dilated_phase(const Params& p, char* lds) {
  const bf16_t* qb = (const bf16_t*)(p.ws + O_RD); const bf16_t* kb = qb + (size_t)T * 1024; const bf16_t* vb = kb + (size_t)T * 1024;
  bf16_t* Op = (bf16_t*)(p.ws + O_RX); float* lse = (float*)(p.ws + S_LSE); const float* bt = (const float*)(p.ws + S_BIAS);
  for (int it = blockIdx.x; it < 3 * 8 * 96; it += gridDim.x) {
    const int pat = it / 768, rem = it - pat * 768, h = rem / 96, blk = rem - h * 96;
    const int dil = pat == 0 ? 1 : (pat == 1 ? 4 : 16);
    int s0, len, b = blk;
    if (b < 16) { s0 = 0; len = 4096; } else if (b < 32) { s0 = 4096; len = 4096; b -= 16; } else { s0 = 8192; len = 16384; b -= 32; }
    const int L = len / dil, nbl = L / 256; const int res = b / nbl, j0 = (b - res * nbl) * 256;
    const size_t tok0 = (size_t)(s0 + res);
    at::Args A;
    A.Q = qb + (tok0 + (size_t)j0 * dil) * 1024 + h * 128;
    A.K = kb + tok0 * 1024 + h * 128; A.Kr = nullptr;
    A.V = vb + tok0 * 1024 + h * 128;
    A.O = Op + ((size_t)pat * T + tok0 + (size_t)j0 * dil) * 1024 + h * 128;
    A.lse = lse + ((size_t)pat * T + tok0 + (size_t)j0 * dil) * 8 + h; A.ldlse = (long)dil * 8;
    A.nt = 6; A.kb0 = j0 - 64; A.L = L; A.biasG = bt + (pat * 8 + h) * 129;
    A.C = 0.08838834764831845f * 1.4426950408889634f; A.thr = 11.5f;
    if (pat == 0) at::attn_body<8, true, 1024, 1024, 1024>(A, lds);
    else if (pat == 1) at::attn_body<8, true, 4096, 4096, 4096>(A, lds);
    else at::attn_body<8, true, 16384, 16384, 16384>(A, lds);
  }
}
__device__ __forceinline__ void mla_phase(const Params& p, char* lds) {
  const bf16_t* Qp = (const bf16_t*)(p.ws + O_RB); const bf16_t* kv = (const bf16_t*)(p.ws + O_RH); const bf16_t* kr = (const bf16_t*)(p.ws + O_RA) + (size_t)T * 1024;
  bf16_t* cat = (bf16_t*)(p.ws + O_RF);
  for (int it = blockIdx.x; it < 512 + 256; it += gridDim.x) {
    int s0, len, h, qb_;
    if (it < 512) { s0 = 8192; len = 16384; h = it >> 6; qb_ = it & 63; }
    else { const int j = it - 512; s0 = (j >> 7) * 4096; len = 4096; h = (j >> 4) & 7; qb_ = j & 15; }
    at::Args A;
    A.Q = Qp + (size_t)(s0 + qb_ * 256) * 1536 + h * 192;
    A.K = kv + (size_t)s0 * 2048 + h * 256; A.Kr = kr + (size_t)s0 * 64;
    A.V = A.K + 128;
    A.O = cat + (size_t)(s0 + qb_ * 256) * 2048 + h * 128;
    A.lse = nullptr; A.ldlse = 0; A.nt = len / 64; A.kb0 = 0; A.L = len; A.biasG = nullptr;
    A.C = 0.07216878364870322f * 1.4426950408889634f; A.thr = 8.f / 0.07216878364870322f;
    at::attn_body<12, false, 1536, 2048, 2048>(A, lds);
  }
}

template <class Epi>
__device__ __forceinline__ void gemm_simple(unsigned char* lds, const pg8::Gemm g, const pg8::StaticOrder& S, const Epi& E) {
  using namespace pg8;
  const int tid = tidx(), wid = tid >> 6, lane = tid & 63, wr = wid >> 2, wc = wid & 3, fr = lane & 15, fq = lane >> 4;
  const int K = g.K, nt = K / BK;
  unsigned offA[2], offB[2];
#pragma unroll
  for (int i = 0; i < 2; ++i) { int R, C; stage_rc(tid * 16 + i * 8192, R, C); const int Rb = Epi::PERM ? ((R & ~31) + perm32(R & 31)) : R;
    offA[i] = (unsigned)(R * K + C); offB[i] = (unsigned)(Rb * K + C); }
  const int aoff = lds_byte(wr * 64 + fr, fq * 8), boff = lds_byte(wc * 32 + fr, fq * 8);
  unsigned char* myst = lds + tid * 16;
  Unit u;
  for (int ui = 0; S.next(ui, u); ++ui) {
    f32x4 acc[2][2][4][2];
#pragma unroll
    for (int a = 0; a < 2; ++a)
#pragma unroll
      for (int b = 0; b < 2; ++b)
#pragma unroll
        for (int m = 0; m < 4; ++m)
#pragma unroll
          for (int n = 0; n < 2; ++n) acc[a][b][m][n] = (f32x4){0.f, 0.f, 0.f, 0.f};
    const bf16_t* Ab = g.A + (size_t)u.pm * 256 * K; const bf16_t* Bb = g.Bt + (size_t)u.pn * 256 * K;
    const size_t hK = (size_t)128 * K;
    bf16x8 sg[2][2];
#define GLOADX(P, off, kt) do { _Pragma("unroll") for (int h = 0; h < 2; ++h) _Pragma("unroll") for (int i = 0; i < 2; ++i) \
      sg[h][i] = *(const bf16x8*)((P) + h * hK + (off)[i] + (size_t)(kt) * BK); } while (0)
#define SWRITEX(base, b) do { _Pragma("unroll") for (int h = 0; h < 2; ++h) _Pragma("unroll") for (int i = 0; i < 2; ++i) \
      *(bf16x8*)(myst + ((base) + (b) * 2 + h) * HTB + i * 8192) = sg[h][i]; } while (0)
    GLOADX(Ab, offA, 0); SWRITEX(0, 0); GLOADX(Bb, offB, 0); SWRITEX(4, 0); __syncthreads();
    for (int kt = 0; kt < nt; ++kt) {
      const int b = kt & 1; const bool more = kt + 1 < nt;
#pragma unroll
      for (int k = 0; k < 2; ++k) {
        if (more) { if (k == 0) GLOADX(Ab, offA, kt + 1); else GLOADX(Bb, offB, kt + 1); }
        __builtin_amdgcn_sched_barrier(0);
        bf16x8 B0[2], B1[2];
#pragma unroll
        for (int n = 0; n < 2; ++n) { B0[n] = *(const bf16x8*)(lds + (4 + b * 2 + 0) * HTB + boff + n * 2048 + k * 1024); B1[n] = *(const bf16x8*)(lds + (4 + b * 2 + 1) * HTB + boff + n * 2048 + k * 1024); }
#pragma unroll
        for (int ai = 0; ai < 2; ++ai) {
#pragma unroll
          for (int m = 0; m < 4; ++m) {
            const bf16x8 At = *(const bf16x8*)(lds + (b * 2 + ai) * HTB + aoff + m * 2048 + k * 1024);
#pragma unroll
            for (int n = 0; n < 2; ++n) {
              acc[ai][0][m][n] = __builtin_amdgcn_mfma_f32_16x16x32_bf16(B0[n], At, acc[ai][0][m][n], 0, 0, 0);
              acc[ai][1][m][n] = __builtin_amdgcn_mfma_f32_16x16x32_bf16(B1[n], At, acc[ai][1][m][n], 0, 0, 0); }
          }
          __builtin_amdgcn_sched_barrier(0);
        }
        if (more) { if (k == 0) SWRITEX(0, b ^ 1); else SWRITEX(4, b ^ 1); }
      }
      __syncthreads();
    }
#undef GLOADX
#undef SWRITEX
    E(acc, u, wr, wc, fr, fq);
  }
}
template <class Epi> __device__ __forceinline__ void run_gemm(unsigned char* lds, const bf16_t* A, const bf16_t* Bt, int N, int K, const Epi& E) {
  pg8::Gemm g{A, Bt, T, N, K}; pg8::StaticOrder S; S.init(T, N, (int)gridDim.x, (int)blockIdx.x);
  gemm_simple<Epi>(lds, g, S, E);
  __syncthreads();
}

__device__ __forceinline__ Params ldp() { auto k = __builtin_amdgcn_kernarg_segment_ptr(); asm volatile("" : "+s"(k)); Params q; __builtin_memcpy(&q, k, sizeof(Params)); return q; }
__device__ __forceinline__ void gbar(unsigned* ctr, unsigned target) {
  __syncthreads();
  if (threadIdx.x == 0) {
    __threadfence();
    __hip_atomic_fetch_add(ctr, 1u, __ATOMIC_RELEASE, __HIP_MEMORY_SCOPE_AGENT);
    while (__hip_atomic_load(ctr, __ATOMIC_ACQUIRE, __HIP_MEMORY_SCOPE_AGENT) < target) __builtin_amdgcn_s_sleep(2);
    __threadfence();
  }
  __syncthreads();
}
#define PHASE(...) do { if (ph >= pk.ph_lo && ph < pk.ph_hi) { const Params p = ldp(); unsigned char* ws = p.ws; WSPTRS; __VA_ARGS__; } ++ph; \
    if (ph > pk.ph_lo && ph < pk.ph_hi) { gbar((unsigned*)(pk.ws + WS_END), (unsigned)ph * gridDim.x); grid.sync(); } } while (0)
#define WSPTRS bf16_t* WM = (bf16_t*)(ws + O_WM); bf16_t* WF = (bf16_t*)(ws + O_RF); \
  float* rinv = (float*)(ws + S_RINV); float* rinvq = (float*)(ws + S_RINVQ); float* rinvkv = (float*)(ws + S_RINVKV); \
  const float* cs = (const float*)(ws + S_COS); const float* sn = (const float*)(ws + S_SIN); \
  float* mix = (float*)(ws + O_RA); bf16_t* xb = (bf16_t*)(ws + O_RC); bf16_t* act = (bf16_t*)(ws + O_RD); \
  const int i = layer >> 1; const float* ng = p.norm_g + (size_t)layer * 4 * DM; const float* mu = p.mu + (size_t)i * 6 * DM; \
  bf16_t* cq = (bf16_t*)(ws + O_RA); bf16_t* ckv = cq + (size_t)T * 512; bf16_t* kr = cq + (size_t)T * 1024; \
  bf16_t* qb = (bf16_t*)(ws + O_RD); bf16_t* kb = qb + (size_t)T * 1024; bf16_t* vb = kb + (size_t)T * 1024; \
  bf16_t* Qp = (bf16_t*)(ws + O_RB); bf16_t* kv = (bf16_t*)(ws + O_RH); bf16_t* cat = (bf16_t*)(ws + O_RF); \
  bf16_t* m0 = (bf16_t*)(ws + O_RD); bf16_t* m1 = (bf16_t*)(ws + O_RE); bf16_t* m2 = (bf16_t*)(ws + O_RX); \
  bf16_t* rB = (bf16_t*)(ws + O_RA); bf16_t* kB = (bf16_t*)(ws + O_RB); bf16_t* vB = (bf16_t*)(ws + O_RC); \
  bf16_t* gl = (bf16_t*)(ws + S_GL); bf16_t* wl = (bf16_t*)(ws + S_WL); bf16_t* al = (bf16_t*)(ws + S_AL); \
  bf16_t* eB = (bf16_t*)(ws + O_RD); bf16_t* aB = (bf16_t*)(ws + O_RX); bf16_t* gB = (bf16_t*)(ws + O_RD); bf16_t* yg = (bf16_t*)(ws + O_RH); \
  (void)WM; (void)WF; (void)rinv; (void)rinvq; (void)rinvkv; (void)cs; (void)sn; (void)mix; (void)xb; (void)act; (void)i; (void)ng; (void)mu; (void)cq; (void)ckv; (void)kr; (void)qb; (void)kb; (void)vb; \
  (void)Qp; (void)kv; (void)cat; (void)m0; (void)m1; (void)m2; (void)rB; (void)kB; (void)vB; (void)gl; (void)wl; (void)al; (void)eB; (void)aB; (void)gB; (void)yg
template <int layer> __device__ __forceinline__ void layer_fn(const Params& pk, unsigned char* lds, cg::grid_group& grid, int& ph) {
    if constexpr ((layer & 1) == 0) {
      PHASE(pg8::EpiIn E{cq, ckv, qb, kb, vb, kr, rinv, cs, sn}; run_gemm(lds, xb, WM + WA_IN, 4352, 2048, E));
      PHASE(rownorm_phase(p); dilated_phase(p, (char*)lds));
      PHASE(pg8::EpiUQ E1{Qp, rinvq, cs, sn}; run_gemm(lds, cq, WM + WA_UQ, 1536, 512, E1);
            pg8::EpiB<0> E2{kv, 2048, nullptr, rinvkv}; run_gemm(lds, ckv, WM + WA_UKV, 2048, 512, E2));
      PHASE(mla_phase(p, (char*)lds); combine_phase(p));
      PHASE(pg8::EpiF32 E{mix, 2048}; run_gemm(lds, cat, WM + WA_OUT, 2048, 2048, E));
    } else {
      PHASE(mix_phase(p, ng, mu, 1, 4, 5));
      PHASE(pg8::EpiB<2> E1{wl, 256, nullptr, nullptr}; run_gemm(lds, m0, WM + WR_W1, 256, 2048, E1);
            pg8::EpiB<0> E2{al, 256, nullptr, nullptr}; run_gemm(lds, m1, WM + WR_A1, 256, 2048, E2));
      PHASE(pg8::EpiB<1> E3{gl, 256, nullptr, nullptr}; run_gemm(lds, m2, WM + WR_G1, 256, 2048, E3));
      PHASE(mix_phase(p, ng, mu, 0, 2, 3));
      PHASE(pg8::EpiB<0> E1{rB, 2048, nullptr, nullptr}; run_gemm(lds, m0, WM + WR_R, 2048, 2048, E1);
            pg8::EpiB<0> E2{kB, 2048, nullptr, nullptr}; run_gemm(lds, m1, WM + WR_K, 2048, 2048, E2);
            pg8::EpiB<0> E3{vB, 2048, nullptr, nullptr}; run_gemm(lds, m2, WM + WR_V, 2048, 2048, E3));
      PHASE(pg8::EpiB<0> E1{eB, 4096, nullptr, nullptr}; run_gemm(lds, wl, WM + WR_W2, 4096, 256, E1);
            pg8::EpiB<0> E2{aB, 4096, nullptr, nullptr}; run_gemm(lds, al, WM + WR_A2, 4096, 256, E2));
      PHASE(scan_phase(p, i, lds));
      PHASE(pg8::EpiB<0> E{gB, 2048, nullptr, nullptr}; run_gemm(lds, gl, WM + WR_G2, 2048, 256, E));
      PHASE(postscan_phase(p, i));
      PHASE(pg8::EpiF32 E{mix, 2048}; run_gemm(lds, yg, WM + WR_O, 2048, 2048, E));
    }
    PHASE(resid_phase(p, mix, ng + DM); convert_ffn_weights(p, layer, (float*)lds));
    PHASE(pg8::EpiSwi E{act, rinv}; run_gemm(lds, xb, WF + WF_GU, 11264, 2048, E));
    PHASE(pg8::EpiF32 E{mix, 2048}; run_gemm(lds, act, WF + WF_DN, 2048, 5632, E));
    PHASE(resid_phase(p, mix, ng + 3 * DM); if (layer < 3) convert_mixer_weights(p, layer + 1, (float*)lds));
  }
__global__ void __launch_bounds__(512, 2) mega(Params pk) {
  constexpr int layer = 0;
  extern __shared__ __attribute__((aligned(16))) unsigned char lds[];
  cg::grid_group grid = cg::this_grid();
  int ph = 0;
  PHASE(resid_phase(p, nullptr, nullptr); tables_phase(p); convert_mixer_weights(p, 0, (float*)lds));
  layer_fn<0>(pk, lds, grid, ph); layer_fn<1>(pk, lds, grid, ph); layer_fn<2>(pk, lds, grid, ph); layer_fn<3>(pk, lds, grid, ph);
}
#undef PHASE
#undef WSPTRS

extern "C" void kernel_launch(void* const* d_in, const int* in_sizes, int n_in, void* d_out, int out_size, void* d_ws, size_t ws_size, hipStream_t stream) {
  static int grid_blocks = 0;
  if (!grid_blocks) {
    int dev = 0, cus = 0, per_cu = 0;
    (void)hipGetDevice(&dev);
    (void)hipDeviceGetAttribute(&cus, hipDeviceAttributeMultiprocessorCount, dev);
    (void)hipFuncSetAttribute((const void*)mega, hipFuncAttributeMaxDynamicSharedMemorySize, LDS_BYTES);
    (void)hipOccupancyMaxActiveBlocksPerMultiprocessor(&per_cu, mega, 512, LDS_BYTES);
    if (per_cu < 1) { fprintf(stderr, "occupancy query returned %d\n", per_cu); per_cu = 1; }
    grid_blocks = cus;
  }
  if (n_in != 31 || ws_size < WS_END + 256) { fprintf(stderr, "kernel_launch: unexpected n_in %d / ws_size %zu\n", n_in, ws_size); return; }
  Params p{};
  const float** f = (const float**)&p;
  for (int k = 0; k < 31; ++k) f[k] = (const float*)d_in[k];
  p.out = (float*)d_out; p.ws = (unsigned char*)d_ws; p.ph_lo = 0; p.ph_hi = 1000;
#ifdef MULTI_LAUNCH
  for (int ph = 0; ph < NPH_RUN; ++ph) { p.ph_lo = ph; p.ph_hi = ph + 1; hipLaunchKernelGGL(mega, dim3(grid_blocks), dim3(512), LDS_BYTES, stream, p); }
#else
  (void)hipMemsetAsync((unsigned char*)d_ws + WS_END, 0, 256, stream);
  void* args[] = {&p};
  hipError_t e = hipLaunchCooperativeKernel((void*)mega, dim3(grid_blocks), dim3(512), args, LDS_BYTES, stream);
  if (e != hipSuccess) fprintf(stderr, "cooperative launch failed: %s (grid %d)\n", hipGetErrorString(e), grid_blocks);
#endif
}
```

```cpp
#include <hip/hip_runtime.h>
#include <hip/hip_cooperative_groups.h>
#include <cstdio>
#include <cstdint>
namespace cg = cooperative_groups;
__device__ __forceinline__ int tidx() { int t = threadIdx.x; asm volatile("" : "+v"(t)); return t; }
namespace pg8 {
#define PG8_LAS __attribute__((address_space(3)))
typedef unsigned short bf16_t;
typedef short bf16x8 __attribute__((ext_vector_type(8)));
typedef float f32x4 __attribute__((ext_vector_type(4)));
typedef unsigned u32x4 __attribute__((ext_vector_type(4)));
constexpr int BM = 256, BK = 64, HALF = 128, HTB = HALF * BK * 2  , STAGE_BYTES = 8 * HTB, NXCD = 8, WGM = 8;

__host__ __device__ __forceinline__ int lds_byte(int r, int c) { const int st = (r >> 4) * 2 + (c >> 5), rr = r & 15, cc = c & 31, ob = rr * 64 + cc * 2; return st * 1024 + (ob ^ (((ob >> 9) & 1) << 5)); }
__host__ __device__ __forceinline__ void stage_rc(int b, int& R, int& C) { const int st = b / 1024, sb = b % 1024, swz = sb ^ (((sb >> 9) & 1) << 5); R = (st >> 1) * 16 + swz / 64; C = (st & 1) * 32 + (swz % 64) / 2; }
__host__ __device__ __forceinline__ int perm32(int rho) { const int n = rho >> 4, i = rho & 15; return 8 * (i >> 2) + 4 * n + (i & 3); }

struct Unit { int pm, pn; };
struct Gemm { const bf16_t* A; const bf16_t* Bt; int M, N, K; };

struct StaticOrder {
    int nM, nN, nwg, G, c;
    __host__ __device__ void init(int M, int N, int G_, int c_) { nM = M / BM; nN = N / BM; nwg = nM * nN; G = G_; c = c_; }
    __host__ __device__ bool next(int i, Unit& u) const {
        const long L = (long)i * G + c; if (L >= nwg) return false;
        int wgid = (int)L; { const int q = nwg / NXCD, r = nwg % NXCD, xcd = wgid % NXCD, off = wgid / NXCD; wgid = (xcd < r ? xcd * (q + 1) : r * (q + 1) + (xcd - r) * q) + off; }
        const int nig = WGM * nN, gid = wgid / nig, fm = gid * WGM, gsz = (nM - fm) < WGM ? (nM - fm) : WGM;
        u.pm = fm + ((wgid % nig) % gsz); u.pn = (wgid % nig) / gsz; return true;
    }
    __device__ __forceinline__ void a_ready(const Unit&) const {}
    __device__ __forceinline__ void done(const Unit&) const {}
};
__device__ __forceinline__ unsigned cvt_pk_bf16(float lo, float hi) { unsigned r; asm volatile("v_cvt_pk_bf16_f32 %0, %1, %2" : "=v"(r) : "v"(lo), "v"(hi)); return r; }
typedef float f32x2 __attribute__((ext_vector_type(2)));
template <class Epi, class Sched, bool STAMP = false>
__device__ __forceinline__ void gemm_phase(PG8_LAS unsigned char* lds, const Gemm g, const Sched& S, const Epi& E, unsigned long long* stamps) {
    const int tid = tidx(), wid = __builtin_amdgcn_readfirstlane(tid >> 6), lane = tid & 63, wr = wid >> 2, wc = wid & 3, fr = lane & 15, fq = lane >> 4;
    const int K = g.K, nt = K / BK;
    int ts_lo = 0, ts_hi = 0, nts = 0; const unsigned long long rt_entry = STAMP ? (unsigned long long)wall_clock64() : 0ull;
#define PG8_STAMP() do { if (STAMP && wid == 0 && nts < 64) { const unsigned long long _c = (unsigned long long)clock64(); \
        ts_lo = (lane == nts) ? (int)(unsigned)_c : ts_lo; ts_hi = (lane == nts) ? (int)(unsigned)(_c >> 32) : ts_hi; ++nts; } } while (0)
    PG8_STAMP();
    unsigned voffA[2], voffB[2];
#pragma unroll
    for (int i = 0; i < 2; ++i) { int R, C; stage_rc(tid * 16 + i * 8192, R, C); const int Rb = Epi::PERM ? ((R & ~31) + perm32(R & 31)) : R;
        voffA[i] = (unsigned)(R * K + C) * 2u; voffB[i] = (unsigned)(Rb * K + C) * 2u; }
    const size_t kstep = (size_t)(BK * 2);
    const size_t hstep = (size_t)HALF * K * 2;
    const size_t tstep = 2 * hstep;
    const unsigned ldsw = (unsigned)wid * 1024u;
    const int aoff = lds_byte(wr * 64 + fr, fq * 8), boff = lds_byte(wc * 32 + fr, fq * 8);
#define PG8_SA(b, h) (((b) * 2 + (h)) * HTB)
#define PG8_SB(b, h) ((4 + (b) * 2 + (h)) * HTB)
#define PG8_STAGE(bufoff, gbase, voff) do { _Pragma("unroll") for (int _i = 0; _i < 2; ++_i) \
        __builtin_amdgcn_global_load_lds((const unsigned*)((const char*)(gbase) + (voff)[_i]), (PG8_LAS unsigned*)(lds + (bufoff) + ldsw + _i * 8192), 16, 0, 0); } while (0)
#define PG8_LDA(dst, b, h) do { _Pragma("unroll") for (int m = 0; m < 4; ++m) _Pragma("unroll") for (int k = 0; k < 2; ++k) dst[m][k] = *(const PG8_LAS bf16x8*)(lds + PG8_SA(b, h) + aoff + m * 2048 + k * 1024); } while (0)
#define PG8_LDB(dst, b, h) do { _Pragma("unroll") for (int n = 0; n < 2; ++n) _Pragma("unroll") for (int k = 0; k < 2; ++k) dst[n][k] = *(const PG8_LAS bf16x8*)(lds + PG8_SB(b, h) + boff + n * 2048 + k * 1024); } while (0)
#define PG8_MMA(ai, bj, At, Bt) do { __builtin_amdgcn_s_setprio(1); _Pragma("unroll") for (int m = 0; m < 4; ++m) _Pragma("unroll") for (int n = 0; n < 2; ++n) _Pragma("unroll") for (int k = 0; k < 2; ++k) \
        acc[ai][bj][m][n] = __builtin_amdgcn_mfma_f32_16x16x32_bf16(Bt[n][k], At[m][k], acc[ai][bj][m][n], 0, 0, 0); __builtin_amdgcn_s_setprio(0); } while (0)
#define PG8_WAIT_V(n) asm volatile("s_waitcnt vmcnt(" #n ")" ::: "memory")
#define PG8_WAIT_L(n) asm volatile("s_waitcnt lgkmcnt(" #n ")" ::: "memory")
#define PG8_BAR __builtin_amdgcn_s_barrier()
#define PG8_SCHED __builtin_amdgcn_sched_barrier(0)
    Unit cur, nxt; int ui = 0;
    if (!S.next(0, cur)) return;
    f32x4 acc[2][2][4][2];
#pragma unroll
    for (int a = 0; a < 2; ++a)
#pragma unroll
        for (int b = 0; b < 2; ++b)
#pragma unroll
            for (int m = 0; m < 4; ++m)
#pragma unroll
                for (int n = 0; n < 2; ++n) acc[a][b][m][n] = (f32x4){0.f, 0.f, 0.f, 0.f};
    bf16x8 At[4][2], B0[2][2], B1[2][2];
    const char* cA = (const char*)g.A + (size_t)cur.pm * tstep; const char* cB = (const char*)g.Bt + (size_t)cur.pn * tstep;
    S.a_ready(cur);
    PG8_STAGE(PG8_SB(0, 0), cB, voffB); PG8_STAGE(PG8_SA(0, 0), cA, voffA); PG8_STAGE(PG8_SB(0, 1), cB + hstep, voffB); PG8_STAGE(PG8_SA(0, 1), cA + hstep, voffA);
    if (wr == 1) PG8_BAR;
    PG8_WAIT_V(4); PG8_BAR;
    PG8_STAGE(PG8_SB(1, 0), cB + kstep, voffB); PG8_STAGE(PG8_SA(1, 0), cA + kstep, voffA); PG8_STAGE(PG8_SB(1, 1), cB + hstep + kstep, voffB);
    PG8_WAIT_V(6); PG8_BAR;
    PG8_STAMP();
    for (;;) {
        const bool has_next = S.next(ui + 1, nxt);
        const char* nA = has_next ? (const char*)g.A + (size_t)nxt.pm * tstep : cA; const char* nB = has_next ? (const char*)g.Bt + (size_t)nxt.pn * tstep : cB;
        for (int t = 0; t < nt; t += 2) {
            const bool last = (t == nt - 2);
            const char* a1 = cA + (size_t)(t + 1) * kstep;
            const char* a2 = last ? nA : cA + (size_t)(t + 2) * kstep; const char* b2 = last ? nB : cB + (size_t)(t + 2) * kstep;
            const char* a3 = a2 + kstep; const char* b3 = b2 + kstep;
            if (last && has_next) S.a_ready(nxt);
            PG8_LDB(B0, 0, 0); PG8_SCHED; PG8_LDA(At, 0, 0); PG8_STAGE(PG8_SA(1, 1), a1 + hstep, voffA);
            PG8_WAIT_L(8); PG8_BAR; PG8_WAIT_L(0); PG8_MMA(0, 0, At, B0); PG8_BAR; PG8_SCHED;
            PG8_LDB(B1, 0, 1); PG8_STAGE(PG8_SB(0, 0), b2, voffB);
            PG8_BAR; PG8_WAIT_L(0); PG8_MMA(0, 1, At, B1); PG8_BAR;
            PG8_LDA(At, 0, 1); PG8_STAGE(PG8_SA(0, 0), a2, voffA);
            PG8_BAR; PG8_WAIT_L(0); PG8_MMA(1, 0, At, B0); PG8_BAR; PG8_SCHED;
            PG8_STAGE(PG8_SB(0, 1), b2 + hstep, voffB);
            PG8_WAIT_V(6); PG8_BAR; PG8_MMA(1, 1, At, B1); PG8_BAR;
            PG8_LDB(B0, 1, 0); PG8_SCHED; PG8_LDA(At, 1, 0); PG8_STAGE(PG8_SA(0, 1), a2 + hstep, voffA);
            PG8_WAIT_L(8); PG8_BAR; PG8_WAIT_L(0); PG8_MMA(0, 0, At, B0); PG8_BAR; PG8_SCHED;
            PG8_LDB(B1, 1, 1); PG8_STAGE(PG8_SB(1, 0), b3, voffB);
            PG8_BAR; PG8_WAIT_L(0); PG8_MMA(0, 1, At, B1); PG8_BAR;
            PG8_LDA(At, 1, 1); PG8_STAGE(PG8_SA(1, 0), a3, voffA);
            PG8_BAR; PG8_WAIT_L(0); PG8_MMA(1, 0, At, B0); PG8_BAR; PG8_SCHED;
            PG8_STAGE(PG8_SB(1, 1), b3 + hstep, voffB);
            PG8_WAIT_V(6); PG8_BAR; PG8_MMA(1, 1, At, B1); PG8_BAR;
        }
        PG8_STAMP();
        if constexpr (!Epi::AFTER_DRAIN) { E(acc, cur, wr, wc, fr, fq); S.done(cur); }
        PG8_STAMP();
        if (!has_next) break;
#pragma unroll
        for (int a = 0; a < 2; ++a)
#pragma unroll
            for (int b = 0; b < 2; ++b)
#pragma unroll
                for (int m = 0; m < 4; ++m)
#pragma unroll
                    for (int n = 0; n < 2; ++n) acc[a][b][m][n] = (f32x4){0.f, 0.f, 0.f, 0.f};
        cur = nxt; cA = nA; cB = nB; ++ui;
    }
    PG8_WAIT_V(0);
    if (wr == 0) PG8_BAR;
    PG8_BAR;
    if constexpr (Epi::AFTER_DRAIN) { E.fused(acc, cur, wr, wc, fr, fq, lds, wid, lane); S.done(cur); }
    PG8_STAMP();
    if (STAMP && wid == 0) { stamps[lane] = lane < nts ? (((unsigned long long)(unsigned)ts_hi << 32) | (unsigned)ts_lo) : 0ull;
        if (lane == 62) stamps[62] = rt_entry; if (lane == 63) stamps[63] = (unsigned long long)wall_clock64(); }
#undef PG8_STAMP
#undef PG8_SA
#undef PG8_SB
#undef PG8_STAGE
#undef PG8_LDA
#undef PG8_LDB
#undef PG8_MMA
#undef PG8_WAIT_V
#undef PG8_WAIT_L
#undef PG8_BAR
#undef PG8_SCHED
}
}
namespace pg8 {
__device__ __forceinline__ float fsig(float x) { return __builtin_amdgcn_rcpf(1.f + __expf(-x)); }
__device__ __forceinline__ float ftanh(float x) { return 1.f - 2.f * __builtin_amdgcn_rcpf(1.f + __expf(2.f * x)); }
__device__ __forceinline__ int seq_start(int t) { return t < 4096 ? 0 : (t < 8192 ? 4096 : 8192); }

struct EpiF32 {
    static constexpr bool PERM = false, AFTER_DRAIN = false;
    float* C; int ldc;
    __device__ __forceinline__ void operator()(const f32x4 (&acc)[2][2][4][2], const Unit& u, int wr, int wc, int fr, int fq) const {
        const int row0 = u.pm * BM + wr * 64 + fr, col0 = u.pn * BM + wc * 32 + 4 * fq;
#pragma unroll
        for (int ai = 0; ai < 2; ++ai)
#pragma unroll
            for (int m = 0; m < 4; ++m) { float* rowp = C + (size_t)(row0 + ai * HALF + m * 16) * ldc + col0;
#pragma unroll
                for (int bj = 0; bj < 2; ++bj)
#pragma unroll
                    for (int n = 0; n < 2; ++n) *(f32x4*)(rowp + bj * HALF + n * 16) = acc[ai][bj][m][n]; }
    }
};
template <int ACT> struct EpiB {
    static constexpr bool PERM = true, AFTER_DRAIN = false;
    bf16_t* O; int ldc; const float* bias; const float* rs;
    __device__ __forceinline__ f32x4 actf(f32x4 v) const {
#pragma unroll
        for (int j = 0; j < 4; ++j) {
            if (ACT == 1) v[j] = 0.5f + 0.5f * ftanh(0.5f * v[j]);
            if (ACT == 2) v[j] = ftanh(v[j]);
            if (ACT == 3) v[j] = 0.6065306597f * fsig(v[j]); }
        return v; }
    __device__ __forceinline__ void operator()(const f32x4 (&acc)[2][2][4][2], const Unit& u, int wr, int wc, int fr, int fq) const {
        const int row0 = u.pm * BM + wr * 64 + fr; const int col0 = u.pn * BM + wc * 32 + 8 * fq;
#pragma unroll
        for (int bj = 0; bj < 2; ++bj) {
#pragma unroll
            for (int ai = 0; ai < 2; ++ai)
#pragma unroll
                for (int m = 0; m < 4; ++m) { const int row = row0 + ai * HALF + m * 16; const float s = rs ? rs[row] : 1.f;
                    f32x4 v0 = acc[ai][bj][m][0] * s; if (bias) v0 += *(const f32x4*)(bias + col0 + bj * HALF); v0 = actf(v0);
                    u32x4 w; w.x = cvt_pk_bf16(v0[0], v0[1]); w.y = cvt_pk_bf16(v0[2], v0[3]);
                    f32x4 v1 = acc[ai][bj][m][1] * s; if (bias) v1 += *(const f32x4*)(bias + col0 + bj * HALF + 4); v1 = actf(v1);
                    w.z = cvt_pk_bf16(v1[0], v1[1]); w.w = cvt_pk_bf16(v1[2], v1[3]);
                    *(u32x4*)(O + (size_t)row * ldc + col0 + bj * HALF) = w; __builtin_amdgcn_sched_barrier(0); } }
    }
};
struct EpiIn {
    static constexpr bool PERM = true, AFTER_DRAIN = false;
    bf16_t *cq, *ckv, *qb, *kb, *vb, *kr; const float* rs; const float* cs; const float* sn;
    __device__ __forceinline__ void operator()(const f32x4 (&acc)[2][2][4][2], const Unit& u, int wr, int wc, int fr, int fq) const {
        const int row0 = u.pm * BM + wr * 64 + fr; const int pn = u.pn;
        if (pn < 16) {
            bf16_t* base; int ldc, colt;
            if (pn < 2) { base = cq; ldc = 512; colt = pn * 256; } else if (pn < 4) { base = ckv; ldc = 512; colt = (pn - 2) * 256; }
            else if (pn < 8) { base = qb; ldc = 1024; colt = (pn - 4) * 256; } else if (pn < 12) { base = kb; ldc = 1024; colt = (pn - 8) * 256; }
            else { base = vb; ldc = 1024; colt = (pn - 12) * 256; }
            const int col0 = colt + wc * 32 + 8 * fq;
#pragma unroll
            for (int ai = 0; ai < 2; ++ai)
#pragma unroll
                for (int m = 0; m < 4; ++m) { const int row = row0 + ai * HALF + m * 16; const float s = rs[row];
                    bf16_t* rowp = base + (size_t)row * ldc + col0;
#pragma unroll
                    for (int bj = 0; bj < 2; ++bj) { const f32x4 v0 = acc[ai][bj][m][0] * s, v1 = acc[ai][bj][m][1] * s;
                        u32x4 w; w.x = cvt_pk_bf16(v0[0], v0[1]); w.y = cvt_pk_bf16(v0[2], v0[3]); w.z = cvt_pk_bf16(v1[0], v1[1]); w.w = cvt_pk_bf16(v1[2], v1[3]);
                        *(u32x4*)(rowp + bj * HALF) = w; } }
        } else if (wc < 2) {
            const int q = wc * 4 + fq;
#pragma unroll
            for (int ai = 0; ai < 2; ++ai)
#pragma unroll
                for (int m = 0; m < 4; ++m) { const int row = row0 + ai * HALF + m * 16; const float s = rs[row]; const int pos = row - seq_start(row);
                    const f32x4 c = *(const f32x4*)(cs + (size_t)pos * 32 + 4 * q), sv = *(const f32x4*)(sn + (size_t)pos * 32 + 4 * q);
                    const f32x4 x1 = acc[ai][0][m][0] * s, x2 = acc[ai][0][m][1] * s;
                    const f32x4 y1 = x1 * c - x2 * sv, y2 = x2 * c + x1 * sv;
                    u32x4 w; w.x = cvt_pk_bf16(y1[0], y1[1]); w.y = cvt_pk_bf16(y1[2], y1[3]); w.z = cvt_pk_bf16(y2[0], y2[1]); w.w = cvt_pk_bf16(y2[2], y2[3]);
                    *(u32x4*)(kr + (size_t)row * 64 + 8 * q) = w; }
        }
    }
};
struct EpiUQ {
    static constexpr bool PERM = true, AFTER_DRAIN = false;
    bf16_t* O; const float* rs; const float* cs; const float* sn;
    __device__ __forceinline__ void operator()(const f32x4 (&acc)[2][2][4][2], const Unit& u, int wr, int wc, int fr, int fq) const {
        const int row0 = u.pm * BM + wr * 64 + fr; const int col0 = u.pn * BM + wc * 32 + 8 * fq;
        const int q = (wc & 1) * 4 + fq;
#pragma unroll
        for (int ai = 0; ai < 2; ++ai)
#pragma unroll
            for (int m = 0; m < 4; ++m) { const int row = row0 + ai * HALF + m * 16; const float s = rs[row]; const int pos = row - seq_start(row);
                bf16_t* rowp = O + (size_t)row * 1536 + col0;
#pragma unroll
                for (int bj = 0; bj < 2; ++bj) { f32x4 v0 = acc[ai][bj][m][0] * s, v1 = acc[ai][bj][m][1] * s;
                    const int blk = u.pn * 4 + bj * 2 + (wc >> 1);
                    if (blk % 3 == 2) {
                        const f32x4 c = *(const f32x4*)(cs + (size_t)pos * 32 + 4 * q), sv = *(const f32x4*)(sn + (size_t)pos * 32 + 4 * q);
                        const f32x4 y1 = v0 * c - v1 * sv, y2 = v1 * c + v0 * sv; v0 = y1; v1 = y2; }
                    u32x4 w; w.x = cvt_pk_bf16(v0[0], v0[1]); w.y = cvt_pk_bf16(v0[2], v0[3]); w.z = cvt_pk_bf16(v1[0], v1[1]); w.w = cvt_pk_bf16(v1[2], v1[3]);
                    *(u32x4*)(rowp + bj * HALF) = w; } __builtin_amdgcn_sched_barrier(0); }
    }
};
struct EpiSwi {
    static constexpr bool PERM = true, AFTER_DRAIN = false;
    bf16_t* O; const float* rs;
    __device__ __forceinline__ void operator()(const f32x4 (&acc)[2][2][4][2], const Unit& u, int wr, int wc, int fr, int fq) const {
        const int row0 = u.pm * BM + wr * 64 + fr; const int col0 = u.pn * 128 + wc * 16 + 4 * fq;
#pragma unroll
        for (int ai = 0; ai < 2; ++ai)
#pragma unroll
            for (int m = 0; m < 4; ++m) { const int row = row0 + ai * HALF + m * 16; const float s = rs[row];
                bf16_t* rowp = O + (size_t)row * 5632 + col0;
#pragma unroll
                for (int bj = 0; bj < 2; ++bj) { const f32x4 g = acc[ai][bj][m][0] * s, up = acc[ai][bj][m][1] * s; f32x4 o;
#pragma unroll
                    for (int j = 0; j < 4; ++j) o[j] = g[j] * fsig(g[j]) * up[j];
                    uint2 w; w.x = cvt_pk_bf16(o[0], o[1]); w.y = cvt_pk_bf16(o[2], o[3]);
                    *(uint2*)(rowp + bj * 64) = w; } }
    }
};
}

namespace pg8 {
struct LoraOrder {
    int c;
    __device__ bool next(int i, Unit& u) const { if (c >= 144 || i >= 2) return false; const int id = c * 2 + i; u.pm = id; u.pn = id / 96; return true; }
    __device__ __forceinline__ void a_ready(const Unit&) const {}
    __device__ __forceinline__ void done(const Unit&) const {}
};
struct EpiLora {
    static constexpr bool PERM = true, AFTER_DRAIN = false;
    bf16_t *wl, *al, *gl;
    __device__ __forceinline__ void operator()(const f32x4 (&acc)[2][2][4][2], const Unit& u, int wr, int wc, int fr, int fq) const {
        const int pn = u.pn; bf16_t* base = pn == 0 ? wl : (pn == 1 ? al : gl);
        const int row0 = u.pm * BM - pn * 24576 + wr * 64 + fr; const int col0 = wc * 32 + 8 * fq;
        const float sc = pn == 2 ? 0.5f : 1.f, ka = pn == 2 ? 0.5f : 1.f, kb = pn == 2 ? 0.5f : 0.f;
#pragma unroll
        for (int bj = 0; bj < 2; ++bj)
#pragma unroll
            for (int ai = 0; ai < 2; ++ai)
#pragma unroll
                for (int m = 0; m < 4; ++m) { const int row = row0 + ai * HALF + m * 16;
                    f32x4 v0 = acc[ai][bj][m][0], v1 = acc[ai][bj][m][1];
#pragma unroll
                    for (int j = 0; j < 4; ++j) { const float t0 = kb + ka * ftanh(v0[j] * sc), t1 = kb + ka * ftanh(v1[j] * sc); v0[j] = pn == 1 ? v0[j] : t0; v1[j] = pn == 1 ? v1[j] : t1; }
                    u32x4 w; w.x = cvt_pk_bf16(v0[0], v0[1]); w.y = cvt_pk_bf16(v0[2], v0[3]); w.z = cvt_pk_bf16(v1[0], v1[1]); w.w = cvt_pk_bf16(v1[2], v1[3]);
                    *(u32x4*)(base + (size_t)row * 256 + col0 + bj * HALF) = w; __builtin_amdgcn_sched_barrier(0); }
    }
};
}
namespace at {
using pg8::bf16_t; using pg8::bf16x8; using pg8::u32x4;
typedef short s16x4 __attribute__((ext_vector_type(4)));
typedef float f32x16 __attribute__((ext_vector_type(16)));
constexpr int NW = 8, QBLK = 32, KVBLK = 64;
constexpr int SHM_V = KVBLK * 128 * 2, SHM_K = KVBLK * 128 * 2, SHM_R = KVBLK * 64 * 2;
constexpr int OFF_V = 0, OFF_K = 2 * SHM_V, OFF_R = OFF_K + 2 * SHM_K, OFF_WS = OFF_R + 2 * SHM_R, OFF_BIAS = OFF_WS + NW * 64 * 4, OFF_QR = OFF_BIAS + 1024, ATT_LDS = OFF_QR + 256 * 128;
#define KSWZ(row, colB) ((row) * 256 + ((colB) ^ (((row) & 7) << 4)))
#define RSWZ(row, colB) ((row) * 128 + ((colB) ^ (((row) & 7) << 4)))
#define SBAR() __builtin_amdgcn_sched_barrier(0)
__device__ __forceinline__ int crow(int r, int hi) { return (r & 3) + 8 * (r >> 2) + 4 * hi; }
__device__ __forceinline__ unsigned cvtpk(float lo, float hi) { unsigned r; asm volatile("v_cvt_pk_bf16_f32 %0, %1, %2" : "=v"(r) : "v"(lo), "v"(hi)); return r; }
__device__ __forceinline__ bf16x8 ld8(const bf16_t* p) { return *reinterpret_cast<const bf16x8*>(p); }

__device__ __forceinline__ void partialSM(f32x16& p0, f32x16& p1, float& m_reg, float& mn, float& alpha, const float C, const float thr) {
  float pmax = p0[0];
#pragma unroll
  for (int r = 1; r < 16; ++r) pmax = fmaxf(pmax, p0[r]);
#pragma unroll
  for (int r = 0; r < 16; ++r) pmax = fmaxf(pmax, p1[r]);
  { auto rr = __builtin_amdgcn_permlane32_swap(__float_as_uint(pmax), __float_as_uint(pmax), false, false);
    pmax = fmaxf(__uint_as_float(rr[0]), __uint_as_float(rr[1])); }
  if (__builtin_expect(__all(pmax - m_reg <= thr), 1)) { mn = m_reg; alpha = 1.f; }
  else { mn = fmaxf(m_reg, pmax); alpha = __builtin_amdgcn_exp2f((m_reg - mn) * C); m_reg = mn; }
  const float mnC = -mn * C;
#pragma unroll
  for (int r = 0; r < 16; ++r) p0[r] = fmaf(p0[r], C, mnC);
#pragma unroll
  for (int r = 0; r < 16; ++r) p1[r] = fmaf(p1[r], C, mnC);
#pragma unroll
  for (int r = 0; r < 16; ++r) p0[r] = __builtin_amdgcn_exp2f(p0[r]);
}
__device__ __forceinline__ void finishSM(f32x16& p0, f32x16& p1, float alpha, float& l_reg, bf16x8& pa0, bf16x8& pa1, bf16x8& pa2, bf16x8& pa3) {
#pragma unroll
  for (int r = 0; r < 16; ++r) p1[r] = __builtin_amdgcn_exp2f(p1[r]);
  float ps = 0;
#pragma unroll
  for (int r = 0; r < 16; ++r) ps += p0[r];
#pragma unroll
  for (int r = 0; r < 16; ++r) ps += p1[r];
  { auto rr = __builtin_amdgcn_permlane32_swap(__float_as_uint(ps), __float_as_uint(ps), false, false);
    ps = __uint_as_float(rr[0]) + __uint_as_float(rr[1]); }
  l_reg = l_reg * alpha + ps;
#define PK4(P, BASE, OUT) do { unsigned a0 = cvtpk(P[BASE + 0], P[BASE + 1]), a1 = cvtpk(P[BASE + 2], P[BASE + 3]);   \
    unsigned b0 = cvtpk(P[BASE + 4], P[BASE + 5]), b1 = cvtpk(P[BASE + 6], P[BASE + 7]);                              \
    auto r0 = __builtin_amdgcn_permlane32_swap(a0, b0, false, false); auto r1 = __builtin_amdgcn_permlane32_swap(a1, b1, false, false); \
    u32x4 w = {r0[0], r1[0], r0[1], r1[1]}; OUT = *reinterpret_cast<bf16x8*>(&w); } while (0)
  PK4(p0, 0, pa0); PK4(p0, 8, pa1); PK4(p1, 0, pa2); PK4(p1, 8, pa3);
#undef PK4
}
template <int NQD>
__device__ __forceinline__ void qkt(f32x16& p0, f32x16& p1, const char* Ks, const char* Rs, const bf16x8* qr, const char* Qrs, int qrow, int r32, int hi) {
  p0 = f32x16{}; p1 = f32x16{};
#pragma unroll
  for (int d0 = 0; d0 < 8; ++d0) { const int cb = (d0 * 16 + hi * 8) * 2;
    bf16x8 b0 = *reinterpret_cast<const bf16x8*>(Ks + KSWZ(r32, cb));
    bf16x8 b1 = *reinterpret_cast<const bf16x8*>(Ks + KSWZ(32 + r32, cb));
    p0 = __builtin_amdgcn_mfma_f32_32x32x16_bf16(b0, qr[d0], p0, 0, 0, 0);
    p1 = __builtin_amdgcn_mfma_f32_32x32x16_bf16(b1, qr[d0], p1, 0, 0, 0); }
  if constexpr (NQD > 8) {
#pragma unroll
    for (int d0 = 8; d0 < NQD; ++d0) { const int cb = ((d0 - 8) * 16 + hi * 8) * 2;
      bf16x8 b0 = *reinterpret_cast<const bf16x8*>(Rs + RSWZ(r32, cb));
      bf16x8 b1 = *reinterpret_cast<const bf16x8*>(Rs + RSWZ(32 + r32, cb));
      const bf16x8 qv = *reinterpret_cast<const bf16x8*>(Qrs + RSWZ(qrow, cb));
      p0 = __builtin_amdgcn_mfma_f32_32x32x16_bf16(b0, qv, p0, 0, 0, 0);
      p1 = __builtin_amdgcn_mfma_f32_32x32x16_bf16(b1, qv, p1, 0, 0, 0); }
  }
}
__device__ __forceinline__ int v_st(int k, int c) { const int kk = (k & ~0xC) | ((k & 4) << 1) | ((k & 8) >> 1); return ((kk >> 3) * 4 + (c >> 5)) * 512 + ((kk & 7) * 32 + (c & 31)) * 2; }
__device__ __forceinline__ int v_rd_base(int lane) { return ((lane & 3) << 3) | (((lane >> 2) & 3) << 6) | (((lane >> 4) & 1) << 5) | (((lane >> 5) & 1) << 8); }
constexpr int v_rd_off(int d0, int ks, int half) { return d0 * 512 + ks * 4096 + half * 2048; }
template <int OFF> __device__ __forceinline__ s16x4 tr_read(int vb) {
  s16x4 r; asm volatile("ds_read_b64_tr_b16 %0, %1 offset:%2" : "=&v"(r) : "v"(vb), "i"(OFF) : "memory"); return r;
}
template <int D0> __device__ __forceinline__ void pv_one(f32x16& od, int vb, bf16x8 pa0, bf16x8 pa1, bf16x8 pa2, bf16x8 pa3) {
  const s16x4 l0 = tr_read<v_rd_off(D0, 0, 0)>(vb), h0 = tr_read<v_rd_off(D0, 0, 1)>(vb), l1 = tr_read<v_rd_off(D0, 1, 0)>(vb), h1 = tr_read<v_rd_off(D0, 1, 1)>(vb);
  const s16x4 l2 = tr_read<v_rd_off(D0, 2, 0)>(vb), h2 = tr_read<v_rd_off(D0, 2, 1)>(vb), l3 = tr_read<v_rd_off(D0, 3, 0)>(vb), h3 = tr_read<v_rd_off(D0, 3, 1)>(vb);
  asm volatile("s_waitcnt lgkmcnt(0)" ::: "memory"); SBAR();
#define PK(L, H) (bf16x8){L[0], L[1], L[2], L[3], H[0], H[1], H[2], H[3]}
  od = __builtin_amdgcn_mfma_f32_32x32x16_bf16(pa0, PK(l0, h0), od, 0, 0, 0);
  od = __builtin_amdgcn_mfma_f32_32x32x16_bf16(pa1, PK(l1, h1), od, 0, 0, 0);
  od = __builtin_amdgcn_mfma_f32_32x32x16_bf16(pa2, PK(l2, h2), od, 0, 0, 0);
  od = __builtin_amdgcn_mfma_f32_32x32x16_bf16(pa3, PK(l3, h3), od, 0, 0, 0);
#undef PK
}
__device__ __forceinline__ void pv_d0(f32x16* o, int vb, bf16x8 pa0, bf16x8 pa1, bf16x8 pa2, bf16x8 pa3) {
  pv_one<0>(o[0], vb, pa0, pa1, pa2, pa3); pv_one<1>(o[1], vb, pa0, pa1, pa2, pa3); pv_one<2>(o[2], vb, pa0, pa1, pa2, pa3); pv_one<3>(o[3], vb, pa0, pa1, pa2, pa3);
}

struct Args {
  const bf16_t* Q;
  const bf16_t* K;
  const bf16_t* Kr;
  const bf16_t* V;
  bf16_t* O;
  float* lse; long ldlse;
  int nt;
  int kb0, L;
  const float* biasG;
  float C, thr;
};

template <int NQD, bool DIL, long LDQ, long LDK, long LDO>
__device__ __forceinline__ void attn_body(const Args& A, char* lds) {
  const int tid = tidx(), wid = tid >> 6, lane = tid & 63, r32 = lane & 31, hi = lane >> 5;
  char* V_lds = lds + OFF_V; char* K_lds = lds + OFF_K; char* R_lds = lds + OFF_R;
  float* ws = (float*)(lds + OFF_WS) + wid * 64; float* li_l = ws; float* al_l = ws + 32;
  float* biasL = (float*)(lds + OFF_BIAS);
  char* Qr_lds = lds + OFF_QR;
  float m_reg = -1e30f, l_reg = 0; f32x16 o[4] = {}; bf16x8 qr[8];
  const bf16_t* Qw = A.Q + (long)(wid * QBLK + r32) * LDQ + hi * 8;
#pragma unroll
  for (int d0 = 0; d0 < 8; ++d0) qr[d0] = ld8(Qw + d0 * 16);
  if constexpr (NQD > 8) {
#pragma unroll
    for (int d0 = 8; d0 < NQD; ++d0) *(bf16x8*)(Qr_lds + RSWZ(wid * 32 + r32, ((d0 - 8) * 16 + hi * 8) * 2)) = ld8(Qw + d0 * 16);
  }
  if constexpr (DIL) { if (tid < 129) biasL[tid] = A.biasG[tid]; }
  const int sr = tid >> 4, sc = (tid & 15) * 8, vst0 = v_st(sr, sc), vst1 = v_st(32 + sr, sc);
  const int rr_ = tid >> 3, rc_ = (tid & 7) * 8;
  const int vb0 = (int)(uintptr_t)V_lds + v_rd_base(lane);
  bf16x8 vs0, vs1, ks0, ks1, rs0;
  const int Lm1 = A.L - 1;
#define SLOAD(i) do { long ra, rb; if constexpr (DIL) { int a_ = A.kb0 + (i) * 64 + sr, b_ = a_ + 32; a_ = a_ < 0 ? 0 : (a_ > Lm1 ? Lm1 : a_); b_ = b_ < 0 ? 0 : (b_ > Lm1 ? Lm1 : b_); ra = a_; rb = b_; } \
      else { ra = (i) * 64 + sr; rb = ra + 32; } \
    vs0 = ld8(A.V + ra * LDK + sc); vs1 = ld8(A.V + rb * LDK + sc); ks0 = ld8(A.K + ra * LDK + sc); ks1 = ld8(A.K + rb * LDK + sc); \
    if constexpr (NQD > 8) rs0 = ld8(A.Kr + (long)((i) * 64 + rr_) * 64 + rc_); } while (0)
#define SWRITE(b) do { *(bf16x8*)(V_lds + (b) * SHM_V + vst0) = vs0; *(bf16x8*)(V_lds + (b) * SHM_V + vst1) = vs1; const int kc = sc * 2; \
    *(bf16x8*)(K_lds + (b) * SHM_K + KSWZ(sr, kc)) = ks0; *(bf16x8*)(K_lds + (b) * SHM_K + KSWZ(32 + sr, kc)) = ks1; \
    if constexpr (NQD > 8) *(bf16x8*)(R_lds + (b) * SHM_R + RSWZ(rr_, rc_ * 2)) = rs0; } while (0)
#define SWAIT() asm volatile("s_waitcnt vmcnt(0)" ::: "memory")
#define RESC(a) do { if (__any((a) < 1.f)) { if (hi == 0) al_l[r32] = (a); asm volatile("s_waitcnt lgkmcnt(0)" ::: "memory"); \
    _Pragma("unroll") for (int d = 0; d < 4; ++d) _Pragma("unroll") for (int r = 0; r < 16; ++r) o[d][r] *= al_l[crow(r, hi)]; } } while (0)
#define MASK(P0, P1, i) do { if constexpr (DIL) { const int relb = 64 * ((i) - 1) - (wid * 32 + r32); const int kpb = A.kb0 + 64 * (i); \
    _Pragma("unroll") for (int r = 0; r < 16; ++r) { const int key = crow(r, hi); \
      { const int rel = relb + key, kp = kpb + key; const bool ok = rel >= -64 && rel <= 64 && kp >= 0 && kp <= Lm1; const int ix = ok ? rel + 64 : 0; P0[r] = ok ? fmaf(P0[r], A.C, biasL[ix]) : -1e30f; } \
      { const int rel = relb + key + 32, kp = kpb + key + 32; const bool ok = rel >= -64 && rel <= 64 && kp >= 0 && kp <= Lm1; const int ix = ok ? rel + 64 : 0; P1[r] = ok ? fmaf(P1[r], A.C, biasL[ix]) : -1e30f; } } } } while (0)
  const float Csm = DIL ? 1.f : A.C; const float thr = A.thr;
  f32x16 pA0, pA1; float mnA, alA; bf16x8 pa0, pa1, pa2, pa3; const int NT = A.nt;
  if constexpr (!DIL) {
    struct StS { bf16x8 vs0, vs1, ks0, ks1, rs0; } sA, sB;
#define SLD(S, i) do { const long ra = (long)(i) * 64 + sr, rb = ra + 32; \
      S.vs0 = ld8(A.V + ra * LDK + sc); S.vs1 = ld8(A.V + rb * LDK + sc); S.ks0 = ld8(A.K + ra * LDK + sc); S.ks1 = ld8(A.K + rb * LDK + sc); \
      if constexpr (NQD > 8) S.rs0 = ld8(A.Kr + (long)((i) * 64 + rr_) * 64 + rc_); } while (0)
#define SWR(b, S) do { *(bf16x8*)(V_lds + (b) * SHM_V + vst0) = S.vs0; *(bf16x8*)(V_lds + (b) * SHM_V + vst1) = S.vs1; const int kc = sc * 2; \
      *(bf16x8*)(K_lds + (b) * SHM_K + KSWZ(sr, kc)) = S.ks0; *(bf16x8*)(K_lds + (b) * SHM_K + KSWZ(32 + sr, kc)) = S.ks1; \
      if constexpr (NQD > 8) *(bf16x8*)(R_lds + (b) * SHM_R + RSWZ(rr_, rc_ * 2)) = S.rs0; } while (0)
#define TILE(b) do { qkt<NQD>(pA0, pA1, K_lds + (b) * SHM_K, R_lds + (b) * SHM_R, qr, Qr_lds, wid * 32 + r32, r32, hi); partialSM(pA0, pA1, m_reg, mnA, alA, Csm, thr); \
      RESC(alA); finishSM(pA0, pA1, alA, l_reg, pa0, pa1, pa2, pa3); SBAR(); pv_d0(o, vb0 + (b) * SHM_V, pa0, pa1, pa2, pa3); } while (0)
    SLD(sA, 0); SWR(0, sA); SLD(sB, 1); __syncthreads();
    for (int i = 0; i + 1 < NT; i += 2) {
      if (i + 2 < NT) SLD(sA, i + 2);
      SBAR(); TILE(0);
      SWR(1, sB);
      __syncthreads();
      if (i + 3 < NT) SLD(sB, i + 3);
      SBAR(); TILE(1);
      if (i + 2 < NT) SWR(0, sA);
      __syncthreads();
    }
#undef SLD
#undef SWR
#undef TILE
  } else {
    SLOAD(0); SWAIT(); SWRITE(0); __syncthreads();
    for (int i = 0; i < NT; ++i) {
      if constexpr (!DIL) { if (i + 1 < NT) SLOAD(i + 1); }
      SBAR();
      bool live = true;
      if constexpr (DIL) { const int k0 = 64 * (i - 1), q0 = wid * 32; live = (k0 - (q0 + 31) <= 64) && (q0 - (k0 + 63) <= 64) && (A.kb0 + 64 * i + 63 >= 0) && (A.kb0 + 64 * i <= Lm1); }
      if (live) {
      qkt<NQD>(pA0, pA1, K_lds + (i & 1) * SHM_K, R_lds + (i & 1) * SHM_R, qr, Qr_lds, wid * 32 + r32, r32, hi); MASK(pA0, pA1, i); partialSM(pA0, pA1, m_reg, mnA, alA, Csm, thr);
      RESC(alA);
      finishSM(pA0, pA1, alA, l_reg, pa0, pa1, pa2, pa3); SBAR();
      pv_d0(o, vb0 + (i & 1) * SHM_V, pa0, pa1, pa2, pa3);
      }
      if (i + 1 < NT) { if constexpr (DIL) SLOAD(i + 1); SWAIT(); SWRITE((i + 1) & 1); }
      __syncthreads();
    }
  }
  if (hi == 0) li_l[r32] = l_reg; asm volatile("s_waitcnt lgkmcnt(0)" ::: "memory");
  if constexpr (DIL) { if (hi == 0) A.lse[(long)(wid * QBLK + r32) * A.ldlse] = m_reg + __log2f(l_reg); }
  float rli[16];
#pragma unroll
  for (int r = 0; r < 16; ++r) rli[r] = __builtin_amdgcn_rcpf(li_l[crow(r, hi)]);
  bf16_t* Ow = A.O + (long)(wid * QBLK) * LDO;
#pragma unroll
  for (int r = 0; r < 16; ++r) { const int orow = crow(r, hi);
#pragma unroll
    for (int d0 = 0; d0 < 4; ++d0) { const float v = o[d0][r] * rli[r]; Ow[(long)orow * LDO + d0 * 32 + r32] = (bf16_t)(cvtpk(v, v) & 0xffffu); } }
  __syncthreads();
#undef SLOAD
#undef SWRITE
#undef SWAIT
#undef RESC
#undef MASK
}
}
using pg8::bf16_t; using pg8::bf16x8; using pg8::f32x4; using pg8::u32x4;
constexpr int T = 24576, DM = 2048, FH = 5632, NTHR = 512;
constexpr size_t MiB = 1048576;
constexpr size_t O_WM = 0, O_SM = 40 * MiB, O_RF = 104 * MiB, O_RA = 200 * MiB, O_RB = 296 * MiB, O_RC = 392 * MiB, O_RD = 488 * MiB, O_RE = 584 * MiB, O_RX = 680 * MiB,
                 O_RG = 776 * MiB, O_RH = 872 * MiB, WS_END = 968 * MiB;
constexpr size_t S_RINV = O_SM, S_RINVQ = S_RINV + 131072, S_RINVKV = S_RINVQ + 131072, S_LSE = S_RINVKV + 131072  , S_COS = S_LSE + 2359296  ,
                 S_SIN = S_COS + 2 * MiB, S_BIAS = S_SIN + 2 * MiB  , S_GL = S_BIAS + 16384  , S_WL = S_GL + 12 * MiB, S_AL = S_WL + 12 * MiB, S_END = S_AL + 12 * MiB;
static_assert(S_END <= O_RF, "small region overflow");
constexpr int LDS_BYTES = 131072;
static_assert(at::ATT_LDS <= LDS_BYTES, "attention LDS");

struct Params {
  const float *xp, *xs, *norm_g, *rel_bias, *w_in, *q_norm, *kv_norm, *w_uq, *w_ukv, *w_out, *mu, *w_r, *w_k, *w_v, *w_o, *w0, *w1, *w2, *a0, *a1, *a2, *g1, *g2, *k_k, *k_a, *r_k, *ln_w, *ln_b,
              *w_gate, *w_up, *w_down;
  float* out; unsigned char* ws; int ph_lo, ph_hi;
};

__device__ __forceinline__ float bf2f(bf16_t b) { return __uint_as_float(((unsigned)b) << 16); }
__device__ __forceinline__ bf16_t f2bf(float f) { unsigned u = __float_as_uint(f); u += 0x7FFFu + ((u >> 16) & 1u); return (bf16_t)(u >> 16); }
__device__ __forceinline__ float wave_sum(float x) {
#pragma unroll
  for (int o = 32; o >= 1; o >>= 1) x += __shfl_xor(x, o);
  return x;
}
template <int CTRL> __device__ __forceinline__ float dpp_f(float x) { return __int_as_float(__builtin_amdgcn_update_dpp(0, __float_as_int(x), CTRL, 0xF, 0xF, false)); }
__device__ __forceinline__ float row16_sum(float x) { x += dpp_f<0x128>(x); x += dpp_f<0x124>(x); x += dpp_f<0x122>(x); x += dpp_f<0x121>(x); return x; }

struct WMap { const float* s0; const float* s1; const float* gain; int ld; int mode; };
__device__ __forceinline__ int rope_dim(int p) { const int q = p >> 3, w = p & 7; return w < 4 ? 4 * q + w : 32 + 4 * q + (w - 4); }
__device__ __forceinline__ float wmap_get(const WMap& m, int k, int n) {
  float g = m.gain ? m.gain[k] : 1.f;
  switch (m.mode) {
    case 0: return m.s0[(size_t)k * m.ld + n] * g;
    case 1: { int col; if (n < 1024) col = n; else if (n < 4096) col = n + 64; else if (n < 4160) col = 1024 + rope_dim(n - 4096); else return 0.f; return m.s0[(size_t)k * 4160 + col] * g; }
    case 2: { const int h = n / 192, c = n - h * 192; const int col = c < 128 ? n : h * 192 + 128 + rope_dim(c - 128); return m.s0[(size_t)k * 1536 + col] * g; }
    case 3: { const int g8 = n >> 3, w = n & 7; return (w < 4 ? m.s0[(size_t)k * FH + g8 * 4 + w] : m.s1[(size_t)k * FH + g8 * 4 + w - 4]) * g; }
    case 4: { if (n < 96) return m.s0[(size_t)k * 96 + n]; if (n < 192) return m.s1[(size_t)k * 96 + n - 96]; return 0.f; }
    default: { const int d = n >> 11, kk = k - d * 96; if (kk < 0 || kk >= 96) return 0.f; return (d ? m.s1 : m.s0)[(size_t)kk * 2048 + (n & 2047)]; }
  }
}
__device__ __forceinline__ void convert_T(const WMap& m, bf16_t* dst, int N, int K, float* tile  ) {
  const int tid = tidx(), ntn = N >> 6, ntk = K >> 6, nt = ntn * ntk;
  for (int t = blockIdx.x; t < nt; t += gridDim.x) {
    const int n0 = (t % ntn) << 6, k0 = (t / ntn) << 6;
    { const int j = tid & 63, i0 = tid >> 6;
#pragma unroll
      for (int kk = 0; kk < 8; ++kk) { const int kl = i0 * 8 + kk; tile[kl * 65 + j] = wmap_get(m, k0 + kl, n0 + j); } }
    __syncthreads();
    { const int nl = tid >> 3, kc = (tid & 7) * 8; float v[8];
#pragma unroll
      for (int e = 0; e < 8; ++e) v[e] = tile[(kc + e) * 65 + nl];
      u32x4 w; w.x = pg8::cvt_pk_bf16(v[0], v[1]); w.y = pg8::cvt_pk_bf16(v[2], v[3]); w.z = pg8::cvt_pk_bf16(v[4], v[5]); w.w = pg8::cvt_pk_bf16(v[6], v[7]);
      *(u32x4*)(dst + (size_t)(n0 + nl) * K + k0 + kc) = w; }
    __syncthreads();
  }
}
__device__ __forceinline__ void convert_attn_weights(const Params& p, int i, int layer, float* tile) {
  bf16_t* W = (bf16_t*)(p.ws + O_WM);
  { WMap m{p.w_in + (size_t)i * 2048 * 4160, nullptr, p.norm_g + (size_t)(layer * 4 + 0) * DM, 4160, 1}; convert_T(m, W, 4352, 2048, tile); }
  { WMap m{p.w_uq + (size_t)i * 512 * 1536, nullptr, p.q_norm + (size_t)i * 512, 1536, 2}; convert_T(m, W + 8912896, 1536, 512, tile); }
  { WMap m{p.w_ukv + (size_t)i * 512 * 2048, nullptr, p.kv_norm + (size_t)i * 512, 2048, 0}; convert_T(m, W + 8912896 + 786432, 2048, 512, tile); }
  { WMap m{p.w_out + (size_t)i * 2048 * 2048, nullptr, nullptr, 2048, 0}; convert_T(m, W + 8912896 + 786432 + 1048576, 2048, 2048, tile); }
}
constexpr size_t WA_IN = 0, WA_UQ = 8912896, WA_UKV = WA_UQ + 786432, WA_OUT = WA_UKV + 1048576;
constexpr size_t WR_R = 0, WR_K = 4194304, WR_V = 2 * 4194304, WR_O = 3 * 4194304, WR_W1 = 4 * 4194304, WR_A1 = WR_W1 + 524288, WR_G1 = WR_A1 + 524288, WR_G2 = WR_G1 + 524288,
                 WR_W2 = WR_G2 + 524288, WR_A2 = WR_W2 + 1048576;
static_assert((WR_A2 + 1048576) * 2 == 40 * MiB, "rwkv weights size");
__device__ __forceinline__ void convert_rwkv_weights(const Params& p, int i, float* tile) {
  bf16_t* W = (bf16_t*)(p.ws + O_WM); const size_t DD = (size_t)DM * DM;
  { WMap m{p.w_r + i * DD, nullptr, nullptr, 2048, 0}; convert_T(m, W + WR_R, 2048, 2048, tile); }
  { WMap m{p.w_k + i * DD, nullptr, nullptr, 2048, 0}; convert_T(m, W + WR_K, 2048, 2048, tile); }
  { WMap m{p.w_v + i * DD, nullptr, nullptr, 2048, 0}; convert_T(m, W + WR_V, 2048, 2048, tile); }
  { WMap m{p.w_o + i * DD, nullptr, nullptr, 2048, 0}; convert_T(m, W + WR_O, 2048, 2048, tile); }
  { WMap m{p.w1 + (size_t)(i * 2) * 2048 * 96, p.w1 + (size_t)(i * 2 + 1) * 2048 * 96, nullptr, 96, 4}; convert_T(m, W + WR_W1, 256, 2048, tile); }
  { WMap m{p.a1 + (size_t)(i * 2) * 2048 * 96, p.a1 + (size_t)(i * 2 + 1) * 2048 * 96, nullptr, 96, 4}; convert_T(m, W + WR_A1, 256, 2048, tile); }
  { WMap m{p.g1 + (size_t)i * 2048 * 256, nullptr, nullptr, 256, 0}; convert_T(m, W + WR_G1, 256, 2048, tile); }
  { WMap m{p.g2 + (size_t)i * 256 * 2048, nullptr, nullptr, 2048, 0}; convert_T(m, W + WR_G2, 2048, 256, tile); }
  { WMap m{p.w2 + (size_t)(i * 2) * 96 * 2048, p.w2 + (size_t)(i * 2 + 1) * 96 * 2048, nullptr, 2048, 5}; convert_T(m, W + WR_W2, 4096, 256, tile); }
  { WMap m{p.a2 + (size_t)(i * 2) * 96 * 2048, p.a2 + (size_t)(i * 2 + 1) * 96 * 2048, nullptr, 2048, 5}; convert_T(m, W + WR_A2, 4096, 256, tile); }
}
constexpr size_t WF_GU = 0, WF_DN = (size_t)11264 * 2048;
__device__ __forceinline__ void convert_ffn_weights(const Params& p, int layer, float* tile) {
  bf16_t* W = (bf16_t*)(p.ws + O_RF); const size_t DF = (size_t)DM * FH;
  { WMap m{p.w_gate + layer * DF, p.w_up + layer * DF, p.norm_g + (size_t)(layer * 4 + 2) * DM, FH, 3}; convert_T(m, W + WF_GU, 11264, 2048, tile); }
  { WMap m{p.w_down + layer * DF, nullptr, nullptr, 2048, 0}; convert_T(m, W + WF_DN, 2048, 5632, tile); }
}
__device__ __forceinline__ void convert_mixer_weights(const Params& p, int layer, float* tile) { if (layer & 1) convert_rwkv_weights(p, layer >> 1, tile); else convert_attn_weights(p, layer >> 1, layer, tile); }

__device__ __forceinline__ void resid_phase(const Params& p, const bf16_t* mix, const float* g) {
  const int lane = tidx() & 63, gw = blockIdx.x * 8 + (tidx() >> 6), nw = gridDim.x * 8;
  bf16_t* xb = (bf16_t*)(p.ws + O_RC); float* rinv = (float*)(p.ws + S_RINV);
  for (int t = gw; t < T; t += nw) {
    float* xr = p.out + (size_t)t * DM; float xv[4][8];
    if (mix) {
      const bf16_t* mr = mix + (size_t)t * DM; float mv[4][8]; float ss = 0;
#pragma unroll
      for (int i = 0; i < 4; ++i) { const bf16x8 m8 = *(const bf16x8*)(mr + i * 512 + lane * 8);
#pragma unroll
        for (int e = 0; e < 8; ++e) { mv[i][e] = bf2f((bf16_t)m8[e]); ss += mv[i][e] * mv[i][e]; } }
      ss = wave_sum(ss); const float sc = rsqrtf(ss * (1.f / DM) + 1e-6f);
#pragma unroll
      for (int i = 0; i < 4; ++i) { const f32x4 g0 = *(const f32x4*)(g + i * 512 + lane * 8), g1 = *(const f32x4*)(g + i * 512 + lane * 8 + 4);
        const f32x4 x0 = *(const f32x4*)(xr + i * 512 + lane * 8), x1 = *(const f32x4*)(xr + i * 512 + lane * 8 + 4);
#pragma unroll
        for (int e = 0; e < 4; ++e) { xv[i][e] = x0[e] + mv[i][e] * sc * g0[e]; xv[i][4 + e] = x1[e] + mv[i][4 + e] * sc * g1[e]; } }
    } else {
      const float* src = t < 8192 ? p.xp + (size_t)t * DM : p.xs + (size_t)(t - 8192) * DM;
#pragma unroll
      for (int i = 0; i < 4; ++i) { const f32x4 x0 = *(const f32x4*)(src + i * 512 + lane * 8), x1 = *(const f32x4*)(src + i * 512 + lane * 8 + 4);
#pragma unroll
        for (int e = 0; e < 4; ++e) { xv[i][e] = x0[e]; xv[i][4 + e] = x1[e]; } }
    }
    float s2 = 0;
#pragma unroll
    for (int i = 0; i < 4; ++i) {
#pragma unroll
      for (int e = 0; e < 8; ++e) s2 += xv[i][e] * xv[i][e];
      *(f32x4*)(xr + i * 512 + lane * 8) = (f32x4){xv[i][0], xv[i][1], xv[i][2], xv[i][3]}; *(f32x4*)(xr + i * 512 + lane * 8 + 4) = (f32x4){xv[i][4], xv[i][5], xv[i][6], xv[i][7]};
      u32x4 w; w.x = pg8::cvt_pk_bf16(xv[i][0], xv[i][1]); w.y = pg8::cvt_pk_bf16(xv[i][2], xv[i][3]); w.z = pg8::cvt_pk_bf16(xv[i][4], xv[i][5]); w.w = pg8::cvt_pk_bf16(xv[i][6], xv[i][7]);
      *(u32x4*)(xb + (size_t)t * DM + i * 512 + lane * 8) = w; }
    s2 = wave_sum(s2); if (lane == 0) rinv[t] = rsqrtf(s2 * (1.f / DM) + 1e-6f);
  }
}
__device__ __forceinline__ void rownorm_phase(const Params& p) {
  const int lane = tidx() & 63, gw = blockIdx.x * 8 + (tidx() >> 6), nw = gridDim.x * 8;
  const bf16_t* cq = (const bf16_t*)(p.ws + O_RA); const bf16_t* ckv = cq + (size_t)T * 512;
  float* rq = (float*)(p.ws + S_RINVQ); float* rkv = (float*)(p.ws + S_RINVKV);
  for (int t = gw; t < 2 * T; t += nw) { const int tt = t >= T ? t - T : t; const bf16_t* src = (t >= T ? ckv : cq) + (size_t)tt * 512 + lane * 8;
    const bf16x8 v = *(const bf16x8*)src; float ss = 0;
#pragma unroll
    for (int e = 0; e < 8; ++e) { const float f = bf2f((bf16_t)v[e]); ss += f * f; }
    ss = wave_sum(ss); if (lane == 0) (t >= T ? rkv : rq)[tt] = rsqrtf(ss * (1.f / 512) + 1e-6f); }
}
__device__ __forceinline__ void mix_phase(const Params& p, const float* g0, const float* mu  , int sel0, int sel1, int sel2) {
  const int lane = tidx() & 63, gw = blockIdx.x * 8 + (tidx() >> 6), nw = gridDim.x * 8;
  const float* rinv = (const float*)(p.ws + S_RINV);
  bf16_t* m0 = (bf16_t*)(p.ws + O_RD); bf16_t* m1 = (bf16_t*)(p.ws + O_RE); bf16_t* m2 = (bf16_t*)(p.ws + O_RX);
  for (int t = gw; t < T; t += nw) {
    const int s0 = pg8::seq_start(t), len = s0 == 8192 ? 16384 : 4096; const bool hasp = t > s0, hasn = t < s0 + len - 1;
    const float rc = rinv[t], rp = hasp ? rinv[t - 1] : 0.f, rn = hasn ? rinv[t + 1] : 0.f;
    const float* xc = p.out + (size_t)t * DM; const float* xpv = hasp ? xc - DM : xc; const float* xnv = hasn ? xc + DM : xc;
#pragma unroll 2
    for (int i = 0; i < 8; ++i) { const int c = i * 256 + lane * 4;
      const f32x4 gv = *(const f32x4*)(g0 + c); const f32x4 h = *(const f32x4*)(xc + c) * rc * gv, hp = *(const f32x4*)(xpv + c) * rp * gv, hn = *(const f32x4*)(xnv + c) * rn * gv;
      const f32x4 xx = (hp + hn) * 0.5f - h;
      const f32x4 a = h + xx * *(const f32x4*)(mu + sel0 * DM + c), b = h + xx * *(const f32x4*)(mu + sel1 * DM + c), d = h + xx * *(const f32x4*)(mu + sel2 * DM + c);
      uint2 w; w.x = pg8::cvt_pk_bf16(a[0], a[1]); w.y = pg8::cvt_pk_bf16(a[2], a[3]); *(uint2*)(m0 + (size_t)t * DM + c) = w;
      w.x = pg8::cvt_pk_bf16(b[0], b[1]); w.y = pg8::cvt_pk_bf16(b[2], b[3]); *(uint2*)(m1 + (size_t)t * DM + c) = w;
      w.x = pg8::cvt_pk_bf16(d[0], d[1]); w.y = pg8::cvt_pk_bf16(d[2], d[3]); *(uint2*)(m2 + (size_t)t * DM + c) = w; }
  }
}
__device__ __forceinline__ void postscan_phase(const Params& p, int i) {
  const int lane = tidx() & 63, gw = blockIdx.x * 8 + (tidx() >> 6), nw = gridDim.x * 8;
  bf16_t* y0 = (bf16_t*)(p.ws + O_RH); const bf16_t* y1 = (const bf16_t*)(p.ws + O_RF);
  const bf16_t* r = (const bf16_t*)(p.ws + O_RA); const bf16_t* k = (const bf16_t*)(p.ws + O_RB); const bf16_t* v = (const bf16_t*)(p.ws + O_RC); const bf16_t* g = (const bf16_t*)(p.ws + O_RD);
  const float* lnw = p.ln_w + (size_t)i * DM; const float* lnb = p.ln_b + (size_t)i * DM; const float* rk = p.r_k + (size_t)i * DM;
  for (int t = gw; t < T; t += nw) {
#pragma unroll 4
    for (int h = 0; h < 32; ++h) { const size_t ix = (size_t)t * DM + h * 64 + lane; const int c = h * 64 + lane;
      const float y = bf2f(y0[ix]) + bf2f(y1[ix]);
      const float mean = wave_sum(y) * (1.f / 64); const float d = y - mean; const float var = wave_sum(d * d) * (1.f / 64);
      float o = d * rsqrtf(var + 64e-5f) * lnw[c] + lnb[c];
      const float rf = bf2f(r[ix]), kf = bf2f(k[ix]), vf = bf2f(v[ix]);
      const float bonus = wave_sum(rf * kf * rk[c]) * vf;
      o = (o + bonus) * bf2f(g[ix]);
      y0[ix] = f2bf(o); }
  }
}
__device__ __forceinline__ void combine_phase(const Params& p) {
  const bf16_t* Op = (const bf16_t*)(p.ws + O_RX); const float* lse = (const float*)(p.ws + S_LSE); bf16_t* cat = (bf16_t*)(p.ws + O_RF);
  const size_t n = (size_t)T * 128;
  for (size_t it = (size_t)blockIdx.x * NTHR + tidx(); it < n; it += (size_t)gridDim.x * NTHR) {
    const int t = (int)(it >> 7), c8 = (int)(it & 127) * 8, h = c8 >> 7;
    const float l0 = lse[((size_t)0 * T + t) * 8 + h], l1 = lse[((size_t)1 * T + t) * 8 + h], l2 = lse[((size_t)2 * T + t) * 8 + h];
    const float m = fmaxf(l0, fmaxf(l1, l2)); float w0 = __builtin_amdgcn_exp2f(l0 - m), w1 = __builtin_amdgcn_exp2f(l1 - m), w2 = __builtin_amdgcn_exp2f(l2 - m);
    const float inv = 1.f / (w0 + w1 + w2); w0 *= inv; w1 *= inv; w2 *= inv;
    const bf16x8 a = *(const bf16x8*)(Op + ((size_t)0 * T + t) * 1024 + c8), b = *(const bf16x8*)(Op + ((size_t)1 * T + t) * 1024 + c8), d = *(const bf16x8*)(Op + ((size_t)2 * T + t) * 1024 + c8);
    float o[8];
#pragma unroll
    for (int e = 0; e < 8; ++e) o[e] = w0 * bf2f((bf16_t)a[e]) + w1 * bf2f((bf16_t)b[e]) + w2 * bf2f((bf16_t)d[e]);
    u32x4 w; w.x = pg8::cvt_pk_bf16(o[0], o[1]); w.y = pg8::cvt_pk_bf16(o[2], o[3]); w.z = pg8::cvt_pk_bf16(o[4], o[5]); w.w = pg8::cvt_pk_bf16(o[6], o[7]);
    *(u32x4*)(cat + (size_t)t * DM + 1024 + c8) = w;
  }
}
__device__ __forceinline__ void tables_phase(const Params& p) {
  float* cs = (float*)(p.ws + S_COS); float* sn = (float*)(p.ws + S_SIN); float* bt = (float*)(p.ws + S_BIAS);
  for (int it = blockIdx.x * NTHR + tidx(); it < 16384 * 32; it += gridDim.x * NTHR) { const int pos = it >> 5, i = it & 31;
    const float inv = __builtin_amdgcn_exp2f(-(float)i * (13.287712379549449f / 32.f)); const float ang = (float)pos * inv;
    const double rev = (double)ang * 0.15915494309189535; const float fr = (float)(rev - __builtin_rint(rev));
    cs[it] = __builtin_amdgcn_cosf(fr); sn[it] = __builtin_amdgcn_sinf(fr); }
  for (int it = blockIdx.x * NTHR + tidx(); it < 3 * 8 * 129; it += gridDim.x * NTHR) { const int pat = it / (8 * 129), rem = it - pat * 8 * 129, h = rem / 129, rl = rem - h * 129 - 64;
    const int dil = pat == 0 ? 1 : (pat == 1 ? 4 : 16); const int rel = rl * dil; const int n = rel < 0 ? -rel : rel;
    int bucket = rel > 0 ? 16 : 0;
    if (n < 8) bucket += n; else { int lg = 8 + (int)(__log2f((float)n * 0.125f) * (8.f / 7.f)); bucket += lg < 15 ? lg : 15; }
    bt[it] = p.rel_bias[bucket * 8 + h] * 1.4426950408889634f; }
}
constexpr int SCH = 32;
constexpr int SC_AM = 0, SC_B = 8192, SC_W = 16384, SC_KD = 24576, SC_R = 32768, SC_V = 40960, SC_Y = 45056, SC_BUF = 49152;
static_assert(2 * SC_BUF <= LDS_BYTES, "scan LDS");
__device__ __forceinline__ void scan_phase(const Params& p, int i, unsigned char* lds) {
  const int tid = tidx(), wid = tid >> 6, lane = tid & 63;
  const bf16_t* rB = (const bf16_t*)(p.ws + O_RA); const bf16_t* kB = (const bf16_t*)(p.ws + O_RB); const bf16_t* vB = (const bf16_t*)(p.ws + O_RC);
  const bf16_t* eB = (const bf16_t*)(p.ws + O_RD); const bf16_t* aB = (const bf16_t*)(p.ws + O_RX);
  const float* kkw = p.k_k + (size_t)i * DM; const float* kaw = p.k_a + (size_t)i * DM;
  for (int wk = blockIdx.x; wk < 256; wk += gridDim.x) {
    for (int q = 0; q < 2; ++q) {
      int s0, len, head, dir, rowbase; const bool qm = (q == 0);
      if (qm) { const int u = wk >> 2; rowbase = (wk & 3) * 16; dir = u & 1; head = u >> 1; s0 = 8192; len = 16384; }
      else { const int u = wk >> 1; rowbase = (wk & 1) * 32; dir = u & 1; head = (u >> 1) & 31; s0 = (u >> 6) * 4096; len = 4096; }
      bf16_t* yB = (bf16_t*)(p.ws + (dir ? O_RF : O_RH));
      const int nch = len / SCH;
      const int rp = lane >> 4, kq = lane & 15;
      float S0[4] = {0.f, 0.f, 0.f, 0.f}, S1[4] = {0.f, 0.f, 0.f, 0.f};
      const int pw = wid - 4, st = lane >> 3, l8 = lane & 7, c8 = l8 * 8;
      f32x4 kkc[2], kac[2], w0c[2], a0c[2];
      if (wid >= 4) {
#pragma unroll
        for (int e = 0; e < 2; ++e) { const int cc = head * 64 + c8 + e * 4;
          kkc[e] = *(const f32x4*)(kkw + cc); kac[e] = *(const f32x4*)(kaw + cc);
          w0c[e] = *(const f32x4*)(p.w0 + (size_t)(i * 2 + dir) * DM + cc); a0c[e] = *(const f32x4*)(p.a0 + (size_t)(i * 2 + dir) * DM + cc); }
      }
      auto fill = [&](int c, int b) {
        unsigned char* B = lds + b * SC_BUF;
        const int sl = pw * 8 + st; const int s = c * SCH + sl; const int t = dir ? len - 1 - s : s; const size_t tok = (size_t)(s0 + t);
        const bf16x8 kv = *(const bf16x8*)(kB + tok * DM + head * 64 + c8), rv = *(const bf16x8*)(rB + tok * DM + head * 64 + c8);
        const bf16x8 ev = *(const bf16x8*)(eB + tok * 4096 + dir * 2048 + head * 64 + c8), av = *(const bf16x8*)(aB + tok * 4096 + dir * 2048 + head * 64 + c8);
        uint2 vv = make_uint2(0u, 0u); if (!qm || l8 < 4) vv = *(const uint2*)(vB + tok * DM + head * 64 + rowbase + l8 * 4);
        float kf[8], kk[8]; float ss = 0.f;
#pragma unroll
        for (int e = 0; e < 8; ++e) { kf[e] = bf2f((bf16_t)kv[e]); kk[e] = kf[e] * kkc[e >> 2][e & 3]; ss += kk[e] * kk[e]; }
        ss += __shfl_xor(ss, 1); ss += __shfl_xor(ss, 2); ss += __shfl_xor(ss, 4);
        const float inv = rsqrtf(ss + 1e-12f);
        f32x4 oam[2], ob[2], ow[2], okd[2], orr[2];
#pragma unroll
        for (int e = 0; e < 8; ++e) { const int q4 = e >> 2, j = e & 3;
          const float af = pg8::fsig(a0c[q4][j] + bf2f((bf16_t)av[e])); const float ef = 0.6065306597f * pg8::fsig(w0c[q4][j] + bf2f((bf16_t)ev[e]));
          const float kn = kk[e] * inv;
          oam[q4][j] = -kn; ob[q4][j] = kn * af; ow[q4][j] = __expf(-ef); okd[q4][j] = kf[e] * (1.f + (af - 1.f) * kac[q4][j]); orr[q4][j] = bf2f((bf16_t)rv[e]); }
        const int o4 = sl * 16 + l8 * 2;
#pragma unroll
        for (int e = 0; e < 2; ++e) { ((f32x4*)(B + SC_AM))[o4 + e] = oam[e]; ((f32x4*)(B + SC_B))[o4 + e] = ob[e]; ((f32x4*)(B + SC_W))[o4 + e] = ow[e];
          ((f32x4*)(B + SC_KD))[o4 + e] = okd[e]; ((f32x4*)(B + SC_R))[o4 + e] = orr[e]; }
        f32x4 vf; vf[0] = __uint_as_float(vv.x << 16); vf[1] = __uint_as_float(vv.x & 0xffff0000u); vf[2] = __uint_as_float(vv.y << 16); vf[3] = __uint_as_float(vv.y & 0xffff0000u);
        ((f32x4*)(B + SC_V))[sl * 8 + l8] = vf;
      };
      auto flush = [&](int c, int b) {
        const unsigned char* B = lds + b * SC_BUF;
        const int sl = pw * 8 + st; const int s = c * SCH + sl; const int t = dir ? len - 1 - s : s;
        const f32x4 y = ((const f32x4*)(B + SC_Y))[sl * 8 + l8];
        uint2 w; w.x = pg8::cvt_pk_bf16(y[0], y[1]); w.y = pg8::cvt_pk_bf16(y[2], y[3]);
        if (!qm || l8 < 4) *(uint2*)(yB + (size_t)(s0 + t) * DM + head * 64 + rowbase + l8 * 4) = w;
      };
      if (wid >= 4) fill(0, 0);
      __syncthreads();
      for (int c = 0; c < nch; ++c) {
        if (wid < 4) {
          const unsigned char* B = lds + (c & 1) * SC_BUF;
          const f32x4* pAM = (const f32x4*)(B + SC_AM) + kq; const f32x4* pB = (const f32x4*)(B + SC_B) + kq; const f32x4* pW = (const f32x4*)(B + SC_W) + kq;
          const f32x4* pKD = (const f32x4*)(B + SC_KD) + kq; const f32x4* pR = (const f32x4*)(B + SC_R) + kq;
          const float2* pV = (const float2*)(B + SC_V) + wid * 4 + rp; float2* pY = (float2*)(B + SC_Y) + wid * 4 + rp;
          if (!qm) {
          f32x4 am = pAM[0], bb = pB[0], ww = pW[0], kd = pKD[0], rr = pR[0]; float2 vv = pV[0]; float yq0 = 0.f, yq1 = 0.f, yk0 = 0.f, yk1 = 0.f;
#pragma unroll 4
          for (int s = 0; s < SCH; ++s) {
            const int sn = (s + 1 < SCH ? s + 1 : s) * 16;
            const f32x4 am_n = pAM[sn], bb_n = pB[sn], ww_n = pW[sn], kd_n = pKD[sn], rr_n = pR[sn]; const float2 vv_n = pV[sn];
            float sa0 = (S0[0] * am[0] + S0[1] * am[1]) + (S0[2] * am[2] + S0[3] * am[3]);
            float sa1 = (S1[0] * am[0] + S1[1] * am[1]) + (S1[2] * am[2] + S1[3] * am[3]);
            float u0[4], u1[4];
#pragma unroll
            for (int j = 0; j < 4; ++j) { u0[j] = fmaf(S0[j], ww[j], vv.x * kd[j]); u1[j] = fmaf(S1[j], ww[j], vv.y * kd[j]); }
            sa0 += dpp_f<0x128>(sa0); sa1 += dpp_f<0x128>(sa1); yq0 += dpp_f<0x128>(yq0); yq1 += dpp_f<0x128>(yq1);
            sa0 += dpp_f<0x124>(sa0); sa1 += dpp_f<0x124>(sa1); yq0 += dpp_f<0x124>(yq0); yq1 += dpp_f<0x124>(yq1);
            sa0 += dpp_f<0x122>(sa0); sa1 += dpp_f<0x122>(sa1); yq0 += dpp_f<0x122>(yq0); yq1 += dpp_f<0x122>(yq1);
            sa0 += dpp_f<0x121>(sa0); sa1 += dpp_f<0x121>(sa1); yq0 += dpp_f<0x121>(yq0); yq1 += dpp_f<0x121>(yq1);
            { const bool me = kq == ((s - 1) & 15); yk0 = me ? yq0 : yk0; yk1 = me ? yq1 : yk1; }
            if (s == 16) pY[kq * 16] = make_float2(yk0, yk1);
#pragma unroll
            for (int j = 0; j < 4; ++j) { S0[j] = fmaf(sa0, bb[j], u0[j]); S1[j] = fmaf(sa1, bb[j], u1[j]); }
            yq0 = (S0[0] * rr[0] + S0[1] * rr[1]) + (S0[2] * rr[2] + S0[3] * rr[3]);
            yq1 = (S1[0] * rr[0] + S1[1] * rr[1]) + (S1[2] * rr[2] + S1[3] * rr[3]);
            am = am_n; bb = bb_n; ww = ww_n; kd = kd_n; rr = rr_n; vv = vv_n;
          }
          yq0 = row16_sum(yq0); yq1 = row16_sum(yq1);
          if (kq == 15) { yk0 = yq0; yk1 = yq1; }
          pY[(16 + kq) * 16] = make_float2(yk0, yk1);
          } else {
          const float* pV1 = (const float*)(B + SC_V) + wid * 4 + rp; float* pY1 = (float*)(B + SC_Y) + wid * 4 + rp;
          f32x4 am = pAM[0], bb = pB[0], ww = pW[0], kd = pKD[0], rr = pR[0]; float vv = pV1[0]; float yq = 0.f, yk = 0.f;
#pragma unroll 4
          for (int s = 0; s < SCH; ++s) {
            const int sn = (s + 1 < SCH ? s + 1 : s);
            const f32x4 am_n = pAM[sn * 16], bb_n = pB[sn * 16], ww_n = pW[sn * 16], kd_n = pKD[sn * 16], rr_n = pR[sn * 16]; const float vv_n = pV1[sn * 32];
            float sa0 = (S0[0] * am[0] + S0[1] * am[1]) + (S0[2] * am[2] + S0[3] * am[3]);
            float u0[4];
#pragma unroll
            for (int j = 0; j < 4; ++j) u0[j] = fmaf(S0[j], ww[j], vv * kd[j]);
            sa0 += dpp_f<0x128>(sa0); yq += dpp_f<0x128>(yq);
            sa0 += dpp_f<0x124>(sa0); yq += dpp_f<0x124>(yq);
            sa0 += dpp_f<0x122>(sa0); yq += dpp_f<0x122>(yq);
            sa0 += dpp_f<0x121>(sa0); yq += dpp_f<0x121>(yq);
            yk = (kq == ((s - 1) & 15)) ? yq : yk;
            if (s == 16) pY1[kq * 32] = yk;
#pragma unroll
            for (int j = 0; j < 4; ++j) S0[j] = fmaf(sa0, bb[j], u0[j]);
            yq = (S0[0] * rr[0] + S0[1] * rr[1]) + (S0[2] * rr[2] + S0[3] * rr[3]);
            am = am_n; bb = bb_n; ww = ww_n; kd = kd_n; rr = rr_n; vv = vv_n;
          }
          yq = row16_sum(yq);
          if (kq == 15) yk = yq;
          pY1[(16 + kq) * 32] = yk;
          }
        } else {
          if (c + 1 < nch) fill(c + 1, (c + 1) & 1);
          if (c >= 1) flush(c - 1, (c - 1) & 1);
        }
        __syncthreads();
      }
      if (wid >= 4) flush(nch - 1, (nch - 1) & 1);
      __syncthreads();
    }
  }
}

__device__ __forceinline__ void dilated_phase(const Params& p, char* lds) {
  const bf16_t* qb = (const bf16_t*)(p.ws + O_RD); const bf16_t* kb = qb + (size_t)T * 1024; const bf16_t* vb = kb + (size_t)T * 1024;
  bf16_t* Op = (bf16_t*)(p.ws + O_RX); float* lse = (float*)(p.ws + S_LSE); const float* bt = (const float*)(p.ws + S_BIAS);
  for (int it = blockIdx.x; it < 3 * 8 * 96; it += gridDim.x) {
    const int pat = it / 768, rem = it - pat * 768, h = rem / 96, blk = rem - h * 96;
    const int dil = pat == 0 ? 1 : (pat == 1 ? 4 : 16);
    int s0, len, b = blk;
    if (b < 16) { s0 = 0; len = 4096; } else if (b < 32) { s0 = 4096; len = 4096; b -= 16; } else { s0 = 8192; len = 16384; b -= 32; }
    const int L = len / dil, nbl = L / 256; const int res = b / nbl, j0 = (b - res * nbl) * 256;
    const size_t tok0 = (size_t)(s0 + res);
    at::Args A;
    A.Q = qb + (tok0 + (size_t)j0 * dil) * 1024 + h * 128;
    A.K = kb + tok0 * 1024 + h * 128; A.Kr = nullptr;
    A.V = vb + tok0 * 1024 + h * 128;
    A.O = Op + ((size_t)pat * T + tok0 + (size_t)j0 * dil) * 1024 + h * 128;
    A.lse = lse + ((size_t)pat * T + tok0 + (size_t)j0 * dil) * 8 + h; A.ldlse = (long)dil * 8;
    A.nt = 6; A.kb0 = j0 - 64; A.L = L; A.biasG = bt + (pat * 8 + h) * 129;
    A.C = 0.08838834764831845f * 1.4426950408889634f; A.thr = 11.5f;
    if (pat == 0) at::attn_body<8, true, 1024, 1024, 1024>(A, lds);
    else if (pat == 1) at::attn_body<8, true, 4096, 4096, 4096>(A, lds);
    else at::attn_body<8, true, 16384, 16384, 16384>(A, lds);
  }
}
__device__ __forceinline__ void mla_phase(const Params& p, char* lds) {
  const bf16_t* Qp = (const bf16_t*)(p.ws + O_RB); const bf16_t* kv = (const bf16_t*)(p.ws + O_RH); const bf16_t* kr = (const bf16_t*)(p.ws + O_RA) + (size_t)T * 1024;
  bf16_t* cat = (bf16_t*)(p.ws + O_RF);
  for (int it = blockIdx.x; it < 512 + 256; it += gridDim.x) {
    int s0, len, h, qb_;
    { const int rnd = it >> 8, v = it & 255, slot = v >> 3; h = v & 7;
      if (rnd < 2) { s0 = 8192; len = 16384; qb_ = rnd * 32 + slot; }
      else { s0 = (slot >> 4) * 4096; len = 4096; qb_ = slot & 15; } }
    at::Args A;
    A.Q = Qp + (size_t)(s0 + qb_ * 256) * 1536 + h * 192;
    A.K = kv + (size_t)s0 * 2048 + h * 256; A.Kr = kr + (size_t)s0 * 64;
    A.V = A.K + 128;
    A.O = cat + (size_t)(s0 + qb_ * 256) * 2048 + h * 128;
    A.lse = nullptr; A.ldlse = 0; A.nt = len / 64; A.kb0 = 0; A.L = len; A.biasG = nullptr;
    A.C = 0.07216878364870322f * 1.4426950408889634f; A.thr = 8.f / 0.07216878364870322f;
    at::attn_body<12, false, 1536, 2048, 2048>(A, lds);
  }
}

template <class Epi>
__device__ __forceinline__ void gemm_simple(unsigned char* lds, const pg8::Gemm g, const pg8::StaticOrder& S, const Epi& E) {
  using namespace pg8;
  const int tid = tidx(), wid = tid >> 6, lane = tid & 63, wr = wid >> 2, wc = wid & 3, fr = lane & 15, fq = lane >> 4;
  const int K = g.K, nt = K / BK;
  unsigned offA[2], offB[2];
#pragma unroll
  for (int i = 0; i < 2; ++i) { int R, C; stage_rc(tid * 16 + i * 8192, R, C); const int Rb = Epi::PERM ? ((R & ~31) + perm32(R & 31)) : R;
    offA[i] = (unsigned)(R * K + C); offB[i] = (unsigned)(Rb * K + C); }
  const int aoff = lds_byte(wr * 64 + fr, fq * 8), boff = lds_byte(wc * 32 + fr, fq * 8);
  unsigned char* myst = lds + tid * 16;
  Unit u;
  for (int ui = 0; S.next(ui, u); ++ui) {
    f32x4 acc[2][2][4][2];
#pragma unroll
    for (int a = 0; a < 2; ++a)
#pragma unroll
      for (int b = 0; b < 2; ++b)
#pragma unroll
        for (int m = 0; m < 4; ++m)
#pragma unroll
          for (int n = 0; n < 2; ++n) acc[a][b][m][n] = (f32x4){0.f, 0.f, 0.f, 0.f};
    const bf16_t* Ab = g.A + (size_t)u.pm * 256 * K; const bf16_t* Bb = g.Bt + (size_t)u.pn * 256 * K;
    const size_t hK = (size_t)128 * K;
    bf16x8 sg[2][2];
#define GLOADX(P, off, kt) do { _Pragma("unroll") for (int h = 0; h < 2; ++h) _Pragma("unroll") for (int i = 0; i < 2; ++i) \
      sg[h][i] = *(const bf16x8*)((P) + h * hK + (off)[i] + (size_t)(kt) * BK); } while (0)
#define SWRITEX(base, b) do { _Pragma("unroll") for (int h = 0; h < 2; ++h) _Pragma("unroll") for (int i = 0; i < 2; ++i) \
      *(bf16x8*)(myst + ((base) + (b) * 2 + h) * HTB + i * 8192) = sg[h][i]; } while (0)
    GLOADX(Ab, offA, 0); SWRITEX(0, 0); GLOADX(Bb, offB, 0); SWRITEX(4, 0); __syncthreads();
    for (int kt = 0; kt < nt; ++kt) {
      const int b = kt & 1; const bool more = kt + 1 < nt;
#pragma unroll
      for (int k = 0; k < 2; ++k) {
        if (more) { if (k == 0) GLOADX(Ab, offA, kt + 1); else GLOADX(Bb, offB, kt + 1); }
        __builtin_amdgcn_sched_barrier(0);
        bf16x8 B0[2], B1[2];
#pragma unroll
        for (int n = 0; n < 2; ++n) { B0[n] = *(const bf16x8*)(lds + (4 + b * 2 + 0) * HTB + boff + n * 2048 + k * 1024); B1[n] = *(const bf16x8*)(lds + (4 + b * 2 + 1) * HTB + boff + n * 2048 + k * 1024); }
#pragma unroll
        for (int ai = 0; ai < 2; ++ai) {
#pragma unroll
          for (int m = 0; m < 4; ++m) {
            const bf16x8 At = *(const bf16x8*)(lds + (b * 2 + ai) * HTB + aoff + m * 2048 + k * 1024);
#pragma unroll
            for (int n = 0; n < 2; ++n) {
              acc[ai][0][m][n] = __builtin_amdgcn_mfma_f32_16x16x32_bf16(B0[n], At, acc[ai][0][m][n], 0, 0, 0);
              acc[ai][1][m][n] = __builtin_amdgcn_mfma_f32_16x16x32_bf16(B1[n], At, acc[ai][1][m][n], 0, 0, 0); }
          }
          __builtin_amdgcn_sched_barrier(0);
        }
        if (more) { if (k == 0) SWRITEX(0, b ^ 1); else SWRITEX(4, b ^ 1); }
      }
      __syncthreads();
    }
#undef GLOADX
#undef SWRITEX
    E(acc, u, wr, wc, fr, fq);
  }
}
template <class Epi> __device__ __forceinline__ void run_gemm(unsigned char* lds, const bf16_t* A, const bf16_t* Bt, int N, int K, const Epi& E) {
  pg8::Gemm g{A, Bt, T, N, K}; pg8::StaticOrder S;
  S.init(T, N, (int)gridDim.x, (int)blockIdx.x);
  pg8::gemm_phase<Epi, pg8::StaticOrder, false>((PG8_LAS unsigned char*)lds, g, S, E, nullptr);
  __syncthreads();
}
template <class Epi> __device__ __forceinline__ void run_gemm_small(unsigned char* lds, const bf16_t* A, const bf16_t* Bt, int N, int K, const Epi& E) {
  pg8::Gemm g{A, Bt, T, N, K}; pg8::StaticOrder S;
  S.init(T, N, (int)gridDim.x, (int)blockIdx.x);
  gemm_simple<Epi>(lds, g, S, E);
  __syncthreads();
}

__device__ __forceinline__ Params ldp() { auto k = __builtin_amdgcn_kernarg_segment_ptr(); asm volatile("" : "+s"(k)); Params q; __builtin_memcpy(&q, k, sizeof(Params)); return q; }
__device__ __forceinline__ void gbar(unsigned* ctr, unsigned target) {
  __syncthreads();
  if (threadIdx.x == 0) {
    __threadfence();
    __hip_atomic_fetch_add(ctr, 1u, __ATOMIC_RELEASE, __HIP_MEMORY_SCOPE_AGENT);
    while (__hip_atomic_load(ctr, __ATOMIC_ACQUIRE, __HIP_MEMORY_SCOPE_AGENT) < target) __builtin_amdgcn_s_sleep(2);
    __threadfence();
  }
  __syncthreads();
}
#define PHASE(...) do { if (ph >= pk.ph_lo && ph < pk.ph_hi) { const Params p = ldp(); unsigned char* ws = p.ws; WSPTRS; __VA_ARGS__; } ++ph; \
    if (ph > pk.ph_lo && ph < pk.ph_hi) { gbar((unsigned*)(pk.ws + WS_END), (unsigned)ph * gridDim.x); } } while (0)
#define WSPTRS bf16_t* WM = (bf16_t*)(ws + O_WM); bf16_t* WF = (bf16_t*)(ws + O_RF); \
  float* rinv = (float*)(ws + S_RINV); float* rinvq = (float*)(ws + S_RINVQ); float* rinvkv = (float*)(ws + S_RINVKV); \
  const float* cs = (const float*)(ws + S_COS); const float* sn = (const float*)(ws + S_SIN); \
  bf16_t* mix = (bf16_t*)(ws + O_RA); bf16_t* xb = (bf16_t*)(ws + O_RC); bf16_t* act = (bf16_t*)(ws + O_RD); \
  const int i = layer >> 1; const float* ng = p.norm_g + (size_t)layer * 4 * DM; const float* mu = p.mu + (size_t)i * 6 * DM; \
  bf16_t* cq = (bf16_t*)(ws + O_RA); bf16_t* ckv = cq + (size_t)T * 512; bf16_t* kr = cq + (size_t)T * 1024; \
  bf16_t* qb = (bf16_t*)(ws + O_RD); bf16_t* kb = qb + (size_t)T * 1024; bf16_t* vb = kb + (size_t)T * 1024; \
  bf16_t* Qp = (bf16_t*)(ws + O_RB); bf16_t* kv = (bf16_t*)(ws + O_RH); bf16_t* cat = (bf16_t*)(ws + O_RF); \
  bf16_t* m0 = (bf16_t*)(ws + O_RD); bf16_t* m1 = (bf16_t*)(ws + O_RE); bf16_t* m2 = (bf16_t*)(ws + O_RX); \
  bf16_t* rB = (bf16_t*)(ws + O_RA); bf16_t* kB = (bf16_t*)(ws + O_RB); bf16_t* vB = (bf16_t*)(ws + O_RC); \
  bf16_t* gl = (bf16_t*)(ws + S_GL); bf16_t* wl = (bf16_t*)(ws + S_WL); bf16_t* al = (bf16_t*)(ws + S_AL); \
  bf16_t* eB = (bf16_t*)(ws + O_RD); bf16_t* aB = (bf16_t*)(ws + O_RX); bf16_t* gB = (bf16_t*)(ws + O_RD); bf16_t* yg = (bf16_t*)(ws + O_RH); \
  (void)WM; (void)WF; (void)rinv; (void)rinvq; (void)rinvkv; (void)cs; (void)sn; (void)mix; (void)xb; (void)act; (void)i; (void)ng; (void)mu; (void)cq; (void)ckv; (void)kr; (void)qb; (void)kb; (void)vb; \
  (void)Qp; (void)kv; (void)cat; (void)m0; (void)m1; (void)m2; (void)rB; (void)kB; (void)vB; (void)gl; (void)wl; (void)al; (void)eB; (void)aB; (void)gB; (void)yg
template <int layer> __device__ __forceinline__ void layer_fn(const Params& pk, unsigned char* lds, cg::grid_group& grid, int& ph) {
    if constexpr ((layer & 1) == 0) {
      PHASE(pg8::EpiIn E{cq, ckv, qb, kb, vb, kr, rinv, cs, sn}; run_gemm(lds, xb, WM + WA_IN, 4352, 2048, E));
      PHASE(rownorm_phase(p); dilated_phase(p, (char*)lds));
      PHASE(pg8::EpiUQ E1{Qp, rinvq, cs, sn}; run_gemm(lds, cq, WM + WA_UQ, 1536, 512, E1);
            pg8::EpiB<0> E2{kv, 2048, nullptr, rinvkv}; run_gemm(lds, ckv, WM + WA_UKV, 2048, 512, E2));
      PHASE(mla_phase(p, (char*)lds); combine_phase(p));
      PHASE(pg8::EpiB<0> E{mix, 2048, nullptr, nullptr}; run_gemm(lds, cat, WM + WA_OUT, 2048, 2048, E));
    } else {
      PHASE(mix_phase(p, ng, mu, 1, 4, 5));
      PHASE(pg8::EpiLora E{wl, al, gl}; pg8::Gemm g3{m0, WM + WR_W1, 3 * T, 768, 2048}; pg8::LoraOrder S3{(int)blockIdx.x};
            pg8::gemm_phase<pg8::EpiLora, pg8::LoraOrder, false>((PG8_LAS unsigned char*)lds, g3, S3, E, nullptr); __syncthreads());
      PHASE(mix_phase(p, ng, mu, 0, 2, 3));
      PHASE(pg8::EpiB<0> E1{rB, 2048, nullptr, nullptr}; run_gemm(lds, m0, WM + WR_R, 2048, 2048, E1);
            pg8::EpiB<0> E2{kB, 2048, nullptr, nullptr}; run_gemm(lds, m1, WM + WR_K, 2048, 2048, E2);
            pg8::EpiB<0> E3{vB, 2048, nullptr, nullptr}; run_gemm(lds, m2, WM + WR_V, 2048, 2048, E3));
      PHASE(pg8::EpiB<0> E1{eB, 4096, nullptr, nullptr}; run_gemm(lds, wl, WM + WR_W2, 4096, 256, E1);
            pg8::EpiB<0> E2{aB, 4096, nullptr, nullptr}; run_gemm(lds, al, WM + WR_A2, 4096, 256, E2));
      PHASE(scan_phase(p, i, lds));
      PHASE(pg8::EpiB<0> E{gB, 2048, nullptr, nullptr}; run_gemm(lds, gl, WM + WR_G2, 2048, 256, E));
      PHASE(postscan_phase(p, i));
      PHASE(pg8::EpiB<0> E{mix, 2048, nullptr, nullptr}; run_gemm(lds, yg, WM + WR_O, 2048, 2048, E));
    }
    PHASE(resid_phase(p, mix, ng + DM); convert_ffn_weights(p, layer, (float*)lds));
    PHASE(pg8::EpiSwi E{act, rinv}; run_gemm(lds, xb, WF + WF_GU, 11264, 2048, E));
    PHASE(pg8::EpiB<0> E{mix, 2048, nullptr, nullptr}; run_gemm(lds, act, WF + WF_DN, 2048, 5632, E));
    PHASE(resid_phase(p, mix, ng + 3 * DM); if (layer < 3) convert_mixer_weights(p, layer + 1, (float*)lds));
  }
__global__ void __launch_bounds__(512, 2) mega(Params pk) {
  constexpr int layer = 0;
  extern __shared__ __attribute__((aligned(16))) unsigned char lds[];
  cg::grid_group grid = cg::this_grid();
  int ph = 0;
  grid.sync();
  PHASE(resid_phase(p, nullptr, nullptr); tables_phase(p); convert_mixer_weights(p, 0, (float*)lds));
  layer_fn<0>(pk, lds, grid, ph); layer_fn<1>(pk, lds, grid, ph); layer_fn<2>(pk, lds, grid, ph); layer_fn<3>(pk, lds, grid, ph);
}
#undef PHASE
#undef WSPTRS

extern "C" void kernel_launch(void* const* d_in, const int* in_sizes, int n_in, void* d_out, int out_size, void* d_ws, size_t ws_size, hipStream_t stream) {
  static int grid_blocks = 0;
  if (!grid_blocks) {
    int dev = 0, cus = 0, per_cu = 0;
    (void)hipGetDevice(&dev);
    (void)hipDeviceGetAttribute(&cus, hipDeviceAttributeMultiprocessorCount, dev);
    (void)hipFuncSetAttribute((const void*)mega, hipFuncAttributeMaxDynamicSharedMemorySize, LDS_BYTES);
    (void)hipOccupancyMaxActiveBlocksPerMultiprocessor(&per_cu, mega, 512, LDS_BYTES);
    if (per_cu < 1) { fprintf(stderr, "occupancy query returned %d\n", per_cu); per_cu = 1; }
    grid_blocks = cus;
  }
  if (n_in != 31 || ws_size < WS_END + 256) { fprintf(stderr, "kernel_launch: unexpected n_in %d / ws_size %zu\n", n_in, ws_size); return; }
  Params p{};
  const float** f = (const float**)&p;
  for (int k = 0; k < 31; ++k) f[k] = (const float*)d_in[k];
  p.out = (float*)d_out; p.ws = (unsigned char*)d_ws; p.ph_lo = 0; p.ph_hi = 1000;
#ifdef MULTI_LAUNCH
  for (int ph = 0; ph < NPH_RUN; ++ph) { p.ph_lo = ph; p.ph_hi = ph + 1; hipLaunchKernelGGL(mega, dim3(grid_blocks), dim3(512), LDS_BYTES, stream, p); }
#else
  (void)hipMemsetAsync((unsigned char*)d_ws + WS_END, 0, 256, stream);
  void* args[] = {&p};
  hipError_t e = hipLaunchCooperativeKernel((void*)mega, dim3(grid_blocks), dim3(512), args, LDS_BYTES, stream);
  if (e != hipSuccess) fprintf(stderr, "cooperative launch failed: %s (grid %d)\n", hipGetErrorString(e), grid_blocks);
#endif
}
```

```cpp
#include <hip/hip_runtime.h>
#include <hip/hip_cooperative_groups.h>
#include <cstdio>
#include <cstdint>
namespace cg = cooperative_groups;
__device__ __forceinline__ int tidx() { int t = threadIdx.x; asm volatile("" : "+v"(t)); return t; }
namespace pg8 {
#define PG8_LAS __attribute__((address_space(3)))
typedef unsigned short bf16_t;
typedef short bf16x8 __attribute__((ext_vector_type(8)));
typedef float f32x4 __attribute__((ext_vector_type(4)));
typedef unsigned u32x4 __attribute__((ext_vector_type(4)));
constexpr int BM = 256, BK = 64, HALF = 128, HTB = HALF * BK * 2  , STAGE_BYTES = 8 * HTB, NXCD = 8, WGM = 8;

__host__ __device__ __forceinline__ int lds_byte(int r, int c) { const int st = (r >> 4) * 2 + (c >> 5), rr = r & 15, cc = c & 31, ob = rr * 64 + cc * 2; return st * 1024 + (ob ^ (((ob >> 9) & 1) << 5)); }
__host__ __device__ __forceinline__ void stage_rc(int b, int& R, int& C) { const int st = b / 1024, sb = b % 1024, swz = sb ^ (((sb >> 9) & 1) << 5); R = (st >> 1) * 16 + swz / 64; C = (st & 1) * 32 + (swz % 64) / 2; }
__host__ __device__ __forceinline__ int perm32(int rho) { const int n = rho >> 4, i = rho & 15; return 8 * (i >> 2) + 4 * n + (i & 3); }

struct Unit { int pm, pn; };
struct Gemm { const bf16_t* A; const bf16_t* Bt; int M, N, K; };

struct StaticOrder {
    int nM, nN, nwg, G, c;
    __host__ __device__ void init(int M, int N, int G_, int c_) { nM = M / BM; nN = N / BM; nwg = nM * nN; G = G_; c = c_; }
    __host__ __device__ bool next(int i, Unit& u) const {
        const long L = (long)i * G + c; if (L >= nwg) return false;
        int wgid = (int)L; { const int q = nwg / NXCD, r = nwg % NXCD, xcd = wgid % NXCD, off = wgid / NXCD; wgid = (xcd < r ? xcd * (q + 1) : r * (q + 1) + (xcd - r) * q) + off; }
        const int nig = WGM * nN, gid = wgid / nig, fm = gid * WGM, gsz = (nM - fm) < WGM ? (nM - fm) : WGM;
        u.pm = fm + ((wgid % nig) % gsz); u.pn = (wgid % nig) / gsz; return true;
    }
    __device__ __forceinline__ void a_ready(const Unit&) const {}
    __device__ __forceinline__ void done(const Unit&) const {}
};
__device__ __forceinline__ unsigned cvt_pk_bf16(float lo, float hi) { unsigned r; asm volatile("v_cvt_pk_bf16_f32 %0, %1, %2" : "=v"(r) : "v"(lo), "v"(hi)); return r; }
typedef float f32x2 __attribute__((ext_vector_type(2)));
template <class Epi, class Sched, bool STAMP = false>
__device__ __forceinline__ void gemm_phase(PG8_LAS unsigned char* lds, const Gemm g, const Sched& S, const Epi& E, unsigned long long* stamps) {
    const int tid = tidx(), wid = __builtin_amdgcn_readfirstlane(tid >> 6), lane = tid & 63, wr = wid >> 2, wc = wid & 3, fr = lane & 15, fq = lane >> 4;
    const int K = g.K, nt = K / BK;
    int ts_lo = 0, ts_hi = 0, nts = 0; const unsigned long long rt_entry = STAMP ? (unsigned long long)wall_clock64() : 0ull;
#define PG8_STAMP() do { if (STAMP && wid == 0 && nts < 64) { const unsigned long long _c = (unsigned long long)clock64(); \
        ts_lo = (lane == nts) ? (int)(unsigned)_c : ts_lo; ts_hi = (lane == nts) ? (int)(unsigned)(_c >> 32) : ts_hi; ++nts; } } while (0)
    PG8_STAMP();
    unsigned voffA[2], voffB[2];
#pragma unroll
    for (int i = 0; i < 2; ++i) { int R, C; stage_rc(tid * 16 + i * 8192, R, C); const int Rb = Epi::PERM ? ((R & ~31) + perm32(R & 31)) : R;
        voffA[i] = (unsigned)(R * K + C) * 2u; voffB[i] = (unsigned)(Rb * K + C) * 2u; }
    const size_t kstep = (size_t)(BK * 2);
    const size_t hstep = (size_t)HALF * K * 2;
    const size_t tstep = 2 * hstep;
    const unsigned ldsw = (unsigned)wid * 1024u;
    const int aoff = lds_byte(wr * 64 + fr, fq * 8), boff = lds_byte(wc * 32 + fr, fq * 8);
#define PG8_SA(b, h) (((b) * 2 + (h)) * HTB)
#define PG8_SB(b, h) ((4 + (b) * 2 + (h)) * HTB)
#define PG8_STAGE(bufoff, gbase, voff) do { _Pragma("unroll") for (int _i = 0; _i < 2; ++_i) \
        __builtin_amdgcn_global_load_lds((const unsigned*)((const char*)(gbase) + (voff)[_i]), (PG8_LAS unsigned*)(lds + (bufoff) + ldsw + _i * 8192), 16, 0, 0); } while (0)
#define PG8_LDA(dst, b, h) do { _Pragma("unroll") for (int m = 0; m < 4; ++m) _Pragma("unroll") for (int k = 0; k < 2; ++k) dst[m][k] = *(const PG8_LAS bf16x8*)(lds + PG8_SA(b, h) + aoff + m * 2048 + k * 1024); } while (0)
#define PG8_LDB(dst, b, h) do { _Pragma("unroll") for (int n = 0; n < 2; ++n) _Pragma("unroll") for (int k = 0; k < 2; ++k) dst[n][k] = *(const PG8_LAS bf16x8*)(lds + PG8_SB(b, h) + boff + n * 2048 + k * 1024); } while (0)
#define PG8_MMA(ai, bj, At, Bt) do { __builtin_amdgcn_s_setprio(1); _Pragma("unroll") for (int m = 0; m < 4; ++m) _Pragma("unroll") for (int n = 0; n < 2; ++n) _Pragma("unroll") for (int k = 0; k < 2; ++k) \
        acc[ai][bj][m][n] = __builtin_amdgcn_mfma_f32_16x16x32_bf16(Bt[n][k], At[m][k], acc[ai][bj][m][n], 0, 0, 0); __builtin_amdgcn_s_setprio(0); } while (0)
#define PG8_WAIT_V(n) asm volatile("s_waitcnt vmcnt(" #n ")" ::: "memory")
#define PG8_WAIT_L(n) asm volatile("s_waitcnt lgkmcnt(" #n ")" ::: "memory")
#define PG8_BAR __builtin_amdgcn_s_barrier()
#define PG8_SCHED __builtin_amdgcn_sched_barrier(0)
    Unit cur, nxt; int ui = 0;
    if (!S.next(0, cur)) return;
    f32x4 acc[2][2][4][2];
#pragma unroll
    for (int a = 0; a < 2; ++a)
#pragma unroll
        for (int b = 0; b < 2; ++b)
#pragma unroll
            for (int m = 0; m < 4; ++m)
#pragma unroll
                for (int n = 0; n < 2; ++n) acc[a][b][m][n] = (f32x4){0.f, 0.f, 0.f, 0.f};
    bf16x8 At[4][2], B0[2][2], B1[2][2];
    const char* cA = (const char*)g.A + (size_t)cur.pm * tstep; const char* cB = (const char*)g.Bt + (size_t)cur.pn * tstep;
    S.a_ready(cur);
    PG8_STAGE(PG8_SB(0, 0), cB, voffB); PG8_STAGE(PG8_SA(0, 0), cA, voffA); PG8_STAGE(PG8_SB(0, 1), cB + hstep, voffB); PG8_STAGE(PG8_SA(0, 1), cA + hstep, voffA);
    if (wr == 1) PG8_BAR;
    PG8_WAIT_V(4); PG8_BAR;
    PG8_STAGE(PG8_SB(1, 0), cB + kstep, voffB); PG8_STAGE(PG8_SA(1, 0), cA + kstep, voffA); PG8_STAGE(PG8_SB(1, 1), cB + hstep + kstep, voffB);
    PG8_WAIT_V(6); PG8_BAR;
    PG8_STAMP();
    for (;;) {
        const bool has_next = S.next(ui + 1, nxt);
        const char* nA = has_next ? (const char*)g.A + (size_t)nxt.pm * tstep : cA; const char* nB = has_next ? (const char*)g.Bt + (size_t)nxt.pn * tstep : cB;
        for (int t = 0; t < nt; t += 2) {
            const bool last = (t == nt - 2);
            const char* a1 = cA + (size_t)(t + 1) * kstep;
            const char* a2 = last ? nA : cA + (size_t)(t + 2) * kstep; const char* b2 = last ? nB : cB + (size_t)(t + 2) * kstep;
            const char* a3 = a2 + kstep; const char* b3 = b2 + kstep;
            if (last && has_next) S.a_ready(nxt);
            PG8_LDB(B0, 0, 0); PG8_SCHED; PG8_LDA(At, 0, 0); PG8_STAGE(PG8_SA(1, 1), a1 + hstep, voffA);
            PG8_WAIT_L(8); PG8_BAR; PG8_WAIT_L(0); PG8_MMA(0, 0, At, B0); PG8_BAR; PG8_SCHED;
            PG8_LDB(B1, 0, 1); PG8_STAGE(PG8_SB(0, 0), b2, voffB);
            PG8_BAR; PG8_WAIT_L(0); PG8_MMA(0, 1, At, B1); PG8_BAR;
            PG8_LDA(At, 0, 1); PG8_STAGE(PG8_SA(0, 0), a2, voffA);
            PG8_BAR; PG8_WAIT_L(0); PG8_MMA(1, 0, At, B0); PG8_BAR; PG8_SCHED;
            PG8_STAGE(PG8_SB(0, 1), b2 + hstep, voffB);
            PG8_WAIT_V(6); PG8_BAR; PG8_MMA(1, 1, At, B1); PG8_BAR;
            PG8_LDB(B0, 1, 0); PG8_SCHED; PG8_LDA(At, 1, 0); PG8_STAGE(PG8_SA(0, 1), a2 + hstep, voffA);
            PG8_WAIT_L(8); PG8_BAR; PG8_WAIT_L(0); PG8_MMA(0, 0, At, B0); PG8_BAR; PG8_SCHED;
            PG8_LDB(B1, 1, 1); PG8_STAGE(PG8_SB(1, 0), b3, voffB);
            PG8_BAR; PG8_WAIT_L(0); PG8_MMA(0, 1, At, B1); PG8_BAR;
            PG8_LDA(At, 1, 1); PG8_STAGE(PG8_SA(1, 0), a3, voffA);
            PG8_BAR; PG8_WAIT_L(0); PG8_MMA(1, 0, At, B0); PG8_BAR; PG8_SCHED;
            PG8_STAGE(PG8_SB(1, 1), b3 + hstep, voffB);
            PG8_WAIT_V(6); PG8_BAR; PG8_MMA(1, 1, At, B1); PG8_BAR;
        }
        PG8_STAMP();
        if constexpr (!Epi::AFTER_DRAIN) { E(acc, cur, wr, wc, fr, fq); S.done(cur); }
        PG8_STAMP();
        if (!has_next) break;
#pragma unroll
        for (int a = 0; a < 2; ++a)
#pragma unroll
            for (int b = 0; b < 2; ++b)
#pragma unroll
                for (int m = 0; m < 4; ++m)
#pragma unroll
                    for (int n = 0; n < 2; ++n) acc[a][b][m][n] = (f32x4){0.f, 0.f, 0.f, 0.f};
        cur = nxt; cA = nA; cB = nB; ++ui;
    }
    PG8_WAIT_V(0);
    if (wr == 0) PG8_BAR;
    PG8_BAR;
    if constexpr (Epi::AFTER_DRAIN) { E.fused(acc, cur, wr, wc, fr, fq, lds, wid, lane); S.done(cur); }
    PG8_STAMP();
    if (STAMP && wid == 0) { stamps[lane] = lane < nts ? (((unsigned long long)(unsigned)ts_hi << 32) | (unsigned)ts_lo) : 0ull;
        if (lane == 62) stamps[62] = rt_entry; if (lane == 63) stamps[63] = (unsigned long long)wall_clock64(); }
#undef PG8_STAMP
#undef PG8_SA
#undef PG8_SB
#undef PG8_STAGE
#undef PG8_LDA
#undef PG8_LDB
#undef PG8_MMA
#undef PG8_WAIT_V
#undef PG8_WAIT_L
#undef PG8_BAR
#undef PG8_SCHED
}
}
namespace pg8 {
__device__ __forceinline__ float fsig(float x) { return __builtin_amdgcn_rcpf(1.f + __expf(-x)); }
__device__ __forceinline__ float ftanh(float x) { return 1.f - 2.f * __builtin_amdgcn_rcpf(1.f + __expf(2.f * x)); }
__device__ __forceinline__ int seq_start(int t) { return t < 4096 ? 0 : (t < 8192 ? 4096 : 8192); }

struct EpiF32 {
    static constexpr bool PERM = false, AFTER_DRAIN = false;
    float* C; int ldc;
    __device__ __forceinline__ void operator()(const f32x4 (&acc)[2][2][4][2], const Unit& u, int wr, int wc, int fr, int fq) const {
        const int row0 = u.pm * BM + wr * 64 + fr, col0 = u.pn * BM + wc * 32 + 4 * fq;
#pragma unroll
        for (int ai = 0; ai < 2; ++ai)
#pragma unroll
            for (int m = 0; m < 4; ++m) { float* rowp = C + (size_t)(row0 + ai * HALF + m * 16) * ldc + col0;
#pragma unroll
                for (int bj = 0; bj < 2; ++bj)
#pragma unroll
                    for (int n = 0; n < 2; ++n) *(f32x4*)(rowp + bj * HALF + n * 16) = acc[ai][bj][m][n]; }
    }
};
template <int ACT> struct EpiB {
    static constexpr bool PERM = true, AFTER_DRAIN = false;
    bf16_t* O; int ldc; const float* bias; const float* rs;
    __device__ __forceinline__ f32x4 actf(f32x4 v) const {
#pragma unroll
        for (int j = 0; j < 4; ++j) {
            if (ACT == 1) v[j] = 0.5f + 0.5f * ftanh(0.5f * v[j]);
            if (ACT == 2) v[j] = ftanh(v[j]);
            if (ACT == 3) v[j] = 0.6065306597f * fsig(v[j]); }
        return v; }
    __device__ __forceinline__ void operator()(const f32x4 (&acc)[2][2][4][2], const Unit& u, int wr, int wc, int fr, int fq) const {
        const int row0 = u.pm * BM + wr * 64 + fr; const int col0 = u.pn * BM + wc * 32 + 8 * fq;
#pragma unroll
        for (int bj = 0; bj < 2; ++bj) {
#pragma unroll
            for (int ai = 0; ai < 2; ++ai)
#pragma unroll
                for (int m = 0; m < 4; ++m) { const int row = row0 + ai * HALF + m * 16; const float s = rs ? rs[row] : 1.f;
                    f32x4 v0 = acc[ai][bj][m][0] * s; if (bias) v0 += *(const f32x4*)(bias + col0 + bj * HALF); v0 = actf(v0);
                    u32x4 w; w.x = cvt_pk_bf16(v0[0], v0[1]); w.y = cvt_pk_bf16(v0[2], v0[3]);
                    f32x4 v1 = acc[ai][bj][m][1] * s; if (bias) v1 += *(const f32x4*)(bias + col0 + bj * HALF + 4); v1 = actf(v1);
                    w.z = cvt_pk_bf16(v1[0], v1[1]); w.w = cvt_pk_bf16(v1[2], v1[3]);
                    *(u32x4*)(O + (size_t)row * ldc + col0 + bj * HALF) = w; __builtin_amdgcn_sched_barrier(0); } }
    }
};
struct EpiIn {
    static constexpr bool PERM = true, AFTER_DRAIN = false;
    bf16_t *cq, *ckv, *qb, *kb, *vb, *kr; const float* rs; const float* cs; const float* sn;
    __device__ __forceinline__ void operator()(const f32x4 (&acc)[2][2][4][2], const Unit& u, int wr, int wc, int fr, int fq) const {
        const int row0 = u.pm * BM + wr * 64 + fr; const int pn = u.pn;
        if (pn < 16) {
            bf16_t* base; int ldc, colt;
            if (pn < 2) { base = cq; ldc = 512; colt = pn * 256; } else if (pn < 4) { base = ckv; ldc = 512; colt = (pn - 2) * 256; }
            else if (pn < 8) { base = qb; ldc = 1024; colt = (pn - 4) * 256; } else if (pn < 12) { base = kb; ldc = 1024; colt = (pn - 8) * 256; }
            else { base = vb; ldc = 1024; colt = (pn - 12) * 256; }
            const int col0 = colt + wc * 32 + 8 * fq;
#pragma unroll
            for (int ai = 0; ai < 2; ++ai)
#pragma unroll
                for (int m = 0; m < 4; ++m) { const int row = row0 + ai * HALF + m * 16; const float s = rs[row];
                    bf16_t* rowp = base + (size_t)row * ldc + col0;
#pragma unroll
                    for (int bj = 0; bj < 2; ++bj) { const f32x4 v0 = acc[ai][bj][m][0] * s, v1 = acc[ai][bj][m][1] * s;
                        u32x4 w; w.x = cvt_pk_bf16(v0[0], v0[1]); w.y = cvt_pk_bf16(v0[2], v0[3]); w.z = cvt_pk_bf16(v1[0], v1[1]); w.w = cvt_pk_bf16(v1[2], v1[3]);
                        *(u32x4*)(rowp + bj * HALF) = w; } }
        } else if (wc < 2) {
            const int q = wc * 4 + fq;
#pragma unroll
            for (int ai = 0; ai < 2; ++ai)
#pragma unroll
                for (int m = 0; m < 4; ++m) { const int row = row0 + ai * HALF + m * 16; const float s = rs[row]; const int pos = row - seq_start(row);
                    const f32x4 c = *(const f32x4*)(cs + (size_t)pos * 32 + 4 * q), sv = *(const f32x4*)(sn + (size_t)pos * 32 + 4 * q);
                    const f32x4 x1 = acc[ai][0][m][0] * s, x2 = acc[ai][0][m][1] * s;
                    const f32x4 y1 = x1 * c - x2 * sv, y2 = x2 * c + x1 * sv;
                    u32x4 w; w.x = cvt_pk_bf16(y1[0], y1[1]); w.y = cvt_pk_bf16(y1[2], y1[3]); w.z = cvt_pk_bf16(y2[0], y2[1]); w.w = cvt_pk_bf16(y2[2], y2[3]);
                    *(u32x4*)(kr + (size_t)row * 64 + 8 * q) = w; }
        }
    }
};
struct EpiUQ {
    static constexpr bool PERM = true, AFTER_DRAIN = false;
    bf16_t* O; const float* rs; const float* cs; const float* sn;
    __device__ __forceinline__ void operator()(const f32x4 (&acc)[2][2][4][2], const Unit& u, int wr, int wc, int fr, int fq) const {
        const int row0 = u.pm * BM + wr * 64 + fr; const int col0 = u.pn * BM + wc * 32 + 8 * fq;
        const int q = (wc & 1) * 4 + fq;
#pragma unroll
        for (int ai = 0; ai < 2; ++ai)
#pragma unroll
            for (int m = 0; m < 4; ++m) { const int row = row0 + ai * HALF + m * 16; const float s = rs[row]; const int pos = row - seq_start(row);
                bf16_t* rowp = O + (size_t)row * 1536 + col0;
#pragma unroll
                for (int bj = 0; bj < 2; ++bj) { f32x4 v0 = acc[ai][bj][m][0] * s, v1 = acc[ai][bj][m][1] * s;
                    const int blk = u.pn * 4 + bj * 2 + (wc >> 1);
                    if (blk % 3 == 2) {
                        const f32x4 c = *(const f32x4*)(cs + (size_t)pos * 32 + 4 * q), sv = *(const f32x4*)(sn + (size_t)pos * 32 + 4 * q);
                        const f32x4 y1 = v0 * c - v1 * sv, y2 = v1 * c + v0 * sv; v0 = y1; v1 = y2; }
                    u32x4 w; w.x = cvt_pk_bf16(v0[0], v0[1]); w.y = cvt_pk_bf16(v0[2], v0[3]); w.z = cvt_pk_bf16(v1[0], v1[1]); w.w = cvt_pk_bf16(v1[2], v1[3]);
                    *(u32x4*)(rowp + bj * HALF) = w; } __builtin_amdgcn_sched_barrier(0); }
    }
};
struct EpiSwi {
    static constexpr bool PERM = true, AFTER_DRAIN = false;
    bf16_t* O; const float* rs;
    __device__ __forceinline__ void operator()(const f32x4 (&acc)[2][2][4][2], const Unit& u, int wr, int wc, int fr, int fq) const {
        const int row0 = u.pm * BM + wr * 64 + fr; const int col0 = u.pn * 128 + wc * 16 + 4 * fq;
#pragma unroll
        for (int ai = 0; ai < 2; ++ai)
#pragma unroll
            for (int m = 0; m < 4; ++m) { const int row = row0 + ai * HALF + m * 16; const float s = rs[row];
                bf16_t* rowp = O + (size_t)row * 5632 + col0;
#pragma unroll
                for (int bj = 0; bj < 2; ++bj) { const f32x4 g = acc[ai][bj][m][0] * s, up = acc[ai][bj][m][1] * s; f32x4 o;
#pragma unroll
                    for (int j = 0; j < 4; ++j) o[j] = g[j] * fsig(g[j]) * up[j];
                    uint2 w; w.x = cvt_pk_bf16(o[0], o[1]); w.y = cvt_pk_bf16(o[2], o[3]);
                    *(uint2*)(rowp + bj * 64) = w; } }
    }
};
}

namespace pg8 {
struct LoraOrder {
    int c;
    __device__ bool next(int i, Unit& u) const { if (c >= 144 || i >= 2) return false; const int id = c * 2 + i; u.pm = id; u.pn = id / 96; return true; }
    __device__ __forceinline__ void a_ready(const Unit&) const {}
    __device__ __forceinline__ void done(const Unit&) const {}
};
struct EpiLora {
    static constexpr bool PERM = true, AFTER_DRAIN = false;
    bf16_t *wl, *al, *gl;
    __device__ __forceinline__ void operator()(const f32x4 (&acc)[2][2][4][2], const Unit& u, int wr, int wc, int fr, int fq) const {
        const int pn = u.pn; bf16_t* base = pn == 0 ? wl : (pn == 1 ? al : gl);
        const int row0 = u.pm * BM - pn * 24576 + wr * 64 + fr; const int col0 = wc * 32 + 8 * fq;
        const float sc = pn == 2 ? 0.5f : 1.f, ka = pn == 2 ? 0.5f : 1.f, kb = pn == 2 ? 0.5f : 0.f;
#pragma unroll
        for (int bj = 0; bj < 2; ++bj)
#pragma unroll
            for (int ai = 0; ai < 2; ++ai)
#pragma unroll
                for (int m = 0; m < 4; ++m) { const int row = row0 + ai * HALF + m * 16;
                    f32x4 v0 = acc[ai][bj][m][0], v1 = acc[ai][bj][m][1];
#pragma unroll
                    for (int j = 0; j < 4; ++j) { const float t0 = kb + ka * ftanh(v0[j] * sc), t1 = kb + ka * ftanh(v1[j] * sc); v0[j] = pn == 1 ? v0[j] : t0; v1[j] = pn == 1 ? v1[j] : t1; }
                    u32x4 w; w.x = cvt_pk_bf16(v0[0], v0[1]); w.y = cvt_pk_bf16(v0[2], v0[3]); w.z = cvt_pk_bf16(v1[0], v1[1]); w.w = cvt_pk_bf16(v1[2], v1[3]);
                    *(u32x4*)(base + (size_t)row * 256 + col0 + bj * HALF) = w; __builtin_amdgcn_sched_barrier(0); }
    }
};
}
namespace at {
using pg8::bf16_t; using pg8::bf16x8; using pg8::u32x4;
typedef short s16x4 __attribute__((ext_vector_type(4)));
typedef float f32x16 __attribute__((ext_vector_type(16)));
constexpr int NW = 8, QBLK = 32, KVBLK = 64;
constexpr int SHM_V = KVBLK * 128 * 2, SHM_K = KVBLK * 128 * 2, SHM_R = KVBLK * 64 * 2;
constexpr int OFF_V = 0, OFF_K = 2 * SHM_V, OFF_R = OFF_K + 2 * SHM_K, OFF_WS = OFF_R + 2 * SHM_R, OFF_BIAS = OFF_WS + NW * 64 * 4, OFF_QR = OFF_BIAS + 1024, ATT_LDS = OFF_QR + 256 * 128;
#define KSWZ(row, colB) ((row) * 256 + ((colB) ^ (((row) & 7) << 4)))
#define RSWZ(row, colB) ((row) * 128 + ((colB) ^ (((row) & 7) << 4)))
#define SBAR() __builtin_amdgcn_sched_barrier(0)
__device__ __forceinline__ int crow(int r, int hi) { return (r & 3) + 8 * (r >> 2) + 4 * hi; }
__device__ __forceinline__ unsigned cvtpk(float lo, float hi) { unsigned r; asm volatile("v_cvt_pk_bf16_f32 %0, %1, %2" : "=v"(r) : "v"(lo), "v"(hi)); return r; }
__device__ __forceinline__ bf16x8 ld8(const bf16_t* p) { return *reinterpret_cast<const bf16x8*>(p); }

__device__ __forceinline__ void partialSM(f32x16& p0, f32x16& p1, float& m_reg, float& mn, float& alpha, const float C, const float thr) {
  float pmax = p0[0];
#pragma unroll
  for (int r = 1; r < 16; ++r) pmax = fmaxf(pmax, p0[r]);
#pragma unroll
  for (int r = 0; r < 16; ++r) pmax = fmaxf(pmax, p1[r]);
  { auto rr = __builtin_amdgcn_permlane32_swap(__float_as_uint(pmax), __float_as_uint(pmax), false, false);
    pmax = fmaxf(__uint_as_float(rr[0]), __uint_as_float(rr[1])); }
  if (__builtin_expect(__all(pmax - m_reg <= thr), 1)) { mn = m_reg; alpha = 1.f; }
  else { mn = fmaxf(m_reg, pmax); alpha = __builtin_amdgcn_exp2f((m_reg - mn) * C); m_reg = mn; }
  const float mnC = -mn * C;
#pragma unroll
  for (int r = 0; r < 16; ++r) p0[r] = fmaf(p0[r], C, mnC);
#pragma unroll
  for (int r = 0; r < 16; ++r) p1[r] = fmaf(p1[r], C, mnC);
#pragma unroll
  for (int r = 0; r < 16; ++r) p0[r] = __builtin_amdgcn_exp2f(p0[r]);
}
__device__ __forceinline__ void finishSM(f32x16& p0, f32x16& p1, float alpha, float& l_reg, bf16x8& pa0, bf16x8& pa1, bf16x8& pa2, bf16x8& pa3) {
#pragma unroll
  for (int r = 0; r < 16; ++r) p1[r] = __builtin_amdgcn_exp2f(p1[r]);
  float ps = 0;
#pragma unroll
  for (int r = 0; r < 16; ++r) ps += p0[r];
#pragma unroll
  for (int r = 0; r < 16; ++r) ps += p1[r];
  { auto rr = __builtin_amdgcn_permlane32_swap(__float_as_uint(ps), __float_as_uint(ps), false, false);
    ps = __uint_as_float(rr[0]) + __uint_as_float(rr[1]); }
  l_reg = l_reg * alpha + ps;
#define PK4(P, BASE, OUT) do { unsigned a0 = cvtpk(P[BASE + 0], P[BASE + 1]), a1 = cvtpk(P[BASE + 2], P[BASE + 3]);   \
    unsigned b0 = cvtpk(P[BASE + 4], P[BASE + 5]), b1 = cvtpk(P[BASE + 6], P[BASE + 7]);                              \
    auto r0 = __builtin_amdgcn_permlane32_swap(a0, b0, false, false); auto r1 = __builtin_amdgcn_permlane32_swap(a1, b1, false, false); \
    u32x4 w = {r0[0], r1[0], r0[1], r1[1]}; OUT = *reinterpret_cast<bf16x8*>(&w); } while (0)
  PK4(p0, 0, pa0); PK4(p0, 8, pa1); PK4(p1, 0, pa2); PK4(p1, 8, pa3);
#undef PK4
}
template <int NQD>
__device__ __forceinline__ void qkt(f32x16& p0, f32x16& p1, const char* Ks, const char* Rs, const bf16x8* qr, const char* Qrs, int qrow, int r32, int hi) {
  p0 = f32x16{}; p1 = f32x16{};
#pragma unroll
  for (int d0 = 0; d0 < 8; ++d0) { const int cb = (d0 * 16 + hi * 8) * 2;
    bf16x8 b0 = *reinterpret_cast<const bf16x8*>(Ks + KSWZ(r32, cb));
    bf16x8 b1 = *reinterpret_cast<const bf16x8*>(Ks + KSWZ(32 + r32, cb));
    p0 = __builtin_amdgcn_mfma_f32_32x32x16_bf16(b0, qr[d0], p0, 0, 0, 0);
    p1 = __builtin_amdgcn_mfma_f32_32x32x16_bf16(b1, qr[d0], p1, 0, 0, 0); }
  if constexpr (NQD > 8) {
#pragma unroll
    for (int d0 = 8; d0 < NQD; ++d0) { const int cb = ((d0 - 8) * 16 + hi * 8) * 2;
      bf16x8 b0 = *reinterpret_cast<const bf16x8*>(Rs + RSWZ(r32, cb));
      bf16x8 b1 = *reinterpret_cast<const bf16x8*>(Rs + RSWZ(32 + r32, cb));
      const bf16x8 qv = *reinterpret_cast<const bf16x8*>(Qrs + RSWZ(qrow, cb));
      p0 = __builtin_amdgcn_mfma_f32_32x32x16_bf16(b0, qv, p0, 0, 0, 0);
      p1 = __builtin_amdgcn_mfma_f32_32x32x16_bf16(b1, qv, p1, 0, 0, 0); }
  }
}
__device__ __forceinline__ int v_st(int k, int c) { const int kk = (k & ~0xC) | ((k & 4) << 1) | ((k & 8) >> 1); return ((kk >> 3) * 4 + (c >> 5)) * 512 + ((kk & 7) * 32 + (c & 31)) * 2; }
__device__ __forceinline__ int v_rd_base(int lane) { return ((lane & 3) << 3) | (((lane >> 2) & 3) << 6) | (((lane >> 4) & 1) << 5) | (((lane >> 5) & 1) << 8); }
constexpr int v_rd_off(int d0, int ks, int half) { return d0 * 512 + ks * 4096 + half * 2048; }
template <int OFF> __device__ __forceinline__ s16x4 tr_read(int vb) {
  s16x4 r; asm volatile("ds_read_b64_tr_b16 %0, %1 offset:%2" : "=&v"(r) : "v"(vb), "i"(OFF) : "memory"); return r;
}
template <int D0> __device__ __forceinline__ void pv_one(f32x16& od, int vb, bf16x8 pa0, bf16x8 pa1, bf16x8 pa2, bf16x8 pa3) {
  const s16x4 l0 = tr_read<v_rd_off(D0, 0, 0)>(vb), h0 = tr_read<v_rd_off(D0, 0, 1)>(vb), l1 = tr_read<v_rd_off(D0, 1, 0)>(vb), h1 = tr_read<v_rd_off(D0, 1, 1)>(vb);
  const s16x4 l2 = tr_read<v_rd_off(D0, 2, 0)>(vb), h2 = tr_read<v_rd_off(D0, 2, 1)>(vb), l3 = tr_read<v_rd_off(D0, 3, 0)>(vb), h3 = tr_read<v_rd_off(D0, 3, 1)>(vb);
  asm volatile("s_waitcnt lgkmcnt(0)" ::: "memory"); SBAR();
#define PK(L, H) (bf16x8){L[0], L[1], L[2], L[3], H[0], H[1], H[2], H[3]}
  od = __builtin_amdgcn_mfma_f32_32x32x16_bf16(pa0, PK(l0, h0), od, 0, 0, 0);
  od = __builtin_amdgcn_mfma_f32_32x32x16_bf16(pa1, PK(l1, h1), od, 0, 0, 0);
  od = __builtin_amdgcn_mfma_f32_32x32x16_bf16(pa2, PK(l2, h2), od, 0, 0, 0);
  od = __builtin_amdgcn_mfma_f32_32x32x16_bf16(pa3, PK(l3, h3), od, 0, 0, 0);
#undef PK
}
__device__ __forceinline__ void pv_d0(f32x16* o, int vb, bf16x8 pa0, bf16x8 pa1, bf16x8 pa2, bf16x8 pa3) {
  pv_one<0>(o[0], vb, pa0, pa1, pa2, pa3); pv_one<1>(o[1], vb, pa0, pa1, pa2, pa3); pv_one<2>(o[2], vb, pa0, pa1, pa2, pa3); pv_one<3>(o[3], vb, pa0, pa1, pa2, pa3);
}

struct Args {
  const bf16_t* Q;
  const bf16_t* K;
  const bf16_t* Kr;
  const bf16_t* V;
  bf16_t* O;
  float* lse; long ldlse;
  int nt;
  int kb0, L;
  const float* biasG;
  float C, thr;
};

template <int NQD, bool DIL, long LDQ, long LDK, long LDO>
__device__ __forceinline__ void attn_body(const Args& A, char* lds) {
  const int tid = tidx(), wid = tid >> 6, lane = tid & 63, r32 = lane & 31, hi = lane >> 5;
  char* V_lds = lds + OFF_V; char* K_lds = lds + OFF_K; char* R_lds = lds + OFF_R;
  float* ws = (float*)(lds + OFF_WS) + wid * 64; float* li_l = ws; float* al_l = ws + 32;
  float* biasL = (float*)(lds + OFF_BIAS);
  char* Qr_lds = lds + OFF_QR;
  float m_reg = -1e30f, l_reg = 0; f32x16 o[4] = {}; bf16x8 qr[8];
  const bf16_t* Qw = A.Q + (long)(wid * QBLK + r32) * LDQ + hi * 8;
#pragma unroll
  for (int d0 = 0; d0 < 8; ++d0) qr[d0] = ld8(Qw + d0 * 16);
  if constexpr (NQD > 8) {
#pragma unroll
    for (int d0 = 8; d0 < NQD; ++d0) *(bf16x8*)(Qr_lds + RSWZ(wid * 32 + r32, ((d0 - 8) * 16 + hi * 8) * 2)) = ld8(Qw + d0 * 16);
  }
  if constexpr (DIL) { if (tid < 129) biasL[tid] = A.biasG[tid]; }
  const int sr = tid >> 4, sc = (tid & 15) * 8, vst0 = v_st(sr, sc), vst1 = v_st(32 + sr, sc);
  const int rr_ = tid >> 3, rc_ = (tid & 7) * 8;
  const int vb0 = (int)(uintptr_t)V_lds + v_rd_base(lane);
  bf16x8 vs0, vs1, ks0, ks1, rs0;
  const int Lm1 = A.L - 1;
#define SLOAD(i) do { long ra, rb; if constexpr (DIL) { int a_ = A.kb0 + (i) * 64 + sr, b_ = a_ + 32; a_ = a_ < 0 ? 0 : (a_ > Lm1 ? Lm1 : a_); b_ = b_ < 0 ? 0 : (b_ > Lm1 ? Lm1 : b_); ra = a_; rb = b_; } \
      else { ra = (i) * 64 + sr; rb = ra + 32; } \
    vs0 = ld8(A.V + ra * LDK + sc); vs1 = ld8(A.V + rb * LDK + sc); ks0 = ld8(A.K + ra * LDK + sc); ks1 = ld8(A.K + rb * LDK + sc); \
    if constexpr (NQD > 8) rs0 = ld8(A.Kr + (long)((i) * 64 + rr_) * 64 + rc_); } while (0)
#define SWRITE(b) do { *(bf16x8*)(V_lds + (b) * SHM_V + vst0) = vs0; *(bf16x8*)(V_lds + (b) * SHM_V + vst1) = vs1; const int kc = sc * 2; \
    *(bf16x8*)(K_lds + (b) * SHM_K + KSWZ(sr, kc)) = ks0; *(bf16x8*)(K_lds + (b) * SHM_K + KSWZ(32 + sr, kc)) = ks1; \
    if constexpr (NQD > 8) *(bf16x8*)(R_lds + (b) * SHM_R + RSWZ(rr_, rc_ * 2)) = rs0; } while (0)
#define SWAIT() asm volatile("s_waitcnt vmcnt(0)" ::: "memory")
#define RESC(a) do { if (__any((a) < 1.f)) { if (hi == 0) al_l[r32] = (a); asm volatile("s_waitcnt lgkmcnt(0)" ::: "memory"); \
    _Pragma("unroll") for (int d = 0; d < 4; ++d) _Pragma("unroll") for (int r = 0; r < 16; ++r) o[d][r] *= al_l[crow(r, hi)]; } } while (0)
#define MASK(P0, P1, i) do { if constexpr (DIL) { const int relb = 64 * ((i) - 1) - (wid * 32 + r32); const int kpb = A.kb0 + 64 * (i); \
    _Pragma("unroll") for (int r = 0; r < 16; ++r) { const int key = crow(r, hi); \
      { const int rel = relb + key, kp = kpb + key; const bool ok = rel >= -64 && rel <= 64 && kp >= 0 && kp <= Lm1; const int ix = ok ? rel + 64 : 0; P0[r] = ok ? fmaf(P0[r], A.C, biasL[ix]) : -1e30f; } \
      { const int rel = relb + key + 32, kp = kpb + key + 32; const bool ok = rel >= -64 && rel <= 64 && kp >= 0 && kp <= Lm1; const int ix = ok ? rel + 64 : 0; P1[r] = ok ? fmaf(P1[r], A.C, biasL[ix]) : -1e30f; } } } } while (0)
  const float Csm = DIL ? 1.f : A.C; const float thr = A.thr;
  f32x16 pA0, pA1; float mnA, alA; bf16x8 pa0, pa1, pa2, pa3; const int NT = A.nt;
  {
    SLOAD(0); SWAIT(); SWRITE(0); __syncthreads();
    for (int i = 0; i < NT; ++i) {
      if constexpr (!DIL) { if (i + 1 < NT) SLOAD(i + 1); }
      SBAR();
      bool live = true;
      if constexpr (DIL) { const int k0 = 64 * (i - 1), q0 = wid * 32; live = (k0 - (q0 + 31) <= 64) && (q0 - (k0 + 63) <= 64) && (A.kb0 + 64 * i + 63 >= 0) && (A.kb0 + 64 * i <= Lm1); }
      if (live) {
      qkt<NQD>(pA0, pA1, K_lds + (i & 1) * SHM_K, R_lds + (i & 1) * SHM_R, qr, Qr_lds, wid * 32 + r32, r32, hi); MASK(pA0, pA1, i); partialSM(pA0, pA1, m_reg, mnA, alA, Csm, thr);
      RESC(alA);
      finishSM(pA0, pA1, alA, l_reg, pa0, pa1, pa2, pa3); SBAR();
      pv_d0(o, vb0 + (i & 1) * SHM_V, pa0, pa1, pa2, pa3);
      }
      if (i + 1 < NT) { if constexpr (DIL) SLOAD(i + 1); SWAIT(); SWRITE((i + 1) & 1); }
      __syncthreads();
    }
  }
  if (hi == 0) li_l[r32] = l_reg; asm volatile("s_waitcnt lgkmcnt(0)" ::: "memory");
  if constexpr (DIL) { if (hi == 0) A.lse[(long)(wid * QBLK + r32) * A.ldlse] = m_reg + __log2f(l_reg); }
  float rli[16];
#pragma unroll
  for (int r = 0; r < 16; ++r) rli[r] = __builtin_amdgcn_rcpf(li_l[crow(r, hi)]);
  bf16_t* Ow = A.O + (long)(wid * QBLK) * LDO;
#pragma unroll
  for (int r = 0; r < 16; ++r) { const int orow = crow(r, hi);
#pragma unroll
    for (int d0 = 0; d0 < 4; ++d0) { const float v = o[d0][r] * rli[r]; Ow[(long)orow * LDO + d0 * 32 + r32] = (bf16_t)(cvtpk(v, v) & 0xffffu); } }
  __syncthreads();
#undef SLOAD
#undef SWRITE
#undef SWAIT
#undef RESC
#undef MASK
}
}
using pg8::bf16_t; using pg8::bf16x8; using pg8::f32x4; using pg8::u32x4;
constexpr int T = 24576, DM = 2048, FH = 5632, NTHR = 512;
constexpr size_t MiB = 1048576;
constexpr size_t O_WM = 0, O_SM = 40 * MiB, O_RF = 104 * MiB, O_RA = 200 * MiB, O_RB = 296 * MiB, O_RC = 392 * MiB, O_RD = 488 * MiB, O_RE = 584 * MiB, O_RX = 680 * MiB,
                 O_RG = 776 * MiB, O_RH = 872 * MiB, WS_END = 968 * MiB;
constexpr size_t S_RINV = O_SM, S_RINVQ = S_RINV + 131072, S_RINVKV = S_RINVQ + 131072, S_LSE = S_RINVKV + 131072  , S_COS = S_LSE + 2359296  ,
                 S_SIN = S_COS + 2 * MiB, S_BIAS = S_SIN + 2 * MiB  , S_GL = S_BIAS + 16384  , S_WL = S_GL + 12 * MiB, S_AL = S_WL + 12 * MiB, S_END = S_AL + 12 * MiB;
static_assert(S_END <= O_RF, "small region overflow");
constexpr int LDS_BYTES = 131072;
static_assert(at::ATT_LDS <= LDS_BYTES, "attention LDS");

struct Params {
  const float *xp, *xs, *norm_g, *rel_bias, *w_in, *q_norm, *kv_norm, *w_uq, *w_ukv, *w_out, *mu, *w_r, *w_k, *w_v, *w_o, *w0, *w1, *w2, *a0, *a1, *a2, *g1, *g2, *k_k, *k_a, *r_k, *ln_w, *ln_b,
              *w_gate, *w_up, *w_down;
  float* out; unsigned char* ws; int ph_lo, ph_hi;
};

__device__ __forceinline__ float bf2f(bf16_t b) { return __uint_as_float(((unsigned)b) << 16); }
__device__ __forceinline__ bf16_t f2bf(float f) { unsigned u = __float_as_uint(f); u += 0x7FFFu + ((u >> 16) & 1u); return (bf16_t)(u >> 16); }
__device__ __forceinline__ float wave_sum(float x) {
#pragma unroll
  for (int o = 32; o >= 1; o >>= 1) x += __shfl_xor(x, o);
  return x;
}
template <int CTRL> __device__ __forceinline__ float dpp_f(float x) { return __int_as_float(__builtin_amdgcn_update_dpp(0, __float_as_int(x), CTRL, 0xF, 0xF, false)); }
__device__ __forceinline__ float row16_sum(float x) { x += dpp_f<0x128>(x); x += dpp_f<0x124>(x); x += dpp_f<0x122>(x); x += dpp_f<0x121>(x); return x; }

struct WMap { const float* s0; const float* s1; const float* gain; int ld; int mode; };
__device__ __forceinline__ int rope_dim(int p) { const int q = p >> 3, w = p & 7; return w < 4 ? 4 * q + w : 32 + 4 * q + (w - 4); }
__device__ __forceinline__ float wmap_get(const WMap& m, int k, int n) {
  float g = m.gain ? m.gain[k] : 1.f;
  switch (m.mode) {
    case 0: return m.s0[(size_t)k * m.ld + n] * g;
    case 1: { int col; if (n < 1024) col = n; else if (n < 4096) col = n + 64; else if (n < 4160) col = 1024 + rope_dim(n - 4096); else return 0.f; return m.s0[(size_t)k * 4160 + col] * g; }
    case 2: { const int h = n / 192, c = n - h * 192; const int col = c < 128 ? n : h * 192 + 128 + rope_dim(c - 128); return m.s0[(size_t)k * 1536 + col] * g; }
    case 3: { const int g8 = n >> 3, w = n & 7; return (w < 4 ? m.s0[(size_t)k * FH + g8 * 4 + w] : m.s1[(size_t)k * FH + g8 * 4 + w - 4]) * g; }
    case 4: { if (n < 96) return m.s0[(size_t)k * 96 + n]; if (n < 192) return m.s1[(size_t)k * 96 + n - 96]; return 0.f; }
    default: { const int d = n >> 11, kk = k - d * 96; if (kk < 0 || kk >= 96) return 0.f; return (d ? m.s1 : m.s0)[(size_t)kk * 2048 + (n & 2047)]; }
  }
}
__device__ __forceinline__ void convert_T(const WMap& m, bf16_t* dst, int N, int K, float* tile  ) {
  const int tid = tidx(), ntn = N >> 6, ntk = K >> 6, nt = ntn * ntk;
  for (int t = blockIdx.x; t < nt; t += gridDim.x) {
    const int n0 = (t % ntn) << 6, k0 = (t / ntn) << 6;
    { const int j = tid & 63, i0 = tid >> 6;
#pragma unroll
      for (int kk = 0; kk < 8; ++kk) { const int kl = i0 * 8 + kk; tile[kl * 65 + j] = wmap_get(m, k0 + kl, n0 + j); } }
    __syncthreads();
    { const int nl = tid >> 3, kc = (tid & 7) * 8; float v[8];
#pragma unroll
      for (int e = 0; e < 8; ++e) v[e] = tile[(kc + e) * 65 + nl];
      u32x4 w; w.x = pg8::cvt_pk_bf16(v[0], v[1]); w.y = pg8::cvt_pk_bf16(v[2], v[3]); w.z = pg8::cvt_pk_bf16(v[4], v[5]); w.w = pg8::cvt_pk_bf16(v[6], v[7]);
      *(u32x4*)(dst + (size_t)(n0 + nl) * K + k0 + kc) = w; }
    __syncthreads();
  }
}
__device__ __forceinline__ void convert_attn_weights(const Params& p, int i, int layer, float* tile) {
  bf16_t* W = (bf16_t*)(p.ws + O_WM);
  { WMap m{p.w_in + (size_t)i * 2048 * 4160, nullptr, p.norm_g + (size_t)(layer * 4 + 0) * DM, 4160, 1}; convert_T(m, W, 4352, 2048, tile); }
  { WMap m{p.w_uq + (size_t)i * 512 * 1536, nullptr, p.q_norm + (size_t)i * 512, 1536, 2}; convert_T(m, W + 8912896, 1536, 512, tile); }
  { WMap m{p.w_ukv + (size_t)i * 512 * 2048, nullptr, p.kv_norm + (size_t)i * 512, 2048, 0}; convert_T(m, W + 8912896 + 786432, 2048, 512, tile); }
  { WMap m{p.w_out + (size_t)i * 2048 * 2048, nullptr, nullptr, 2048, 0}; convert_T(m, W + 8912896 + 786432 + 1048576, 2048, 2048, tile); }
}
constexpr size_t WA_IN = 0, WA_UQ = 8912896, WA_UKV = WA_UQ + 786432, WA_OUT = WA_UKV + 1048576;
constexpr size_t WR_R = 0, WR_K = 4194304, WR_V = 2 * 4194304, WR_O = 3 * 4194304, WR_W1 = 4 * 4194304, WR_A1 = WR_W1 + 524288, WR_G1 = WR_A1 + 524288, WR_G2 = WR_G1 + 524288,
                 WR_W2 = WR_G2 + 524288, WR_A2 = WR_W2 + 1048576;
static_assert((WR_A2 + 1048576) * 2 == 40 * MiB, "rwkv weights size");
__device__ __forceinline__ void convert_rwkv_weights(const Params& p, int i, float* tile) {
  bf16_t* W = (bf16_t*)(p.ws + O_WM); const size_t DD = (size_t)DM * DM;
  { WMap m{p.w_r + i * DD, nullptr, nullptr, 2048, 0}; convert_T(m, W + WR_R, 2048, 2048, tile); }
  { WMap m{p.w_k + i * DD, nullptr, nullptr, 2048, 0}; convert_T(m, W + WR_K, 2048, 2048, tile); }
  { WMap m{p.w_v + i * DD, nullptr, nullptr, 2048, 0}; convert_T(m, W + WR_V, 2048, 2048, tile); }
  { WMap m{p.w_o + i * DD, nullptr, nullptr, 2048, 0}; convert_T(m, W + WR_O, 2048, 2048, tile); }
  { WMap m{p.w1 + (size_t)(i * 2) * 2048 * 96, p.w1 + (size_t)(i * 2 + 1) * 2048 * 96, nullptr, 96, 4}; convert_T(m, W + WR_W1, 256, 2048, tile); }
  { WMap m{p.a1 + (size_t)(i * 2) * 2048 * 96, p.a1 + (size_t)(i * 2 + 1) * 2048 * 96, nullptr, 96, 4}; convert_T(m, W + WR_A1, 256, 2048, tile); }
  { WMap m{p.g1 + (size_t)i * 2048 * 256, nullptr, nullptr, 256, 0}; convert_T(m, W + WR_G1, 256, 2048, tile); }
  { WMap m{p.g2 + (size_t)i * 256 * 2048, nullptr, nullptr, 2048, 0}; convert_T(m, W + WR_G2, 2048, 256, tile); }
  { WMap m{p.w2 + (size_t)(i * 2) * 96 * 2048, p.w2 + (size_t)(i * 2 + 1) * 96 * 2048, nullptr, 2048, 5}; convert_T(m, W + WR_W2, 4096, 256, tile); }
  { WMap m{p.a2 + (size_t)(i * 2) * 96 * 2048, p.a2 + (size_t)(i * 2 + 1) * 96 * 2048, nullptr, 2048, 5}; convert_T(m, W + WR_A2, 4096, 256, tile); }
}
constexpr size_t WF_GU = 0, WF_DN = (size_t)11264 * 2048;
__device__ __forceinline__ void convert_ffn_weights(const Params& p, int layer, float* tile) {
  bf16_t* W = (bf16_t*)(p.ws + O_RF); const size_t DF = (size_t)DM * FH;
  { WMap m{p.w_gate + layer * DF, p.w_up + layer * DF, p.norm_g + (size_t)(layer * 4 + 2) * DM, FH, 3}; convert_T(m, W + WF_GU, 11264, 2048, tile); }
  { WMap m{p.w_down + layer * DF, nullptr, nullptr, 2048, 0}; convert_T(m, W + WF_DN, 2048, 5632, tile); }
}
__device__ __forceinline__ void convert_mixer_weights(const Params& p, int layer, float* tile) { if (layer & 1) convert_rwkv_weights(p, layer >> 1, tile); else convert_attn_weights(p, layer >> 1, layer, tile); }

__device__ __forceinline__ void resid_phase(const Params& p, const bf16_t* mix, const float* g) {
  const int lane = tidx() & 63, gw = blockIdx.x * 8 + (tidx() >> 6), nw = gridDim.x * 8;
  bf16_t* xb = (bf16_t*)(p.ws + O_RC); float* rinv = (float*)(p.ws + S_RINV);
  for (int t = gw; t < T; t += nw) {
    float* xr = p.out + (size_t)t * DM; float xv[4][8];
    if (mix) {
      const bf16_t* mr = mix + (size_t)t * DM; float mv[4][8]; float ss = 0;
#pragma unroll
      for (int i = 0; i < 4; ++i) { const bf16x8 m8 = *(const bf16x8*)(mr + i * 512 + lane * 8);
#pragma unroll
        for (int e = 0; e < 8; ++e) { mv[i][e] = bf2f((bf16_t)m8[e]); ss += mv[i][e] * mv[i][e]; } }
      ss = wave_sum(ss); const float sc = rsqrtf(ss * (1.f / DM) + 1e-6f);
#pragma unroll
      for (int i = 0; i < 4; ++i) { const f32x4 g0 = *(const f32x4*)(g + i * 512 + lane * 8), g1 = *(const f32x4*)(g + i * 512 + lane * 8 + 4);
        const f32x4 x0 = *(const f32x4*)(xr + i * 512 + lane * 8), x1 = *(const f32x4*)(xr + i * 512 + lane * 8 + 4);
#pragma unroll
        for (int e = 0; e < 4; ++e) { xv[i][e] = x0[e] + mv[i][e] * sc * g0[e]; xv[i][4 + e] = x1[e] + mv[i][4 + e] * sc * g1[e]; } }
    } else {
      const float* src = t < 8192 ? p.xp + (size_t)t * DM : p.xs + (size_t)(t - 8192) * DM;
#pragma unroll
      for (int i = 0; i < 4; ++i) { const f32x4 x0 = *(const f32x4*)(src + i * 512 + lane * 8), x1 = *(const f32x4*)(src + i * 512 + lane * 8 + 4);
#pragma unroll
        for (int e = 0; e < 4; ++e) { xv[i][e] = x0[e]; xv[i][4 + e] = x1[e]; } }
    }
    float s2 = 0;
#pragma unroll
    for (int i = 0; i < 4; ++i) {
#pragma unroll
      for (int e = 0; e < 8; ++e) s2 += xv[i][e] * xv[i][e];
      *(f32x4*)(xr + i * 512 + lane * 8) = (f32x4){xv[i][0], xv[i][1], xv[i][2], xv[i][3]}; *(f32x4*)(xr + i * 512 + lane * 8 + 4) = (f32x4){xv[i][4], xv[i][5], xv[i][6], xv[i][7]};
      u32x4 w; w.x = pg8::cvt_pk_bf16(xv[i][0], xv[i][1]); w.y = pg8::cvt_pk_bf16(xv[i][2], xv[i][3]); w.z = pg8::cvt_pk_bf16(xv[i][4], xv[i][5]); w.w = pg8::cvt_pk_bf16(xv[i][6], xv[i][7]);
      *(u32x4*)(xb + (size_t)t * DM + i * 512 + lane * 8) = w; }
    s2 = wave_sum(s2); if (lane == 0) rinv[t] = rsqrtf(s2 * (1.f / DM) + 1e-6f);
  }
}
__device__ __forceinline__ void rownorm_phase(const Params& p) {
  const int lane = tidx() & 63, gw = blockIdx.x * 8 + (tidx() >> 6), nw = gridDim.x * 8;
  const bf16_t* cq = (const bf16_t*)(p.ws + O_RA); const bf16_t* ckv = cq + (size_t)T * 512;
  float* rq = (float*)(p.ws + S_RINVQ); float* rkv = (float*)(p.ws + S_RINVKV);
  for (int t = gw; t < 2 * T; t += nw) { const int tt = t >= T ? t - T : t; const bf16_t* src = (t >= T ? ckv : cq) + (size_t)tt * 512 + lane * 8;
    const bf16x8 v = *(const bf16x8*)src; float ss = 0;
#pragma unroll
    for (int e = 0; e < 8; ++e) { const float f = bf2f((bf16_t)v[e]); ss += f * f; }
    ss = wave_sum(ss); if (lane == 0) (t >= T ? rkv : rq)[tt] = rsqrtf(ss * (1.f / 512) + 1e-6f); }
}
__device__ __forceinline__ void mix_phase(const Params& p, const float* g0, const float* mu  , int sel0, int sel1, int sel2) {
  const int lane = tidx() & 63, gw = blockIdx.x * 8 + (tidx() >> 6), nw = gridDim.x * 8;
  const float* rinv = (const float*)(p.ws + S_RINV);
  bf16_t* m0 = (bf16_t*)(p.ws + O_RD); bf16_t* m1 = (bf16_t*)(p.ws + O_RE); bf16_t* m2 = (bf16_t*)(p.ws + O_RX);
  for (int t = gw; t < T; t += nw) {
    const int s0 = pg8::seq_start(t), len = s0 == 8192 ? 16384 : 4096; const bool hasp = t > s0, hasn = t < s0 + len - 1;
    const float rc = rinv[t], rp = hasp ? rinv[t - 1] : 0.f, rn = hasn ? rinv[t + 1] : 0.f;
    const float* xc = p.out + (size_t)t * DM; const float* xpv = hasp ? xc - DM : xc; const float* xnv = hasn ? xc + DM : xc;
#pragma unroll 2
    for (int i = 0; i < 8; ++i) { const int c = i * 256 + lane * 4;
      const f32x4 gv = *(const f32x4*)(g0 + c); const f32x4 h = *(const f32x4*)(xc + c) * rc * gv, hp = *(const f32x4*)(xpv + c) * rp * gv, hn = *(const f32x4*)(xnv + c) * rn * gv;
      const f32x4 xx = (hp + hn) * 0.5f - h;
      const f32x4 a = h + xx * *(const f32x4*)(mu + sel0 * DM + c), b = h + xx * *(const f32x4*)(mu + sel1 * DM + c), d = h + xx * *(const f32x4*)(mu + sel2 * DM + c);
      uint2 w; w.x = pg8::cvt_pk_bf16(a[0], a[1]); w.y = pg8::cvt_pk_bf16(a[2], a[3]); *(uint2*)(m0 + (size_t)t * DM + c) = w;
      w.x = pg8::cvt_pk_bf16(b[0], b[1]); w.y = pg8::cvt_pk_bf16(b[2], b[3]); *(uint2*)(m1 + (size_t)t * DM + c) = w;
      w.x = pg8::cvt_pk_bf16(d[0], d[1]); w.y = pg8::cvt_pk_bf16(d[2], d[3]); *(uint2*)(m2 + (size_t)t * DM + c) = w; }
  }
}
__device__ __forceinline__ float sum8(float x) { x += __shfl_xor(x, 1); x += __shfl_xor(x, 2); x += __shfl_xor(x, 4); return x; }
__device__ __forceinline__ void postscan_phase(const Params& p, int i) {
  const int lane = tidx() & 63, gw = blockIdx.x * 8 + (tidx() >> 6), nw = gridDim.x * 8;
  bf16_t* y0 = (bf16_t*)(p.ws + O_RH); const bf16_t* y1 = (const bf16_t*)(p.ws + O_RF);
  const bf16_t* r = (const bf16_t*)(p.ws + O_RA); const bf16_t* k = (const bf16_t*)(p.ws + O_RB); const bf16_t* v = (const bf16_t*)(p.ws + O_RC); const bf16_t* g = (const bf16_t*)(p.ws + O_RD);
  const float* lnw = p.ln_w + (size_t)i * DM; const float* lnb = p.ln_b + (size_t)i * DM; const float* rk = p.r_k + (size_t)i * DM;
  for (int t = gw; t < T; t += nw) {
#pragma unroll 2
    for (int hg = 0; hg < 4; ++hg) { const int c = hg * 512 + lane * 8; const size_t ix = (size_t)t * DM + c;
      const bf16x8 a0 = *(const bf16x8*)(y0 + ix), a1 = *(const bf16x8*)(y1 + ix), rv = *(const bf16x8*)(r + ix), kv = *(const bf16x8*)(k + ix), vv = *(const bf16x8*)(v + ix), gv = *(const bf16x8*)(g + ix);
      const f32x4 w0 = *(const f32x4*)(lnw + c), w1 = *(const f32x4*)(lnw + c + 4), b0 = *(const f32x4*)(lnb + c), b1 = *(const f32x4*)(lnb + c + 4), q0 = *(const f32x4*)(rk + c), q1 = *(const f32x4*)(rk + c + 4);
      float y[8]; float s = 0.f, bs = 0.f;
#pragma unroll
      for (int e = 0; e < 8; ++e) { y[e] = bf2f((bf16_t)a0[e]) + bf2f((bf16_t)a1[e]); s += y[e]; bs += bf2f((bf16_t)rv[e]) * bf2f((bf16_t)kv[e]) * (e < 4 ? q0[e & 3] : q1[e & 3]); }
      const float mean = sum8(s) * (1.f / 64); const float bonus = sum8(bs);
      float vs = 0.f;
#pragma unroll
      for (int e = 0; e < 8; ++e) { y[e] -= mean; vs += y[e] * y[e]; }
      const float rstd = rsqrtf(sum8(vs) * (1.f / 64) + 64e-5f);
      float o[8];
#pragma unroll
      for (int e = 0; e < 8; ++e) { const float wv = e < 4 ? w0[e & 3] : w1[e & 3], bv = e < 4 ? b0[e & 3] : b1[e & 3];
        o[e] = (y[e] * rstd * wv + bv + bonus * bf2f((bf16_t)vv[e])) * bf2f((bf16_t)gv[e]); }
      u32x4 w; w.x = pg8::cvt_pk_bf16(o[0], o[1]); w.y = pg8::cvt_pk_bf16(o[2], o[3]); w.z = pg8::cvt_pk_bf16(o[4], o[5]); w.w = pg8::cvt_pk_bf16(o[6], o[7]);
      *(u32x4*)(y0 + ix) = w; }
  }
}
__device__ __forceinline__ void combine_phase(const Params& p) {
  const bf16_t* Op = (const bf16_t*)(p.ws + O_RX); const float* lse = (const float*)(p.ws + S_LSE); bf16_t* cat = (bf16_t*)(p.ws + O_RF);
  const size_t n = (size_t)T * 128;
  for (size_t it = (size_t)blockIdx.x * NTHR + tidx(); it < n; it += (size_t)gridDim.x * NTHR) {
    const int t = (int)(it >> 7), c8 = (int)(it & 127) * 8, h = c8 >> 7;
    const float l0 = lse[((size_t)0 * T + t) * 8 + h], l1 = lse[((size_t)1 * T + t) * 8 + h], l2 = lse[((size_t)2 * T + t) * 8 + h];
    const float m = fmaxf(l0, fmaxf(l1, l2)); float w0 = __builtin_amdgcn_exp2f(l0 - m), w1 = __builtin_amdgcn_exp2f(l1 - m), w2 = __builtin_amdgcn_exp2f(l2 - m);
    const float inv = 1.f / (w0 + w1 + w2); w0 *= inv; w1 *= inv; w2 *= inv;
    const bf16x8 a = *(const bf16x8*)(Op + ((size_t)0 * T + t) * 1024 + c8), b = *(const bf16x8*)(Op + ((size_t)1 * T + t) * 1024 + c8), d = *(const bf16x8*)(Op + ((size_t)2 * T + t) * 1024 + c8);
    float o[8];
#pragma unroll
    for (int e = 0; e < 8; ++e) o[e] = w0 * bf2f((bf16_t)a[e]) + w1 * bf2f((bf16_t)b[e]) + w2 * bf2f((bf16_t)d[e]);
    u32x4 w; w.x = pg8::cvt_pk_bf16(o[0], o[1]); w.y = pg8::cvt_pk_bf16(o[2], o[3]); w.z = pg8::cvt_pk_bf16(o[4], o[5]); w.w = pg8::cvt_pk_bf16(o[6], o[7]);
    *(u32x4*)(cat + (size_t)t * DM + 1024 + c8) = w;
  }
}
__device__ __forceinline__ void tables_phase(const Params& p) {
  float* cs = (float*)(p.ws + S_COS); float* sn = (float*)(p.ws + S_SIN); float* bt = (float*)(p.ws + S_BIAS);
  for (int it = blockIdx.x * NTHR + tidx(); it < 16384 * 32; it += gridDim.x * NTHR) { const int pos = it >> 5, i = it & 31;
    const float inv = __builtin_amdgcn_exp2f(-(float)i * (13.287712379549449f / 32.f)); const float ang = (float)pos * inv;
    const double rev = (double)ang * 0.15915494309189535; const float fr = (float)(rev - __builtin_rint(rev));
    cs[it] = __builtin_amdgcn_cosf(fr); sn[it] = __builtin_amdgcn_sinf(fr); }
  for (int it = blockIdx.x * NTHR + tidx(); it < 3 * 8 * 129; it += gridDim.x * NTHR) { const int pat = it / (8 * 129), rem = it - pat * 8 * 129, h = rem / 129, rl = rem - h * 129 - 64;
    const int dil = pat == 0 ? 1 : (pat == 1 ? 4 : 16); const int rel = rl * dil; const int n = rel < 0 ? -rel : rel;
    int bucket = rel > 0 ? 16 : 0;
    if (n < 8) bucket += n; else { int lg = 8 + (int)(__log2f((float)n * 0.125f) * (8.f / 7.f)); bucket += lg < 15 ? lg : 15; }
    bt[it] = p.rel_bias[bucket * 8 + h] * 1.4426950408889634f; }
}
constexpr int SCH = 32;
constexpr int SC_AM = 0, SC_B = 8192, SC_W = 16384, SC_KD = 24576, SC_R = 32768, SC_V = 40960, SC_Y = 45056, SC_BUF = 49152;
static_assert(2 * SC_BUF <= LDS_BYTES, "scan LDS");
__device__ __forceinline__ void scan_phase(const Params& p, int i, unsigned char* lds) {
  const int tid = tidx(), wid = tid >> 6, lane = tid & 63;
  const bf16_t* rB = (const bf16_t*)(p.ws + O_RA); const bf16_t* kB = (const bf16_t*)(p.ws + O_RB); const bf16_t* vB = (const bf16_t*)(p.ws + O_RC);
  const bf16_t* eB = (const bf16_t*)(p.ws + O_RD); const bf16_t* aB = (const bf16_t*)(p.ws + O_RX);
  const float* kkw = p.k_k + (size_t)i * DM; const float* kaw = p.k_a + (size_t)i * DM;
  for (int wk = blockIdx.x; wk < 256; wk += gridDim.x) {
    for (int q = 0; q < 2; ++q) {
      int s0, len, head, dir, rowbase; const bool qm = (q == 0);
      if (qm) { const int u = wk >> 2; rowbase = (wk & 3) * 16; dir = u & 1; head = u >> 1; s0 = 8192; len = 16384; }
      else { const int u = wk >> 1; rowbase = (wk & 1) * 32; dir = u & 1; head = (u >> 1) & 31; s0 = (u >> 6) * 4096; len = 4096; }
      bf16_t* yB = (bf16_t*)(p.ws + (dir ? O_RF : O_RH));
      const int nch = len / SCH;
      const int rp = lane >> 4, kq = lane & 15;
      float S0[4] = {0.f, 0.f, 0.f, 0.f}, S1[4] = {0.f, 0.f, 0.f, 0.f};
      const int pw = wid - 4, st = lane >> 3, l8 = lane & 7, c8 = l8 * 8;
      f32x4 kkc[2], kac[2], w0c[2], a0c[2];
      if (wid >= 4) {
#pragma unroll
        for (int e = 0; e < 2; ++e) { const int cc = head * 64 + c8 + e * 4;
          kkc[e] = *(const f32x4*)(kkw + cc); kac[e] = *(const f32x4*)(kaw + cc);
          w0c[e] = *(const f32x4*)(p.w0 + (size_t)(i * 2 + dir) * DM + cc); a0c[e] = *(const f32x4*)(p.a0 + (size_t)(i * 2 + dir) * DM + cc); }
      }
      auto fill = [&](int c, int b) {
        unsigned char* B = lds + b * SC_BUF;
        const int sl = pw * 8 + st; const int s = c * SCH + sl; const int t = dir ? len - 1 - s : s; const size_t tok = (size_t)(s0 + t);
        const bf16x8 kv = *(const bf16x8*)(kB + tok * DM + head * 64 + c8), rv = *(const bf16x8*)(rB + tok * DM + head * 64 + c8);
        const bf16x8 ev = *(const bf16x8*)(eB + tok * 4096 + dir * 2048 + head * 64 + c8), av = *(const bf16x8*)(aB + tok * 4096 + dir * 2048 + head * 64 + c8);
        uint2 vv = make_uint2(0u, 0u); if (!qm || l8 < 4) vv = *(const uint2*)(vB + tok * DM + head * 64 + rowbase + l8 * 4);
        float kf[8], kk[8]; float ss = 0.f;
#pragma unroll
        for (int e = 0; e < 8; ++e) { kf[e] = bf2f((bf16_t)kv[e]); kk[e] = kf[e] * kkc[e >> 2][e & 3]; ss += kk[e] * kk[e]; }
        ss += __shfl_xor(ss, 1); ss += __shfl_xor(ss, 2); ss += __shfl_xor(ss, 4);
        const float inv = rsqrtf(ss + 1e-12f);
        f32x4 oam[2], ob[2], ow[2], okd[2], orr[2];
#pragma unroll
        for (int e = 0; e < 8; ++e) { const int q4 = e >> 2, j = e & 3;
          const float af = pg8::fsig(a0c[q4][j] + bf2f((bf16_t)av[e])); const float ef = 0.6065306597f * pg8::fsig(w0c[q4][j] + bf2f((bf16_t)ev[e]));
          const float kn = kk[e] * inv;
          oam[q4][j] = -kn; ob[q4][j] = kn * af; ow[q4][j] = __expf(-ef); okd[q4][j] = kf[e] * (1.f + (af - 1.f) * kac[q4][j]); orr[q4][j] = bf2f((bf16_t)rv[e]); }
        const int o4 = sl * 16 + l8 * 2;
#pragma unroll
        for (int e = 0; e < 2; ++e) { ((f32x4*)(B + SC_AM))[o4 + e] = oam[e]; ((f32x4*)(B + SC_B))[o4 + e] = ob[e]; ((f32x4*)(B + SC_W))[o4 + e] = ow[e];
          ((f32x4*)(B + SC_KD))[o4 + e] = okd[e]; ((f32x4*)(B + SC_R))[o4 + e] = orr[e]; }
        f32x4 vf; vf[0] = __uint_as_float(vv.x << 16); vf[1] = __uint_as_float(vv.x & 0xffff0000u); vf[2] = __uint_as_float(vv.y << 16); vf[3] = __uint_as_float(vv.y & 0xffff0000u);
        ((f32x4*)(B + SC_V))[sl * 8 + l8] = vf;
      };
      auto flush = [&](int c, int b) {
        const unsigned char* B = lds + b * SC_BUF;
        const int sl = pw * 8 + st; const int s = c * SCH + sl; const int t = dir ? len - 1 - s : s;
        const f32x4 y = ((const f32x4*)(B + SC_Y))[sl * 8 + l8];
        uint2 w; w.x = pg8::cvt_pk_bf16(y[0], y[1]); w.y = pg8::cvt_pk_bf16(y[2], y[3]);
        if (!qm || l8 < 4) *(uint2*)(yB + (size_t)(s0 + t) * DM + head * 64 + rowbase + l8 * 4) = w;
      };
      if (wid >= 4) fill(0, 0);
      __syncthreads();
      for (int c = 0; c < nch; ++c) {
        if (wid < 4) {
          const unsigned char* B = lds + (c & 1) * SC_BUF;
          const f32x4* pAM = (const f32x4*)(B + SC_AM) + kq; const f32x4* pB = (const f32x4*)(B + SC_B) + kq; const f32x4* pW = (const f32x4*)(B + SC_W) + kq;
          const f32x4* pKD = (const f32x4*)(B + SC_KD) + kq; const f32x4* pR = (const f32x4*)(B + SC_R) + kq;
          const float2* pV = (const float2*)(B + SC_V) + wid * 4 + rp; float2* pY = (float2*)(B + SC_Y) + wid * 4 + rp;
          if (!qm) {
          f32x4 am = pAM[0], bb = pB[0], ww = pW[0], kd = pKD[0], rr = pR[0]; float2 vv = pV[0]; float yq0 = 0.f, yq1 = 0.f, yk0 = 0.f, yk1 = 0.f;
#pragma unroll 4
          for (int s = 0; s < SCH; ++s) {
            const int sn = (s + 1 < SCH ? s + 1 : s) * 16;
            const f32x4 am_n = pAM[sn], bb_n = pB[sn], ww_n = pW[sn], kd_n = pKD[sn], rr_n = pR[sn]; const float2 vv_n = pV[sn];
            float sa0 = (S0[0] * am[0] + S0[1] * am[1]) + (S0[2] * am[2] + S0[3] * am[3]);
            float sa1 = (S1[0] * am[0] + S1[1] * am[1]) + (S1[2] * am[2] + S1[3] * am[3]);
            float u0[4], u1[4];
#pragma unroll
            for (int j = 0; j < 4; ++j) { u0[j] = fmaf(S0[j], ww[j], vv.x * kd[j]); u1[j] = fmaf(S1[j], ww[j], vv.y * kd[j]); }
            sa0 += dpp_f<0x128>(sa0); sa1 += dpp_f<0x128>(sa1); yq0 += dpp_f<0x128>(yq0); yq1 += dpp_f<0x128>(yq1);
            sa0 += dpp_f<0x124>(sa0); sa1 += dpp_f<0x124>(sa1); yq0 += dpp_f<0x124>(yq0); yq1 += dpp_f<0x124>(yq1);
            sa0 += dpp_f<0x122>(sa0); sa1 += dpp_f<0x122>(sa1); yq0 += dpp_f<0x122>(yq0); yq1 += dpp_f<0x122>(yq1);
            sa0 += dpp_f<0x121>(sa0); sa1 += dpp_f<0x121>(sa1); yq0 += dpp_f<0x121>(yq0); yq1 += dpp_f<0x121>(yq1);
            { const bool me = kq == ((s - 1) & 15); yk0 = me ? yq0 : yk0; yk1 = me ? yq1 : yk1; }
            if (s == 16) pY[kq * 16] = make_float2(yk0, yk1);
#pragma unroll
            for (int j = 0; j < 4; ++j) { S0[j] = fmaf(sa0, bb[j], u0[j]); S1[j] = fmaf(sa1, bb[j], u1[j]); }
            yq0 = (S0[0] * rr[0] + S0[1] * rr[1]) + (S0[2] * rr[2] + S0[3] * rr[3]);
            yq1 = (S1[0] * rr[0] + S1[1] * rr[1]) + (S1[2] * rr[2] + S1[3] * rr[3]);
            am = am_n; bb = bb_n; ww = ww_n; kd = kd_n; rr = rr_n; vv = vv_n;
          }
          yq0 = row16_sum(yq0); yq1 = row16_sum(yq1);
          if (kq == 15) { yk0 = yq0; yk1 = yq1; }
          pY[(16 + kq) * 16] = make_float2(yk0, yk1);
          } else {
          const float* pV1 = (const float*)(B + SC_V) + wid * 4 + rp; float* pY1 = (float*)(B + SC_Y) + wid * 4 + rp;
          f32x4 am = pAM[0], bb = pB[0], ww = pW[0], kd = pKD[0], rr = pR[0]; float vv = pV1[0]; float yq = 0.f, yk = 0.f;
#pragma unroll 4
          for (int s = 0; s < SCH; ++s) {
            const int sn = (s + 1 < SCH ? s + 1 : s);
            const f32x4 am_n = pAM[sn * 16], bb_n = pB[sn * 16], ww_n = pW[sn * 16], kd_n = pKD[sn * 16], rr_n = pR[sn * 16]; const float vv_n = pV1[sn * 32];
            float sa0 = (S0[0] * am[0] + S0[1] * am[1]) + (S0[2] * am[2] + S0[3] * am[3]);
            float u0[4];
#pragma unroll
            for (int j = 0; j < 4; ++j) u0[j] = fmaf(S0[j], ww[j], vv * kd[j]);
            sa0 += dpp_f<0x128>(sa0); yq += dpp_f<0x128>(yq);
            sa0 += dpp_f<0x124>(sa0); yq += dpp_f<0x124>(yq);
            sa0 += dpp_f<0x122>(sa0); yq += dpp_f<0x122>(yq);
            sa0 += dpp_f<0x121>(sa0); yq += dpp_f<0x121>(yq);
            yk = (kq == ((s - 1) & 15)) ? yq : yk;
            if (s == 16) pY1[kq * 32] = yk;
#pragma unroll
            for (int j = 0; j < 4; ++j) S0[j] = fmaf(sa0, bb[j], u0[j]);
            yq = (S0[0] * rr[0] + S0[1] * rr[1]) + (S0[2] * rr[2] + S0[3] * rr[3]);
            am = am_n; bb = bb_n; ww = ww_n; kd = kd_n; rr = rr_n; vv = vv_n;
          }
          yq = row16_sum(yq);
          if (kq == 15) yk = yq;
          pY1[(16 + kq) * 32] = yk;
          }
        } else {
          if (c + 1 < nch) fill(c + 1, (c + 1) & 1);
          if (c >= 1) flush(c - 1, (c - 1) & 1);
        }
        __syncthreads();
      }
      if (wid >= 4) flush(nch - 1, (nch - 1) & 1);
      __syncthreads();
    }
  }
}

__device__ __forceinline__ void dilated_phase(const Params& p, char* lds) {
  const bf16_t* qb = (const bf16_t*)(p.ws + O_RD); const bf16_t* kb = qb + (size_t)T * 1024; const bf16_t* vb = kb + (size_t)T * 1024;
  bf16_t* Op = (bf16_t*)(p.ws + O_RX); float* lse = (float*)(p.ws + S_LSE); const float* bt = (const float*)(p.ws + S_BIAS);
  for (int it = blockIdx.x; it < 3 * 8 * 96; it += gridDim.x) {
    const int pat = it / 768, rem = it - pat * 768, h = rem / 96, blk = rem - h * 96;
    const int dil = pat == 0 ? 1 : (pat == 1 ? 4 : 16);
    int s0, len, b = blk;
    if (b < 16) { s0 = 0; len = 4096; } else if (b < 32) { s0 = 4096; len = 4096; b -= 16; } else { s0 = 8192; len = 16384; b -= 32; }
    const int L = len / dil, nbl = L / 256; const int res = b / nbl, j0 = (b - res * nbl) * 256;
    const size_t tok0 = (size_t)(s0 + res);
    at::Args A;
    A.Q = qb + (tok0 + (size_t)j0 * dil) * 1024 + h * 128;
    A.K = kb + tok0 * 1024 + h * 128; A.Kr = nullptr;
    A.V = vb + tok0 * 1024 + h * 128;
    A.O = Op + ((size_t)pat * T + tok0 + (size_t)j0 * dil) * 1024 + h * 128;
    A.lse = lse + ((size_t)pat * T + tok0 + (size_t)j0 * dil) * 8 + h; A.ldlse = (long)dil * 8;
    A.nt = 6; A.kb0 = j0 - 64; A.L = L; A.biasG = bt + (pat * 8 + h) * 129;
    A.C = 0.08838834764831845f * 1.4426950408889634f; A.thr = 11.5f;
    if (pat == 0) at::attn_body<8, true, 1024, 1024, 1024>(A, lds);
    else if (pat == 1) at::attn_body<8, true, 4096, 4096, 4096>(A, lds);
    else at::attn_body<8, true, 16384, 16384, 16384>(A, lds);
  }
}
__device__ __forceinline__ void mla_phase(const Params& p, char* lds) {
  const bf16_t* Qp = (const bf16_t*)(p.ws + O_RB); const bf16_t* kv = (const bf16_t*)(p.ws + O_RH); const bf16_t* kr = (const bf16_t*)(p.ws + O_RA) + (size_t)T * 1024;
  bf16_t* cat = (bf16_t*)(p.ws + O_RF);
  for (int it = blockIdx.x; it < 512 + 256; it += gridDim.x) {
    int s0, len, h, qb_;
    { const int rnd = it >> 8, v = it & 255, slot = v >> 3; h = v & 7;
      if (rnd < 2) { s0 = 8192; len = 16384; qb_ = rnd * 32 + slot; }
      else { s0 = (slot >> 4) * 4096; len = 4096; qb_ = slot & 15; } }
    at::Args A;
    A.Q = Qp + (size_t)(s0 + qb_ * 256) * 1536 + h * 192;
    A.K = kv + (size_t)s0 * 2048 + h * 256; A.Kr = kr + (size_t)s0 * 64;
    A.V = A.K + 128;
    A.O = cat + (size_t)(s0 + qb_ * 256) * 2048 + h * 128;
    A.lse = nullptr; A.ldlse = 0; A.nt = len / 64; A.kb0 = 0; A.L = len; A.biasG = nullptr;
    A.C = 0.07216878364870322f * 1.4426950408889634f; A.thr = 8.f / 0.07216878364870322f;
    at::attn_body<12, false, 1536, 2048, 2048>(A, lds);
  }
}

template <class Epi>
__device__ __forceinline__ void gemm_simple(unsigned char* lds, const pg8::Gemm g, const pg8::StaticOrder& S, const Epi& E) {
  using namespace pg8;
  const int tid = tidx(), wid = tid >> 6, lane = tid & 63, wr = wid >> 2, wc = wid & 3, fr = lane & 15, fq = lane >> 4;
  const int K = g.K, nt = K / BK;
  unsigned offA[2], offB[2];
#pragma unroll
  for (int i = 0; i < 2; ++i) { int R, C; stage_rc(tid * 16 + i * 8192, R, C); const int Rb = Epi::PERM ? ((R & ~31) + perm32(R & 31)) : R;
    offA[i] = (unsigned)(R * K + C); offB[i] = (unsigned)(Rb * K + C); }
  const int aoff = lds_byte(wr * 64 + fr, fq * 8), boff = lds_byte(wc * 32 + fr, fq * 8);
  unsigned char* myst = lds + tid * 16;
  Unit u;
  for (int ui = 0; S.next(ui, u); ++ui) {
    f32x4 acc[2][2][4][2];
#pragma unroll
    for (int a = 0; a < 2; ++a)
#pragma unroll
      for (int b = 0; b < 2; ++b)
#pragma unroll
        for (int m = 0; m < 4; ++m)
#pragma unroll
          for (int n = 0; n < 2; ++n) acc[a][b][m][n] = (f32x4){0.f, 0.f, 0.f, 0.f};
    const bf16_t* Ab = g.A + (size_t)u.pm * 256 * K; const bf16_t* Bb = g.Bt + (size_t)u.pn * 256 * K;
    const size_t hK = (size_t)128 * K;
    bf16x8 sg[2][2];
#define GLOADX(P, off, kt) do { _Pragma("unroll") for (int h = 0; h < 2; ++h) _Pragma("unroll") for (int i = 0; i < 2; ++i) \
      sg[h][i] = *(const bf16x8*)((P) + h * hK + (off)[i] + (size_t)(kt) * BK); } while (0)
#define SWRITEX(base, b) do { _Pragma("unroll") for (int h = 0; h < 2; ++h) _Pragma("unroll") for (int i = 0; i < 2; ++i) \
      *(bf16x8*)(myst + ((base) + (b) * 2 + h) * HTB + i * 8192) = sg[h][i]; } while (0)
    GLOADX(Ab, offA, 0); SWRITEX(0, 0); GLOADX(Bb, offB, 0); SWRITEX(4, 0); __syncthreads();
    for (int kt = 0; kt < nt; ++kt) {
      const int b = kt & 1; const bool more = kt + 1 < nt;
#pragma unroll
      for (int k = 0; k < 2; ++k) {
        if (more) { if (k == 0) GLOADX(Ab, offA, kt + 1); else GLOADX(Bb, offB, kt + 1); }
        __builtin_amdgcn_sched_barrier(0);
        bf16x8 B0[2], B1[2];
#pragma unroll
        for (int n = 0; n < 2; ++n) { B0[n] = *(const bf16x8*)(lds + (4 + b * 2 + 0) * HTB + boff + n * 2048 + k * 1024); B1[n] = *(const bf16x8*)(lds + (4 + b * 2 + 1) * HTB + boff + n * 2048 + k * 1024); }
#pragma unroll
        for (int ai = 0; ai < 2; ++ai) {
#pragma unroll
          for (int m = 0; m < 4; ++m) {
            const bf16x8 At = *(const bf16x8*)(lds + (b * 2 + ai) * HTB + aoff + m * 2048 + k * 1024);
#pragma unroll
            for (int n = 0; n < 2; ++n) {
              acc[ai][0][m][n] = __builtin_amdgcn_mfma_f32_16x16x32_bf16(B0[n], At, acc[ai][0][m][n], 0, 0, 0);
              acc[ai][1][m][n] = __builtin_amdgcn_mfma_f32_16x16x32_bf16(B1[n], At, acc[ai][1][m][n], 0, 0, 0); }
          }
          __builtin_amdgcn_sched_barrier(0);
        }
        if (more) { if (k == 0) SWRITEX(0, b ^ 1); else SWRITEX(4, b ^ 1); }
      }
      __syncthreads();
    }
#undef GLOADX
#undef SWRITEX
    E(acc, u, wr, wc, fr, fq);
  }
}
template <class Epi> __device__ __forceinline__ void run_gemm(unsigned char* lds, const bf16_t* A, const bf16_t* Bt, int N, int K, const Epi& E) {
  pg8::Gemm g{A, Bt, T, N, K}; pg8::StaticOrder S;
  S.init(T, N, (int)gridDim.x, (int)blockIdx.x);
  pg8::gemm_phase<Epi, pg8::StaticOrder, false>((PG8_LAS unsigned char*)lds, g, S, E, nullptr);
  __syncthreads();
}
template <class Epi> __device__ __forceinline__ void run_gemm_small(unsigned char* lds, const bf16_t* A, const bf16_t* Bt, int N, int K, const Epi& E) {
  pg8::Gemm g{A, Bt, T, N, K}; pg8::StaticOrder S;
  S.init(T, N, (int)gridDim.x, (int)blockIdx.x);
  gemm_simple<Epi>(lds, g, S, E);
  __syncthreads();
}

__device__ __forceinline__ Params ldp() { auto k = __builtin_amdgcn_kernarg_segment_ptr(); asm volatile("" : "+s"(k)); Params q; __builtin_memcpy(&q, k, sizeof(Params)); return q; }
__device__ __forceinline__ void gbar(unsigned* ctr, unsigned target) {
  __syncthreads();
  if (threadIdx.x == 0) {
    __threadfence();
    __hip_atomic_fetch_add(ctr, 1u, __ATOMIC_RELEASE, __HIP_MEMORY_SCOPE_AGENT);
    while (__hip_atomic_load(ctr, __ATOMIC_ACQUIRE, __HIP_MEMORY_SCOPE_AGENT) < target) __builtin_amdgcn_s_sleep(2);
    __threadfence();
  }
  __syncthreads();
}
#define PHASE(...) do { if (ph >= pk.ph_lo && ph < pk.ph_hi) { const Params p = ldp(); unsigned char* ws = p.ws; WSPTRS; __VA_ARGS__; } ++ph; \
    if (ph > pk.ph_lo && ph < pk.ph_hi) { gbar((unsigned*)(pk.ws + WS_END), (unsigned)ph * gridDim.x); } } while (0)
#define WSPTRS bf16_t* WM = (bf16_t*)(ws + O_WM); bf16_t* WF = (bf16_t*)(ws + O_RF); \
  float* rinv = (float*)(ws + S_RINV); float* rinvq = (float*)(ws + S_RINVQ); float* rinvkv = (float*)(ws + S_RINVKV); \
  const float* cs = (const float*)(ws + S_COS); const float* sn = (const float*)(ws + S_SIN); \
  bf16_t* mix = (bf16_t*)(ws + O_RA); bf16_t* xb = (bf16_t*)(ws + O_RC); bf16_t* act = (bf16_t*)(ws + O_RD); \
  const int i = layer >> 1; const float* ng = p.norm_g + (size_t)layer * 4 * DM; const float* mu = p.mu + (size_t)i * 6 * DM; \
  bf16_t* cq = (bf16_t*)(ws + O_RA); bf16_t* ckv = cq + (size_t)T * 512; bf16_t* kr = cq + (size_t)T * 1024; \
  bf16_t* qb = (bf16_t*)(ws + O_RD); bf16_t* kb = qb + (size_t)T * 1024; bf16_t* vb = kb + (size_t)T * 1024; \
  bf16_t* Qp = (bf16_t*)(ws + O_RB); bf16_t* kv = (bf16_t*)(ws + O_RH); bf16_t* cat = (bf16_t*)(ws + O_RF); \
  bf16_t* m0 = (bf16_t*)(ws + O_RD); bf16_t* m1 = (bf16_t*)(ws + O_RE); bf16_t* m2 = (bf16_t*)(ws + O_RX); \
  bf16_t* rB = (bf16_t*)(ws + O_RA); bf16_t* kB = (bf16_t*)(ws + O_RB); bf16_t* vB = (bf16_t*)(ws + O_RC); \
  bf16_t* gl = (bf16_t*)(ws + S_GL); bf16_t* wl = (bf16_t*)(ws + S_WL); bf16_t* al = (bf16_t*)(ws + S_AL); \
  bf16_t* eB = (bf16_t*)(ws + O_RD); bf16_t* aB = (bf16_t*)(ws + O_RX); bf16_t* gB = (bf16_t*)(ws + O_RD); bf16_t* yg = (bf16_t*)(ws + O_RH); \
  (void)WM; (void)WF; (void)rinv; (void)rinvq; (void)rinvkv; (void)cs; (void)sn; (void)mix; (void)xb; (void)act; (void)i; (void)ng; (void)mu; (void)cq; (void)ckv; (void)kr; (void)qb; (void)kb; (void)vb; \
  (void)Qp; (void)kv; (void)cat; (void)m0; (void)m1; (void)m2; (void)rB; (void)kB; (void)vB; (void)gl; (void)wl; (void)al; (void)eB; (void)aB; (void)gB; (void)yg
template <int layer> __device__ __forceinline__ void layer_fn(const Params& pk, unsigned char* lds, cg::grid_group& grid, int& ph) {
    if constexpr ((layer & 1) == 0) {
      PHASE(pg8::EpiIn E{cq, ckv, qb, kb, vb, kr, rinv, cs, sn}; run_gemm(lds, xb, WM + WA_IN, 4352, 2048, E));
      PHASE(rownorm_phase(p); dilated_phase(p, (char*)lds));
      PHASE(pg8::EpiUQ E1{Qp, rinvq, cs, sn}; run_gemm(lds, cq, WM + WA_UQ, 1536, 512, E1);
            pg8::EpiB<0> E2{kv, 2048, nullptr, rinvkv}; run_gemm(lds, ckv, WM + WA_UKV, 2048, 512, E2));
      PHASE(mla_phase(p, (char*)lds); combine_phase(p));
      PHASE(pg8::EpiB<0> E{mix, 2048, nullptr, nullptr}; run_gemm(lds, cat, WM + WA_OUT, 2048, 2048, E));
    } else {
      PHASE(mix_phase(p, ng, mu, 1, 4, 5));
      PHASE(pg8::EpiLora E{wl, al, gl}; pg8::Gemm g3{m0, WM + WR_W1, 3 * T, 768, 2048}; pg8::LoraOrder S3{(int)blockIdx.x};
            pg8::gemm_phase<pg8::EpiLora, pg8::LoraOrder, false>((PG8_LAS unsigned char*)lds, g3, S3, E, nullptr); __syncthreads());
      PHASE(mix_phase(p, ng, mu, 0, 2, 3));
      PHASE(pg8::EpiB<0> E1{rB, 2048, nullptr, nullptr}; run_gemm(lds, m0, WM + WR_R, 2048, 2048, E1);
            pg8::EpiB<0> E2{kB, 2048, nullptr, nullptr}; run_gemm(lds, m1, WM + WR_K, 2048, 2048, E2);
            pg8::EpiB<0> E3{vB, 2048, nullptr, nullptr}; run_gemm(lds, m2, WM + WR_V, 2048, 2048, E3));
      PHASE(pg8::EpiB<0> E1{eB, 4096, nullptr, nullptr}; run_gemm(lds, wl, WM + WR_W2, 4096, 256, E1);
            pg8::EpiB<0> E2{aB, 4096, nullptr, nullptr}; run_gemm(lds, al, WM + WR_A2, 4096, 256, E2));
      PHASE(scan_phase(p, i, lds));
      PHASE(pg8::EpiB<0> E{gB, 2048, nullptr, nullptr}; run_gemm(lds, gl, WM + WR_G2, 2048, 256, E));
      PHASE(postscan_phase(p, i));
      PHASE(pg8::EpiB<0> E{mix, 2048, nullptr, nullptr}; run_gemm(lds, yg, WM + WR_O, 2048, 2048, E));
    }
    PHASE(resid_phase(p, mix, ng + DM); convert_ffn_weights(p, layer, (float*)lds));
    PHASE(pg8::EpiSwi E{act, rinv}; run_gemm(lds, xb, WF + WF_GU, 11264, 2048, E));
    PHASE(pg8::EpiB<0> E{mix, 2048, nullptr, nullptr}; run_gemm(lds, act, WF + WF_DN, 2048, 5632, E));
    PHASE(resid_phase(p, mix, ng + 3 * DM); if (layer < 3) convert_mixer_weights(p, layer + 1, (float*)lds));
  }
__global__ void __launch_bounds__(512, 2) mega(Params pk) {
  constexpr int layer = 0;
  extern __shared__ __attribute__((aligned(16))) unsigned char lds[];
  cg::grid_group grid = cg::this_grid();
  int ph = 0;
  grid.sync();
  PHASE(resid_phase(p, nullptr, nullptr); tables_phase(p); convert_mixer_weights(p, 0, (float*)lds));
  layer_fn<0>(pk, lds, grid, ph); layer_fn<1>(pk, lds, grid, ph); layer_fn<2>(pk, lds, grid, ph); layer_fn<3>(pk, lds, grid, ph);
}
#undef PHASE
#undef WSPTRS

extern "C" void kernel_launch(void* const* d_in, const int* in_sizes, int n_in, void* d_out, int out_size, void* d_ws, size_t ws_size, hipStream_t stream) {
  static int grid_blocks = 0;
  if (!grid_blocks) {
    int dev = 0, cus = 0, per_cu = 0;
    (void)hipGetDevice(&dev);
    (void)hipDeviceGetAttribute(&cus, hipDeviceAttributeMultiprocessorCount, dev);
    (void)hipFuncSetAttribute((const void*)mega, hipFuncAttributeMaxDynamicSharedMemorySize, LDS_BYTES);
    (void)hipOccupancyMaxActiveBlocksPerMultiprocessor(&per_cu, mega, 512, LDS_BYTES);
    if (per_cu < 1) { fprintf(stderr, "occupancy query returned %d\n", per_cu); per_cu = 1; }
    grid_blocks = cus;
  }
  if (n_in != 31 || ws_size < WS_END + 256) { fprintf(stderr, "kernel_launch: unexpected n_in %d / ws_size %zu\n", n_in, ws_size); return; }
  Params p{};
  const float** f = (const float**)&p;
  for (int k = 0; k < 31; ++k) f[k] = (const float*)d_in[k];
  p.out = (float*)d_out; p.ws = (unsigned char*)d_ws; p.ph_lo = 0; p.ph_hi = 1000;
#ifdef MULTI_LAUNCH
  for (int ph = 0; ph < NPH_RUN; ++ph) { p.ph_lo = ph; p.ph_hi = ph + 1; hipLaunchKernelGGL(mega, dim3(grid_blocks), dim3(512), LDS_BYTES, stream, p); }
#else
  (void)hipMemsetAsync((unsigned char*)d_ws + WS_END, 0, 256, stream);
  void* args[] = {&p};
  hipError_t e = hipLaunchCooperativeKernel((void*)mega, dim3(grid_blocks), dim3(512), args, LDS_BYTES, stream);
  if (e != hipSuccess) fprintf(stderr, "cooperative launch failed: %s (grid %d)\n", hipGetErrorString(e), grid_blocks);
#endif
}
```

```cpp
#include <hip/hip_runtime.h>
#include <hip/hip_cooperative_groups.h>
#include <cstdio>
#include <cstdint>
namespace cg = cooperative_groups;
__device__ __forceinline__ int tidx() { int t = threadIdx.x; asm volatile("" : "+v"(t)); return t; }
namespace pg8 {
#define PG8_LAS __attribute__((address_space(3)))
typedef unsigned short bf16_t;
typedef short bf16x8 __attribute__((ext_vector_type(8)));
typedef float f32x4 __attribute__((ext_vector_type(4)));
typedef unsigned u32x4 __attribute__((ext_vector_type(4)));
constexpr int BM = 256, BK = 64, HALF = 128, HTB = HALF * BK * 2  , STAGE_BYTES = 8 * HTB, NXCD = 8, WGM = 8;

__host__ __device__ __forceinline__ int lds_byte(int r, int c) { const int st = (r >> 4) * 2 + (c >> 5), rr = r & 15, cc = c & 31, ob = rr * 64 + cc * 2; return st * 1024 + (ob ^ (((ob >> 9) & 1) << 5)); }
__host__ __device__ __forceinline__ void stage_rc(int b, int& R, int& C) { const int st = b / 1024, sb = b % 1024, swz = sb ^ (((sb >> 9) & 1) << 5); R = (st >> 1) * 16 + swz / 64; C = (st & 1) * 32 + (swz % 64) / 2; }
__host__ __device__ __forceinline__ int perm32(int rho) { const int n = rho >> 4, i = rho & 15; return 8 * (i >> 2) + 4 * n + (i & 3); }

struct Unit { int pm, pn; };
struct Gemm { const bf16_t* A; const bf16_t* Bt; int M, N, K; };

struct StaticOrder {
    int nM, nN, nwg, G, c;
    __host__ __device__ void init(int M, int N, int G_, int c_) { nM = M / BM; nN = N / BM; nwg = nM * nN; G = G_; c = c_; }
    __host__ __device__ bool next(int i, Unit& u) const {
        const long L = (long)i * G + c; if (L >= nwg) return false;
        int wgid = (int)L; { const int q = nwg / NXCD, r = nwg % NXCD, xcd = wgid % NXCD, off = wgid / NXCD; wgid = (xcd < r ? xcd * (q + 1) : r * (q + 1) + (xcd - r) * q) + off; }
        const int nig = WGM * nN, gid = wgid / nig, fm = gid * WGM, gsz = (nM - fm) < WGM ? (nM - fm) : WGM;
        u.pm = fm + ((wgid % nig) % gsz); u.pn = (wgid % nig) / gsz; return true;
    }
    __device__ __forceinline__ void a_ready(const Unit&) const {}
    __device__ __forceinline__ void done(const Unit&) const {}
};
__device__ __forceinline__ unsigned cvt_pk_bf16(float lo, float hi) { unsigned r; asm volatile("v_cvt_pk_bf16_f32 %0, %1, %2" : "=v"(r) : "v"(lo), "v"(hi)); return r; }
typedef float f32x2 __attribute__((ext_vector_type(2)));
template <class Epi, class Sched, bool STAMP = false>
__device__ __forceinline__ void gemm_phase(PG8_LAS unsigned char* lds, const Gemm g, const Sched& S, const Epi& E, unsigned long long* stamps) {
    const int tid = tidx(), wid = __builtin_amdgcn_readfirstlane(tid >> 6), lane = tid & 63, wr = wid >> 2, wc = wid & 3, fr = lane & 15, fq = lane >> 4;
    const int K = g.K, nt = K / BK;
    int ts_lo = 0, ts_hi = 0, nts = 0; const unsigned long long rt_entry = STAMP ? (unsigned long long)wall_clock64() : 0ull;
#define PG8_STAMP() do { if (STAMP && wid == 0 && nts < 64) { const unsigned long long _c = (unsigned long long)clock64(); \
        ts_lo = (lane == nts) ? (int)(unsigned)_c : ts_lo; ts_hi = (lane == nts) ? (int)(unsigned)(_c >> 32) : ts_hi; ++nts; } } while (0)
    PG8_STAMP();
    unsigned voffA[2], voffB[2];
#pragma unroll
    for (int i = 0; i < 2; ++i) { int R, C; stage_rc(tid * 16 + i * 8192, R, C); const int Rb = Epi::PERM ? ((R & ~31) + perm32(R & 31)) : R;
        voffA[i] = (unsigned)(R * K + C) * 2u; voffB[i] = (unsigned)(Rb * K + C) * 2u; }
    const size_t kstep = (size_t)(BK * 2);
    const size_t hstep = (size_t)HALF * K * 2;
    const size_t tstep = 2 * hstep;
    const unsigned ldsw = (unsigned)wid * 1024u;
    const int aoff = lds_byte(wr * 64 + fr, fq * 8), boff = lds_byte(wc * 32 + fr, fq * 8);
#define PG8_SA(b, h) (((b) * 2 + (h)) * HTB)
#define PG8_SB(b, h) ((4 + (b) * 2 + (h)) * HTB)
#define PG8_STAGE(bufoff, gbase, voff) do { _Pragma("unroll") for (int _i = 0; _i < 2; ++_i) \
        __builtin_amdgcn_global_load_lds((const unsigned*)((const char*)(gbase) + (voff)[_i]), (PG8_LAS unsigned*)(lds + (bufoff) + ldsw + _i * 8192), 16, 0, 0); } while (0)
#define PG8_LDA(dst, b, h) do { _Pragma("unroll") for (int m = 0; m < 4; ++m) _Pragma("unroll") for (int k = 0; k < 2; ++k) dst[m][k] = *(const PG8_LAS bf16x8*)(lds + PG8_SA(b, h) + aoff + m * 2048 + k * 1024); } while (0)
#define PG8_LDB(dst, b, h) do { _Pragma("unroll") for (int n = 0; n < 2; ++n) _Pragma("unroll") for (int k = 0; k < 2; ++k) dst[n][k] = *(const PG8_LAS bf16x8*)(lds + PG8_SB(b, h) + boff + n * 2048 + k * 1024); } while (0)
#define PG8_MMA(ai, bj, At, Bt) do { __builtin_amdgcn_s_setprio(1); _Pragma("unroll") for (int m = 0; m < 4; ++m) _Pragma("unroll") for (int n = 0; n < 2; ++n) _Pragma("unroll") for (int k = 0; k < 2; ++k) \
        acc[ai][bj][m][n] = __builtin_amdgcn_mfma_f32_16x16x32_bf16(Bt[n][k], At[m][k], acc[ai][bj][m][n], 0, 0, 0); __builtin_amdgcn_s_setprio(0); } while (0)
#define PG8_WAIT_V(n) asm volatile("s_waitcnt vmcnt(" #n ")" ::: "memory")
#define PG8_WAIT_L(n) asm volatile("s_waitcnt lgkmcnt(" #n ")" ::: "memory")
#define PG8_BAR __builtin_amdgcn_s_barrier()
#define PG8_SCHED __builtin_amdgcn_sched_barrier(0)
    Unit cur, nxt; int ui = 0;
    if (!S.next(0, cur)) return;
    f32x4 acc[2][2][4][2];
#pragma unroll
    for (int a = 0; a < 2; ++a)
#pragma unroll
        for (int b = 0; b < 2; ++b)
#pragma unroll
            for (int m = 0; m < 4; ++m)
#pragma unroll
                for (int n = 0; n < 2; ++n) acc[a][b][m][n] = (f32x4){0.f, 0.f, 0.f, 0.f};
    bf16x8 At[4][2], B0[2][2], B1[2][2];
    const char* cA = (const char*)g.A + (size_t)cur.pm * tstep; const char* cB = (const char*)g.Bt + (size_t)cur.pn * tstep;
    S.a_ready(cur);
    PG8_STAGE(PG8_SB(0, 0), cB, voffB); PG8_STAGE(PG8_SA(0, 0), cA, voffA); PG8_STAGE(PG8_SB(0, 1), cB + hstep, voffB); PG8_STAGE(PG8_SA(0, 1), cA + hstep, voffA);
    if (wr == 1) PG8_BAR;
    PG8_WAIT_V(4); PG8_BAR;
    PG8_STAGE(PG8_SB(1, 0), cB + kstep, voffB); PG8_STAGE(PG8_SA(1, 0), cA + kstep, voffA); PG8_STAGE(PG8_SB(1, 1), cB + hstep + kstep, voffB);
    PG8_WAIT_V(6); PG8_BAR;
    PG8_STAMP();
    for (;;) {
        const bool has_next = S.next(ui + 1, nxt);
        const char* nA = has_next ? (const char*)g.A + (size_t)nxt.pm * tstep : cA; const char* nB = has_next ? (const char*)g.Bt + (size_t)nxt.pn * tstep : cB;
        for (int t = 0; t < nt; t += 2) {
            const bool last = (t == nt - 2);
            const char* a1 = cA + (size_t)(t + 1) * kstep;
            const char* a2 = last ? nA : cA + (size_t)(t + 2) * kstep; const char* b2 = last ? nB : cB + (size_t)(t + 2) * kstep;
            const char* a3 = a2 + kstep; const char* b3 = b2 + kstep;
            if (last && has_next) S.a_ready(nxt);
            PG8_LDB(B0, 0, 0); PG8_SCHED; PG8_LDA(At, 0, 0); PG8_STAGE(PG8_SA(1, 1), a1 + hstep, voffA);
            PG8_WAIT_L(8); PG8_BAR; PG8_WAIT_L(0); PG8_MMA(0, 0, At, B0); PG8_BAR; PG8_SCHED;
            PG8_LDB(B1, 0, 1); PG8_STAGE(PG8_SB(0, 0), b2, voffB);
            PG8_BAR; PG8_WAIT_L(0); PG8_MMA(0, 1, At, B1); PG8_BAR;
            PG8_LDA(At, 0, 1); PG8_STAGE(PG8_SA(0, 0), a2, voffA);
            PG8_BAR; PG8_WAIT_L(0); PG8_MMA(1, 0, At, B0); PG8_BAR; PG8_SCHED;
            PG8_STAGE(PG8_SB(0, 1), b2 + hstep, voffB);
            PG8_WAIT_V(6); PG8_BAR; PG8_MMA(1, 1, At, B1); PG8_BAR;
            PG8_LDB(B0, 1, 0); PG8_SCHED; PG8_LDA(At, 1, 0); PG8_STAGE(PG8_SA(0, 1), a2 + hstep, voffA);
            PG8_WAIT_L(8); PG8_BAR; PG8_WAIT_L(0); PG8_MMA(0, 0, At, B0); PG8_BAR; PG8_SCHED;
            PG8_LDB(B1, 1, 1); PG8_STAGE(PG8_SB(1, 0), b3, voffB);
            PG8_BAR; PG8_WAIT_L(0); PG8_MMA(0, 1, At, B1); PG8_BAR;
            PG8_LDA(At, 1, 1); PG8_STAGE(PG8_SA(1, 0), a3, voffA);
            PG8_BAR; PG8_WAIT_L(0); PG8_MMA(1, 0, At, B0); PG8_BAR; PG8_SCHED;
            PG8_STAGE(PG8_SB(1, 1), b3 + hstep, voffB);
            PG8_WAIT_V(6); PG8_BAR; PG8_MMA(1, 1, At, B1); PG8_BAR;
        }
        PG8_STAMP();
        if constexpr (!Epi::AFTER_DRAIN) { E(acc, cur, wr, wc, fr, fq); S.done(cur); }
        PG8_STAMP();
        if (!has_next) break;
#pragma unroll
        for (int a = 0; a < 2; ++a)
#pragma unroll
            for (int b = 0; b < 2; ++b)
#pragma unroll
                for (int m = 0; m < 4; ++m)
#pragma unroll
                    for (int n = 0; n < 2; ++n) acc[a][b][m][n] = (f32x4){0.f, 0.f, 0.f, 0.f};
        cur = nxt; cA = nA; cB = nB; ++ui;
    }
    PG8_WAIT_V(0);
    if (wr == 0) PG8_BAR;
    PG8_BAR;
    if constexpr (Epi::AFTER_DRAIN) { E.fused(acc, cur, wr, wc, fr, fq, lds, wid, lane); S.done(cur); }
    PG8_STAMP();
    if (STAMP && wid == 0) { stamps[lane] = lane < nts ? (((unsigned long long)(unsigned)ts_hi << 32) | (unsigned)ts_lo) : 0ull;
        if (lane == 62) stamps[62] = rt_entry; if (lane == 63) stamps[63] = (unsigned long long)wall_clock64(); }
#undef PG8_STAMP
#undef PG8_SA
#undef PG8_SB
#undef PG8_STAGE
#undef PG8_LDA
#undef PG8_LDB
#undef PG8_MMA
#undef PG8_WAIT_V
#undef PG8_WAIT_L
#undef PG8_BAR
#undef PG8_SCHED
}
}
namespace pg8 {
__device__ __forceinline__ float fsig(float x) { return __builtin_amdgcn_rcpf(1.f + __expf(-x)); }
__device__ __forceinline__ float ftanh(float x) { return 1.f - 2.f * __builtin_amdgcn_rcpf(1.f + __expf(2.f * x)); }
__device__ __forceinline__ int seq_start(int t) { return t < 4096 ? 0 : (t < 8192 ? 4096 : 8192); }

struct EpiF32 {
    static constexpr bool PERM = false, AFTER_DRAIN = false;
    float* C; int ldc;
    __device__ __forceinline__ void operator()(const f32x4 (&acc)[2][2][4][2], const Unit& u, int wr, int wc, int fr, int fq) const {
        const int row0 = u.pm * BM + wr * 64 + fr, col0 = u.pn * BM + wc * 32 + 4 * fq;
#pragma unroll
        for (int ai = 0; ai < 2; ++ai)
#pragma unroll
            for (int m = 0; m < 4; ++m) { float* rowp = C + (size_t)(row0 + ai * HALF + m * 16) * ldc + col0;
#pragma unroll
                for (int bj = 0; bj < 2; ++bj)
#pragma unroll
                    for (int n = 0; n < 2; ++n) *(f32x4*)(rowp + bj * HALF + n * 16) = acc[ai][bj][m][n]; }
    }
};
template <int ACT> struct EpiB {
    static constexpr bool PERM = true, AFTER_DRAIN = false;
    bf16_t* O; int ldc; const float* bias; const float* rs;
    __device__ __forceinline__ f32x4 actf(f32x4 v) const {
#pragma unroll
        for (int j = 0; j < 4; ++j) {
            if (ACT == 1) v[j] = 0.5f + 0.5f * ftanh(0.5f * v[j]);
            if (ACT == 2) v[j] = ftanh(v[j]);
            if (ACT == 3) v[j] = 0.6065306597f * fsig(v[j]); }
        return v; }
    __device__ __forceinline__ void operator()(const f32x4 (&acc)[2][2][4][2], const Unit& u, int wr, int wc, int fr, int fq) const {
        const int row0 = u.pm * BM + wr * 64 + fr; const int col0 = u.pn * BM + wc * 32 + 8 * fq;
#pragma unroll
        for (int bj = 0; bj < 2; ++bj) {
#pragma unroll
            for (int ai = 0; ai < 2; ++ai)
#pragma unroll
                for (int m = 0; m < 4; ++m) { const int row = row0 + ai * HALF + m * 16; const float s = rs ? rs[row] : 1.f;
                    f32x4 v0 = acc[ai][bj][m][0] * s; if (bias) v0 += *(const f32x4*)(bias + col0 + bj * HALF); v0 = actf(v0);
                    u32x4 w; w.x = cvt_pk_bf16(v0[0], v0[1]); w.y = cvt_pk_bf16(v0[2], v0[3]);
                    f32x4 v1 = acc[ai][bj][m][1] * s; if (bias) v1 += *(const f32x4*)(bias + col0 + bj * HALF + 4); v1 = actf(v1);
                    w.z = cvt_pk_bf16(v1[0], v1[1]); w.w = cvt_pk_bf16(v1[2], v1[3]);
                    *(u32x4*)(O + (size_t)row * ldc + col0 + bj * HALF) = w; __builtin_amdgcn_sched_barrier(0); } }
    }
};
struct EpiIn {
    static constexpr bool PERM = true, AFTER_DRAIN = false;
    bf16_t *cq, *ckv, *qb, *kb, *vb, *kr; const float* rs; const float* cs; const float* sn;
    __device__ __forceinline__ void operator()(const f32x4 (&acc)[2][2][4][2], const Unit& u, int wr, int wc, int fr, int fq) const {
        const int row0 = u.pm * BM + wr * 64 + fr; const int pn = u.pn;
        if (pn < 16) {
            bf16_t* base; int ldc, colt;
            if (pn < 2) { base = cq; ldc = 512; colt = pn * 256; } else if (pn < 4) { base = ckv; ldc = 512; colt = (pn - 2) * 256; }
            else if (pn < 8) { base = qb; ldc = 1024; colt = (pn - 4) * 256; } else if (pn < 12) { base = kb; ldc = 1024; colt = (pn - 8) * 256; }
            else { base = vb; ldc = 1024; colt = (pn - 12) * 256; }
            const int col0 = colt + wc * 32 + 8 * fq;
#pragma unroll
            for (int ai = 0; ai < 2; ++ai)
#pragma unroll
                for (int m = 0; m < 4; ++m) { const int row = row0 + ai * HALF + m * 16; const float s = rs[row];
                    bf16_t* rowp = base + (size_t)row * ldc + col0;
#pragma unroll
                    for (int bj = 0; bj < 2; ++bj) { const f32x4 v0 = acc[ai][bj][m][0] * s, v1 = acc[ai][bj][m][1] * s;
                        u32x4 w; w.x = cvt_pk_bf16(v0[0], v0[1]); w.y = cvt_pk_bf16(v0[2], v0[3]); w.z = cvt_pk_bf16(v1[0], v1[1]); w.w = cvt_pk_bf16(v1[2], v1[3]);
                        *(u32x4*)(rowp + bj * HALF) = w; } }
        } else if (wc < 2) {
            const int q = wc * 4 + fq;
#pragma unroll
            for (int ai = 0; ai < 2; ++ai)
#pragma unroll
                for (int m = 0; m < 4; ++m) { const int row = row0 + ai * HALF + m * 16; const float s = rs[row]; const int pos = row - seq_start(row);
                    const f32x4 c = *(const f32x4*)(cs + (size_t)pos * 32 + 4 * q), sv = *(const f32x4*)(sn + (size_t)pos * 32 + 4 * q);
                    const f32x4 x1 = acc[ai][0][m][0] * s, x2 = acc[ai][0][m][1] * s;
                    const f32x4 y1 = x1 * c - x2 * sv, y2 = x2 * c + x1 * sv;
                    u32x4 w; w.x = cvt_pk_bf16(y1[0], y1[1]); w.y = cvt_pk_bf16(y1[2], y1[3]); w.z = cvt_pk_bf16(y2[0], y2[1]); w.w = cvt_pk_bf16(y2[2], y2[3]);
                    *(u32x4*)(kr + (size_t)row * 64 + 8 * q) = w; }
        }
    }
};
struct EpiUQ {
    static constexpr bool PERM = true, AFTER_DRAIN = false;
    bf16_t* O; const float* rs; const float* cs; const float* sn;
    __device__ __forceinline__ void operator()(const f32x4 (&acc)[2][2][4][2], const Unit& u, int wr, int wc, int fr, int fq) const {
        const int row0 = u.pm * BM + wr * 64 + fr; const int col0 = u.pn * BM + wc * 32 + 8 * fq;
        const int q = (wc & 1) * 4 + fq;
#pragma unroll
        for (int ai = 0; ai < 2; ++ai)
#pragma unroll
            for (int m = 0; m < 4; ++m) { const int row = row0 + ai * HALF + m * 16; const float s = rs[row]; const int pos = row - seq_start(row);
                bf16_t* rowp = O + (size_t)row * 1536 + col0;
#pragma unroll
                for (int bj = 0; bj < 2; ++bj) { f32x4 v0 = acc[ai][bj][m][0] * s, v1 = acc[ai][bj][m][1] * s;
                    const int blk = u.pn * 4 + bj * 2 + (wc >> 1);
                    if (blk % 3 == 2) {
                        const f32x4 c = *(const f32x4*)(cs + (size_t)pos * 32 + 4 * q), sv = *(const f32x4*)(sn + (size_t)pos * 32 + 4 * q);
                        const f32x4 y1 = v0 * c - v1 * sv, y2 = v1 * c + v0 * sv; v0 = y1; v1 = y2; }
                    u32x4 w; w.x = cvt_pk_bf16(v0[0], v0[1]); w.y = cvt_pk_bf16(v0[2], v0[3]); w.z = cvt_pk_bf16(v1[0], v1[1]); w.w = cvt_pk_bf16(v1[2], v1[3]);
                    *(u32x4*)(rowp + bj * HALF) = w; } __builtin_amdgcn_sched_barrier(0); }
    }
};
struct EpiSwi {
    static constexpr bool PERM = true, AFTER_DRAIN = false;
    bf16_t* O; const float* rs;
    __device__ __forceinline__ void operator()(const f32x4 (&acc)[2][2][4][2], const Unit& u, int wr, int wc, int fr, int fq) const {
        const int row0 = u.pm * BM + wr * 64 + fr; const int col0 = u.pn * 128 + wc * 16 + 4 * fq;
#pragma unroll
        for (int ai = 0; ai < 2; ++ai)
#pragma unroll
            for (int m = 0; m < 4; ++m) { const int row = row0 + ai * HALF + m * 16; const float s = rs[row];
                bf16_t* rowp = O + (size_t)row * 5632 + col0;
#pragma unroll
                for (int bj = 0; bj < 2; ++bj) { const f32x4 g = acc[ai][bj][m][0] * s, up = acc[ai][bj][m][1] * s; f32x4 o;
#pragma unroll
                    for (int j = 0; j < 4; ++j) o[j] = g[j] * fsig(g[j]) * up[j];
                    uint2 w; w.x = cvt_pk_bf16(o[0], o[1]); w.y = cvt_pk_bf16(o[2], o[3]);
                    *(uint2*)(rowp + bj * 64) = w; } }
    }
};
}

namespace pg8 {
struct LoraOrder {
    int c;
    __device__ bool next(int i, Unit& u) const { if (c >= 144 || i >= 2) return false; const int id = c * 2 + i; u.pm = id; u.pn = id / 96; return true; }
    __device__ __forceinline__ void a_ready(const Unit&) const {}
    __device__ __forceinline__ void done(const Unit&) const {}
};
struct EpiLora {
    static constexpr bool PERM = true, AFTER_DRAIN = false;
    bf16_t *wl, *al, *gl;
    __device__ __forceinline__ void operator()(const f32x4 (&acc)[2][2][4][2], const Unit& u, int wr, int wc, int fr, int fq) const {
        const int pn = u.pn; bf16_t* base = pn == 0 ? wl : (pn == 1 ? al : gl);
        const int row0 = u.pm * BM - pn * 24576 + wr * 64 + fr; const int col0 = wc * 32 + 8 * fq;
        const float sc = pn == 2 ? 0.5f : 1.f, ka = pn == 2 ? 0.5f : 1.f, kb = pn == 2 ? 0.5f : 0.f;
#pragma unroll
        for (int bj = 0; bj < 2; ++bj)
#pragma unroll
            for (int ai = 0; ai < 2; ++ai)
#pragma unroll
                for (int m = 0; m < 4; ++m) { const int row = row0 + ai * HALF + m * 16;
                    f32x4 v0 = acc[ai][bj][m][0], v1 = acc[ai][bj][m][1];
#pragma unroll
                    for (int j = 0; j < 4; ++j) { const float t0 = kb + ka * ftanh(v0[j] * sc), t1 = kb + ka * ftanh(v1[j] * sc); v0[j] = pn == 1 ? v0[j] : t0; v1[j] = pn == 1 ? v1[j] : t1; }
                    u32x4 w; w.x = cvt_pk_bf16(v0[0], v0[1]); w.y = cvt_pk_bf16(v0[2], v0[3]); w.z = cvt_pk_bf16(v1[0], v1[1]); w.w = cvt_pk_bf16(v1[2], v1[3]);
                    *(u32x4*)(base + (size_t)row * 256 + col0 + bj * HALF) = w; __builtin_amdgcn_sched_barrier(0); }
    }
};
}
namespace at {
using pg8::bf16_t; using pg8::bf16x8; using pg8::u32x4;
typedef short s16x4 __attribute__((ext_vector_type(4)));
typedef float f32x16 __attribute__((ext_vector_type(16)));
constexpr int NW = 8, QBLK = 32, KVBLK = 64;
constexpr int SHM_V = KVBLK * 128 * 2, SHM_K = KVBLK * 128 * 2, SHM_R = KVBLK * 64 * 2;
constexpr int OFF_V = 0, OFF_K = 2 * SHM_V, OFF_R = OFF_K + 2 * SHM_K, OFF_WS = OFF_R + 2 * SHM_R, OFF_BIAS = OFF_WS + NW * 64 * 4, OFF_QR = OFF_BIAS + 1024, ATT_LDS = OFF_QR + 256 * 128;
#define KSWZ(row, colB) ((row) * 256 + ((colB) ^ (((row) & 7) << 4)))
#define RSWZ(row, colB) ((row) * 128 + ((colB) ^ (((row) & 7) << 4)))
#define SBAR() __builtin_amdgcn_sched_barrier(0)
__device__ __forceinline__ int crow(int r, int hi) { return (r & 3) + 8 * (r >> 2) + 4 * hi; }
__device__ __forceinline__ unsigned cvtpk(float lo, float hi) { unsigned r; asm volatile("v_cvt_pk_bf16_f32 %0, %1, %2" : "=v"(r) : "v"(lo), "v"(hi)); return r; }
__device__ __forceinline__ bf16x8 ld8(const bf16_t* p) { return *reinterpret_cast<const bf16x8*>(p); }

__device__ __forceinline__ void partialSM(f32x16& p0, f32x16& p1, float& m_reg, float& mn, float& alpha, const float C, const float thr) {
  float pmax = p0[0];
#pragma unroll
  for (int r = 1; r < 16; ++r) pmax = fmaxf(pmax, p0[r]);
#pragma unroll
  for (int r = 0; r < 16; ++r) pmax = fmaxf(pmax, p1[r]);
  { auto rr = __builtin_amdgcn_permlane32_swap(__float_as_uint(pmax), __float_as_uint(pmax), false, false);
    pmax = fmaxf(__uint_as_float(rr[0]), __uint_as_float(rr[1])); }
  if (__builtin_expect(__all(pmax - m_reg <= thr), 1)) { mn = m_reg; alpha = 1.f; }
  else { mn = fmaxf(m_reg, pmax); alpha = __builtin_amdgcn_exp2f((m_reg - mn) * C); m_reg = mn; }
  const float mnC = -mn * C;
#pragma unroll
  for (int r = 0; r < 16; ++r) p0[r] = fmaf(p0[r], C, mnC);
#pragma unroll
  for (int r = 0; r < 16; ++r) p1[r] = fmaf(p1[r], C, mnC);
#pragma unroll
  for (int r = 0; r < 16; ++r) p0[r] = __builtin_amdgcn_exp2f(p0[r]);
}
__device__ __forceinline__ void finishSM(f32x16& p0, f32x16& p1, float alpha, float& l_reg, bf16x8& pa0, bf16x8& pa1, bf16x8& pa2, bf16x8& pa3) {
#pragma unroll
  for (int r = 0; r < 16; ++r) p1[r] = __builtin_amdgcn_exp2f(p1[r]);
  float ps = 0;
#pragma unroll
  for (int r = 0; r < 16; ++r) ps += p0[r];
#pragma unroll
  for (int r = 0; r < 16; ++r) ps += p1[r];
  { auto rr = __builtin_amdgcn_permlane32_swap(__float_as_uint(ps), __float_as_uint(ps), false, false);
    ps = __uint_as_float(rr[0]) + __uint_as_float(rr[1]); }
  l_reg = l_reg * alpha + ps;
#define PK4(P, BASE, OUT) do { unsigned a0 = cvtpk(P[BASE + 0], P[BASE + 1]), a1 = cvtpk(P[BASE + 2], P[BASE + 3]);   \
    unsigned b0 = cvtpk(P[BASE + 4], P[BASE + 5]), b1 = cvtpk(P[BASE + 6], P[BASE + 7]);                              \
    auto r0 = __builtin_amdgcn_permlane32_swap(a0, b0, false, false); auto r1 = __builtin_amdgcn_permlane32_swap(a1, b1, false, false); \
    u32x4 w = {r0[0], r1[0], r0[1], r1[1]}; OUT = *reinterpret_cast<bf16x8*>(&w); } while (0)
  PK4(p0, 0, pa0); PK4(p0, 8, pa1); PK4(p1, 0, pa2); PK4(p1, 8, pa3);
#undef PK4
}
template <int NQD>
__device__ __forceinline__ void qkt(f32x16& p0, f32x16& p1, const char* Ks, const char* Rs, const bf16x8* qr, const char* Qrs, int qrow, int r32, int hi) {
  p0 = f32x16{}; p1 = f32x16{};
#pragma unroll
  for (int d0 = 0; d0 < 8; ++d0) { const int cb = (d0 * 16 + hi * 8) * 2;
    bf16x8 b0 = *reinterpret_cast<const bf16x8*>(Ks + KSWZ(r32, cb));
    bf16x8 b1 = *reinterpret_cast<const bf16x8*>(Ks + KSWZ(32 + r32, cb));
    p0 = __builtin_amdgcn_mfma_f32_32x32x16_bf16(b0, qr[d0], p0, 0, 0, 0);
    p1 = __builtin_amdgcn_mfma_f32_32x32x16_bf16(b1, qr[d0], p1, 0, 0, 0); }
  if constexpr (NQD > 8) {
#pragma unroll
    for (int d0 = 8; d0 < NQD; ++d0) { const int cb = ((d0 - 8) * 16 + hi * 8) * 2;
      bf16x8 b0 = *reinterpret_cast<const bf16x8*>(Rs + RSWZ(r32, cb));
      bf16x8 b1 = *reinterpret_cast<const bf16x8*>(Rs + RSWZ(32 + r32, cb));
      const bf16x8 qv = *reinterpret_cast<const bf16x8*>(Qrs + RSWZ(qrow, cb));
      p0 = __builtin_amdgcn_mfma_f32_32x32x16_bf16(b0, qv, p0, 0, 0, 0);
      p1 = __builtin_amdgcn_mfma_f32_32x32x16_bf16(b1, qv, p1, 0, 0, 0); }
  }
}
__device__ __forceinline__ int v_st(int k, int c) { const int kk = (k & ~0xC) | ((k & 4) << 1) | ((k & 8) >> 1); return ((kk >> 3) * 4 + (c >> 5)) * 512 + ((kk & 7) * 32 + (c & 31)) * 2; }
__device__ __forceinline__ int v_rd_base(int lane) { return ((lane & 3) << 3) | (((lane >> 2) & 3) << 6) | (((lane >> 4) & 1) << 5) | (((lane >> 5) & 1) << 8); }
constexpr int v_rd_off(int d0, int ks, int half) { return d0 * 512 + ks * 4096 + half * 2048; }
template <int OFF> __device__ __forceinline__ s16x4 tr_read(int vb) {
  s16x4 r; asm volatile("ds_read_b64_tr_b16 %0, %1 offset:%2" : "=&v"(r) : "v"(vb), "i"(OFF) : "memory"); return r;
}
template <int D0> __device__ __forceinline__ void pv_one(f32x16& od, int vb, bf16x8 pa0, bf16x8 pa1, bf16x8 pa2, bf16x8 pa3) {
  const s16x4 l0 = tr_read<v_rd_off(D0, 0, 0)>(vb), h0 = tr_read<v_rd_off(D0, 0, 1)>(vb), l1 = tr_read<v_rd_off(D0, 1, 0)>(vb), h1 = tr_read<v_rd_off(D0, 1, 1)>(vb);
  const s16x4 l2 = tr_read<v_rd_off(D0, 2, 0)>(vb), h2 = tr_read<v_rd_off(D0, 2, 1)>(vb), l3 = tr_read<v_rd_off(D0, 3, 0)>(vb), h3 = tr_read<v_rd_off(D0, 3, 1)>(vb);
  asm volatile("s_waitcnt lgkmcnt(0)" ::: "memory"); SBAR();
#define PK(L, H) (bf16x8){L[0], L[1], L[2], L[3], H[0], H[1], H[2], H[3]}
  od = __builtin_amdgcn_mfma_f32_32x32x16_bf16(pa0, PK(l0, h0), od, 0, 0, 0);
  od = __builtin_amdgcn_mfma_f32_32x32x16_bf16(pa1, PK(l1, h1), od, 0, 0, 0);
  od = __builtin_amdgcn_mfma_f32_32x32x16_bf16(pa2, PK(l2, h2), od, 0, 0, 0);
  od = __builtin_amdgcn_mfma_f32_32x32x16_bf16(pa3, PK(l3, h3), od, 0, 0, 0);
#undef PK
}
__device__ __forceinline__ void pv_d0(f32x16* o, int vb, bf16x8 pa0, bf16x8 pa1, bf16x8 pa2, bf16x8 pa3) {
  pv_one<0>(o[0], vb, pa0, pa1, pa2, pa3); pv_one<1>(o[1], vb, pa0, pa1, pa2, pa3); pv_one<2>(o[2], vb, pa0, pa1, pa2, pa3); pv_one<3>(o[3], vb, pa0, pa1, pa2, pa3);
}

struct Args {
  const bf16_t* Q;
  const bf16_t* K;
  const bf16_t* Kr;
  const bf16_t* V;
  bf16_t* O;
  float* lse; long ldlse;
  int nt;
  int kb0, L;
  const float* biasG;
  float C, thr;
};

template <int NQD, bool DIL, long LDQ, long LDK, long LDO>
__device__ __forceinline__ void attn_body(const Args& A, char* lds) {
  const int tid = tidx(), wid = tid >> 6, lane = tid & 63, r32 = lane & 31, hi = lane >> 5;
  char* V_lds = lds + OFF_V; char* K_lds = lds + OFF_K; char* R_lds = lds + OFF_R;
  float* ws = (float*)(lds + OFF_WS) + wid * 64; float* li_l = ws; float* al_l = ws + 32;
  float* biasL = (float*)(lds + OFF_BIAS);
  char* Qr_lds = lds + OFF_QR;
  float m_reg = -1e30f, l_reg = 0; f32x16 o[4] = {}; bf16x8 qr[8];
  const bf16_t* Qw = A.Q + (long)(wid * QBLK + r32) * LDQ + hi * 8;
#pragma unroll
  for (int d0 = 0; d0 < 8; ++d0) qr[d0] = ld8(Qw + d0 * 16);
  if constexpr (NQD > 8) {
#pragma unroll
    for (int d0 = 8; d0 < NQD; ++d0) *(bf16x8*)(Qr_lds + RSWZ(wid * 32 + r32, ((d0 - 8) * 16 + hi * 8) * 2)) = ld8(Qw + d0 * 16);
  }
  if constexpr (DIL) { if (tid < 129) biasL[tid] = A.biasG[tid]; }
  const int sr = tid >> 4, sc = (tid & 15) * 8, vst0 = v_st(sr, sc), vst1 = v_st(32 + sr, sc);
  const int rr_ = tid >> 3, rc_ = (tid & 7) * 8;
  const int vb0 = (int)(uintptr_t)V_lds + v_rd_base(lane);
  bf16x8 vs0, vs1, ks0, ks1, rs0;
  const int Lm1 = A.L - 1;
#define SLOAD(i) do { long ra, rb; if constexpr (DIL) { int a_ = A.kb0 + (i) * 64 + sr, b_ = a_ + 32; a_ = a_ < 0 ? 0 : (a_ > Lm1 ? Lm1 : a_); b_ = b_ < 0 ? 0 : (b_ > Lm1 ? Lm1 : b_); ra = a_; rb = b_; } \
      else { ra = (i) * 64 + sr; rb = ra + 32; } \
    vs0 = ld8(A.V + ra * LDK + sc); vs1 = ld8(A.V + rb * LDK + sc); ks0 = ld8(A.K + ra * LDK + sc); ks1 = ld8(A.K + rb * LDK + sc); \
    if constexpr (NQD > 8) rs0 = ld8(A.Kr + (long)((i) * 64 + rr_) * 64 + rc_); } while (0)
#define SWRITE(b) do { *(bf16x8*)(V_lds + (b) * SHM_V + vst0) = vs0; *(bf16x8*)(V_lds + (b) * SHM_V + vst1) = vs1; const int kc = sc * 2; \
    *(bf16x8*)(K_lds + (b) * SHM_K + KSWZ(sr, kc)) = ks0; *(bf16x8*)(K_lds + (b) * SHM_K + KSWZ(32 + sr, kc)) = ks1; \
    if constexpr (NQD > 8) *(bf16x8*)(R_lds + (b) * SHM_R + RSWZ(rr_, rc_ * 2)) = rs0; } while (0)
#define SWAIT() asm volatile("s_waitcnt vmcnt(0)" ::: "memory")
#define RESC(a) do { if (__any((a) < 1.f)) { if (hi == 0) al_l[r32] = (a); asm volatile("s_waitcnt lgkmcnt(0)" ::: "memory"); \
    _Pragma("unroll") for (int d = 0; d < 4; ++d) _Pragma("unroll") for (int r = 0; r < 16; ++r) o[d][r] *= al_l[crow(r, hi)]; } } while (0)
#define MASK(P0, P1, i) do { if constexpr (DIL) { const int relb = 64 * ((i) - 1) - (wid * 32 + r32); const int kpb = A.kb0 + 64 * (i); \
    _Pragma("unroll") for (int r = 0; r < 16; ++r) { const int key = crow(r, hi); \
      { const int rel = relb + key, kp = kpb + key; const bool ok = rel >= -64 && rel <= 64 && kp >= 0 && kp <= Lm1; const int ix = ok ? rel + 64 : 0; P0[r] = ok ? fmaf(P0[r], A.C, biasL[ix]) : -1e30f; } \
      { const int rel = relb + key + 32, kp = kpb + key + 32; const bool ok = rel >= -64 && rel <= 64 && kp >= 0 && kp <= Lm1; const int ix = ok ? rel + 64 : 0; P1[r] = ok ? fmaf(P1[r], A.C, biasL[ix]) : -1e30f; } } } } while (0)
  const float Csm = DIL ? 1.f : A.C; const float thr = A.thr;
  f32x16 pA0, pA1; float mnA, alA; bf16x8 pa0, pa1, pa2, pa3; const int NT = A.nt;
  {
    SLOAD(0); SWAIT(); SWRITE(0); __syncthreads();
    for (int i = 0; i < NT; ++i) {
      if constexpr (!DIL) { if (i + 1 < NT) SLOAD(i + 1); }
      SBAR();
      bool live = true;
      if constexpr (DIL) { const int k0 = 64 * (i - 1), q0 = wid * 32; live = (k0 - (q0 + 31) <= 64) && (q0 - (k0 + 63) <= 64) && (A.kb0 + 64 * i + 63 >= 0) && (A.kb0 + 64 * i <= Lm1); }
      if (live) {
      qkt<NQD>(pA0, pA1, K_lds + (i & 1) * SHM_K, R_lds + (i & 1) * SHM_R, qr, Qr_lds, wid * 32 + r32, r32, hi); MASK(pA0, pA1, i); partialSM(pA0, pA1, m_reg, mnA, alA, Csm, thr);
      RESC(alA);
      finishSM(pA0, pA1, alA, l_reg, pa0, pa1, pa2, pa3); SBAR();
      pv_d0(o, vb0 + (i & 1) * SHM_V, pa0, pa1, pa2, pa3);
      }
      if (i + 1 < NT) { if constexpr (DIL) SLOAD(i + 1); SWAIT(); SWRITE((i + 1) & 1); }
      __syncthreads();
    }
  }
  if (hi == 0) li_l[r32] = l_reg; asm volatile("s_waitcnt lgkmcnt(0)" ::: "memory");
  if constexpr (DIL) { if (hi == 0) A.lse[(long)(wid * QBLK + r32) * A.ldlse] = m_reg + __log2f(l_reg); }
  float rli[16];
#pragma unroll
  for (int r = 0; r < 16; ++r) rli[r] = __builtin_amdgcn_rcpf(li_l[crow(r, hi)]);
  bf16_t* Ow = A.O + (long)(wid * QBLK) * LDO;
#pragma unroll
  for (int r = 0; r < 16; ++r) { const int orow = crow(r, hi);
#pragma unroll
    for (int d0 = 0; d0 < 4; ++d0) { const float v = o[d0][r] * rli[r]; Ow[(long)orow * LDO + d0 * 32 + r32] = (bf16_t)(cvtpk(v, v) & 0xffffu); } }
  __syncthreads();
#undef SLOAD
#undef SWRITE
#undef SWAIT
#undef RESC
#undef MASK
}
}
using pg8::bf16_t; using pg8::bf16x8; using pg8::f32x4; using pg8::u32x4;
constexpr int T = 24576, DM = 2048, FH = 5632, NTHR = 512;
constexpr size_t MiB = 1048576;
constexpr size_t O_WM = 0, O_SM = 40 * MiB, O_RF = 104 * MiB, O_RA = 200 * MiB, O_RB = 296 * MiB, O_RC = 392 * MiB, O_RD = 488 * MiB, O_RE = 584 * MiB, O_RX = 680 * MiB,
                 O_RG = 776 * MiB, O_RH = 872 * MiB, WS_END = 968 * MiB;
constexpr size_t S_RINV = O_SM, S_RINVQ = S_RINV + 131072, S_RINVKV = S_RINVQ + 131072, S_LSE = S_RINVKV + 131072  , S_COS = S_LSE + 2359296  ,
                 S_SIN = S_COS + 2 * MiB, S_BIAS = S_SIN + 2 * MiB  , S_GL = S_BIAS + 16384  , S_WL = S_GL + 12 * MiB, S_AL = S_WL + 12 * MiB, S_END = S_AL + 12 * MiB;
static_assert(S_END <= O_RF, "small region overflow");
constexpr int LDS_BYTES = 131072;
static_assert(at::ATT_LDS <= LDS_BYTES, "attention LDS");

struct Params {
  const float *xp, *xs, *norm_g, *rel_bias, *w_in, *q_norm, *kv_norm, *w_uq, *w_ukv, *w_out, *mu, *w_r, *w_k, *w_v, *w_o, *w0, *w1, *w2, *a0, *a1, *a2, *g1, *g2, *k_k, *k_a, *r_k, *ln_w, *ln_b,
              *w_gate, *w_up, *w_down;
  float* out; unsigned char* ws; int ph_lo, ph_hi;
};

__device__ __forceinline__ float bf2f(bf16_t b) { return __uint_as_float(((unsigned)b) << 16); }
__device__ __forceinline__ bf16_t f2bf(float f) { unsigned u = __float_as_uint(f); u += 0x7FFFu + ((u >> 16) & 1u); return (bf16_t)(u >> 16); }
__device__ __forceinline__ float wave_sum(float x) {
#pragma unroll
  for (int o = 32; o >= 1; o >>= 1) x += __shfl_xor(x, o);
  return x;
}
template <int CTRL> __device__ __forceinline__ float dpp_f(float x) { return __int_as_float(__builtin_amdgcn_update_dpp(0, __float_as_int(x), CTRL, 0xF, 0xF, false)); }
__device__ __forceinline__ float row16_sum(float x) { x += dpp_f<0x128>(x); x += dpp_f<0x124>(x); x += dpp_f<0x122>(x); x += dpp_f<0x121>(x); return x; }

struct WMap { const float* s0; const float* s1; const float* gain; int ld; int mode; };
__device__ __forceinline__ int rope_dim(int p) { const int q = p >> 3, w = p & 7; return w < 4 ? 4 * q + w : 32 + 4 * q + (w - 4); }
__device__ __forceinline__ float wmap_get(const WMap& m, int k, int n) {
  float g = m.gain ? m.gain[k] : 1.f;
  switch (m.mode) {
    case 0: return m.s0[(size_t)k * m.ld + n] * g;
    case 1: { int col; if (n < 1024) col = n; else if (n < 4096) col = n + 64; else if (n < 4160) col = 1024 + rope_dim(n - 4096); else return 0.f; return m.s0[(size_t)k * 4160 + col] * g; }
    case 2: { const int h = n / 192, c = n - h * 192; const int col = c < 128 ? n : h * 192 + 128 + rope_dim(c - 128); return m.s0[(size_t)k * 1536 + col] * g; }
    case 3: { const int g8 = n >> 3, w = n & 7; return (w < 4 ? m.s0[(size_t)k * FH + g8 * 4 + w] : m.s1[(size_t)k * FH + g8 * 4 + w - 4]) * g; }
    case 4: { if (n < 96) return m.s0[(size_t)k * 96 + n]; if (n < 192) return m.s1[(size_t)k * 96 + n - 96]; return 0.f; }
    default: { const int d = n >> 11, kk = k - d * 96; if (kk < 0 || kk >= 96) return 0.f; return (d ? m.s1 : m.s0)[(size_t)kk * 2048 + (n & 2047)]; }
  }
}
__device__ __forceinline__ void convert_T(const WMap& m, bf16_t* dst, int N, int K, float* tile  ) {
  const int tid = tidx(), ntn = N >> 6, ntk = K >> 6, nt = ntn * ntk;
  for (int t = blockIdx.x; t < nt; t += gridDim.x) {
    const int n0 = (t % ntn) << 6, k0 = (t / ntn) << 6;
    { const int j = tid & 63, i0 = tid >> 6;
#pragma unroll
      for (int kk = 0; kk < 8; ++kk) { const int kl = i0 * 8 + kk; tile[kl * 65 + j] = wmap_get(m, k0 + kl, n0 + j); } }
    __syncthreads();
    { const int nl = tid >> 3, kc = (tid & 7) * 8; float v[8];
#pragma unroll
      for (int e = 0; e < 8; ++e) v[e] = tile[(kc + e) * 65 + nl];
      u32x4 w; w.x = pg8::cvt_pk_bf16(v[0], v[1]); w.y = pg8::cvt_pk_bf16(v[2], v[3]); w.z = pg8::cvt_pk_bf16(v[4], v[5]); w.w = pg8::cvt_pk_bf16(v[6], v[7]);
      *(u32x4*)(dst + (size_t)(n0 + nl) * K + k0 + kc) = w; }
    __syncthreads();
  }
}
__device__ __forceinline__ void convert_attn_weights(const Params& p, int i, int layer, float* tile) {
  bf16_t* W = (bf16_t*)(p.ws + O_WM);
  { WMap m{p.w_in + (size_t)i * 2048 * 4160, nullptr, p.norm_g + (size_t)(layer * 4 + 0) * DM, 4160, 1}; convert_T(m, W, 4352, 2048, tile); }
  { WMap m{p.w_uq + (size_t)i * 512 * 1536, nullptr, p.q_norm + (size_t)i * 512, 1536, 2}; convert_T(m, W + 8912896, 1536, 512, tile); }
  { WMap m{p.w_ukv + (size_t)i * 512 * 2048, nullptr, p.kv_norm + (size_t)i * 512, 2048, 0}; convert_T(m, W + 8912896 + 786432, 2048, 512, tile); }
  { WMap m{p.w_out + (size_t)i * 2048 * 2048, nullptr, nullptr, 2048, 0}; convert_T(m, W + 8912896 + 786432 + 1048576, 2048, 2048, tile); }
}
constexpr size_t WA_IN = 0, WA_UQ = 8912896, WA_UKV = WA_UQ + 786432, WA_OUT = WA_UKV + 1048576;
constexpr size_t WR_R = 0, WR_K = 4194304, WR_V = 2 * 4194304, WR_O = 3 * 4194304, WR_W1 = 4 * 4194304, WR_A1 = WR_W1 + 524288, WR_G1 = WR_A1 + 524288, WR_G2 = WR_G1 + 524288,
                 WR_W2 = WR_G2 + 524288, WR_A2 = WR_W2 + 1048576;
static_assert((WR_A2 + 1048576) * 2 == 40 * MiB, "rwkv weights size");
__device__ __forceinline__ void convert_rwkv_weights(const Params& p, int i, float* tile) {
  bf16_t* W = (bf16_t*)(p.ws + O_WM); const size_t DD = (size_t)DM * DM;
  { WMap m{p.w_r + i * DD, nullptr, nullptr, 2048, 0}; convert_T(m, W + WR_R, 2048, 2048, tile); }
  { WMap m{p.w_k + i * DD, nullptr, nullptr, 2048, 0}; convert_T(m, W + WR_K, 2048, 2048, tile); }
  { WMap m{p.w_v + i * DD, nullptr, nullptr, 2048, 0}; convert_T(m, W + WR_V, 2048, 2048, tile); }
  { WMap m{p.w_o + i * DD, nullptr, nullptr, 2048, 0}; convert_T(m, W + WR_O, 2048, 2048, tile); }
  { WMap m{p.w1 + (size_t)(i * 2) * 2048 * 96, p.w1 + (size_t)(i * 2 + 1) * 2048 * 96, nullptr, 96, 4}; convert_T(m, W + WR_W1, 256, 2048, tile); }
  { WMap m{p.a1 + (size_t)(i * 2) * 2048 * 96, p.a1 + (size_t)(i * 2 + 1) * 2048 * 96, nullptr, 96, 4}; convert_T(m, W + WR_A1, 256, 2048, tile); }
  { WMap m{p.g1 + (size_t)i * 2048 * 256, nullptr, nullptr, 256, 0}; convert_T(m, W + WR_G1, 256, 2048, tile); }
  { WMap m{p.g2 + (size_t)i * 256 * 2048, nullptr, nullptr, 2048, 0}; convert_T(m, W + WR_G2, 2048, 256, tile); }
  { WMap m{p.w2 + (size_t)(i * 2) * 96 * 2048, p.w2 + (size_t)(i * 2 + 1) * 96 * 2048, nullptr, 2048, 5}; convert_T(m, W + WR_W2, 4096, 256, tile); }
  { WMap m{p.a2 + (size_t)(i * 2) * 96 * 2048, p.a2 + (size_t)(i * 2 + 1) * 96 * 2048, nullptr, 2048, 5}; convert_T(m, W + WR_A2, 4096, 256, tile); }
}
constexpr size_t WF_GU = 0, WF_DN = (size_t)11264 * 2048;
__device__ __forceinline__ void convert_ffn_weights(const Params& p, int layer, float* tile) {
  bf16_t* W = (bf16_t*)(p.ws + O_RF); const size_t DF = (size_t)DM * FH;
  { WMap m{p.w_gate + layer * DF, p.w_up + layer * DF, p.norm_g + (size_t)(layer * 4 + 2) * DM, FH, 3}; convert_T(m, W + WF_GU, 11264, 2048, tile); }
  { WMap m{p.w_down + layer * DF, nullptr, nullptr, 2048, 0}; convert_T(m, W + WF_DN, 2048, 5632, tile); }
}
__device__ __forceinline__ void convert_mixer_weights(const Params& p, int layer, float* tile) { if (layer & 1) convert_rwkv_weights(p, layer >> 1, tile); else convert_attn_weights(p, layer >> 1, layer, tile); }

__device__ __forceinline__ void resid_phase(const Params& p, const bf16_t* mix, const float* g) {
  const int lane = tidx() & 63, gw = blockIdx.x * 8 + (tidx() >> 6), nw = gridDim.x * 8;
  bf16_t* xb = (bf16_t*)(p.ws + O_RC); float* rinv = (float*)(p.ws + S_RINV);
  for (int t = gw; t < T; t += nw) {
    float* xr = p.out + (size_t)t * DM; float xv[4][8];
    if (mix) {
      const bf16_t* mr = mix + (size_t)t * DM; float mv[4][8]; float ss = 0;
#pragma unroll
      for (int i = 0; i < 4; ++i) { const bf16x8 m8 = *(const bf16x8*)(mr + i * 512 + lane * 8);
#pragma unroll
        for (int e = 0; e < 8; ++e) { mv[i][e] = bf2f((bf16_t)m8[e]); ss += mv[i][e] * mv[i][e]; } }
      ss = wave_sum(ss); const float sc = rsqrtf(ss * (1.f / DM) + 1e-6f);
#pragma unroll
      for (int i = 0; i < 4; ++i) { const f32x4 g0 = *(const f32x4*)(g + i * 512 + lane * 8), g1 = *(const f32x4*)(g + i * 512 + lane * 8 + 4);
        const f32x4 x0 = *(const f32x4*)(xr + i * 512 + lane * 8), x1 = *(const f32x4*)(xr + i * 512 + lane * 8 + 4);
#pragma unroll
        for (int e = 0; e < 4; ++e) { xv[i][e] = x0[e] + mv[i][e] * sc * g0[e]; xv[i][4 + e] = x1[e] + mv[i][4 + e] * sc * g1[e]; } }
    } else {
      const float* src = t < 8192 ? p.xp + (size_t)t * DM : p.xs + (size_t)(t - 8192) * DM;
#pragma unroll
      for (int i = 0; i < 4; ++i) { const f32x4 x0 = *(const f32x4*)(src + i * 512 + lane * 8), x1 = *(const f32x4*)(src + i * 512 + lane * 8 + 4);
#pragma unroll
        for (int e = 0; e < 4; ++e) { xv[i][e] = x0[e]; xv[i][4 + e] = x1[e]; } }
    }
    float s2 = 0;
#pragma unroll
    for (int i = 0; i < 4; ++i) {
#pragma unroll
      for (int e = 0; e < 8; ++e) s2 += xv[i][e] * xv[i][e];
      *(f32x4*)(xr + i * 512 + lane * 8) = (f32x4){xv[i][0], xv[i][1], xv[i][2], xv[i][3]}; *(f32x4*)(xr + i * 512 + lane * 8 + 4) = (f32x4){xv[i][4], xv[i][5], xv[i][6], xv[i][7]};
      u32x4 w; w.x = pg8::cvt_pk_bf16(xv[i][0], xv[i][1]); w.y = pg8::cvt_pk_bf16(xv[i][2], xv[i][3]); w.z = pg8::cvt_pk_bf16(xv[i][4], xv[i][5]); w.w = pg8::cvt_pk_bf16(xv[i][6], xv[i][7]);
      *(u32x4*)(xb + (size_t)t * DM + i * 512 + lane * 8) = w; }
    s2 = wave_sum(s2); if (lane == 0) rinv[t] = rsqrtf(s2 * (1.f / DM) + 1e-6f);
  }
}
__device__ __forceinline__ void rownorm_phase(const Params& p) {
  const int lane = tidx() & 63, gw = blockIdx.x * 8 + (tidx() >> 6), nw = gridDim.x * 8;
  const bf16_t* cq = (const bf16_t*)(p.ws + O_RA); const bf16_t* ckv = cq + (size_t)T * 512;
  float* rq = (float*)(p.ws + S_RINVQ); float* rkv = (float*)(p.ws + S_RINVKV);
  for (int t = gw; t < 2 * T; t += nw) { const int tt = t >= T ? t - T : t; const bf16_t* src = (t >= T ? ckv : cq) + (size_t)tt * 512 + lane * 8;
    const bf16x8 v = *(const bf16x8*)src; float ss = 0;
#pragma unroll
    for (int e = 0; e < 8; ++e) { const float f = bf2f((bf16_t)v[e]); ss += f * f; }
    ss = wave_sum(ss); if (lane == 0) (t >= T ? rkv : rq)[tt] = rsqrtf(ss * (1.f / 512) + 1e-6f); }
}
__device__ __forceinline__ void mix_phase(const Params& p, const float* g0, const float* mu  , int sel0, int sel1, int sel2) {
  const int lane = tidx() & 63, gw = blockIdx.x * 8 + (tidx() >> 6), nw = gridDim.x * 8;
  const float* rinv = (const float*)(p.ws + S_RINV);
  bf16_t* m0 = (bf16_t*)(p.ws + O_RD); bf16_t* m1 = (bf16_t*)(p.ws + O_RE); bf16_t* m2 = (bf16_t*)(p.ws + O_RX);
  for (int t = gw; t < T; t += nw) {
    const int s0 = pg8::seq_start(t), len = s0 == 8192 ? 16384 : 4096; const bool hasp = t > s0, hasn = t < s0 + len - 1;
    const float rc = rinv[t], rp = hasp ? rinv[t - 1] : 0.f, rn = hasn ? rinv[t + 1] : 0.f;
    const float* xc = p.out + (size_t)t * DM; const float* xpv = hasp ? xc - DM : xc; const float* xnv = hasn ? xc + DM : xc;
#pragma unroll 2
    for (int i = 0; i < 8; ++i) { const int c = i * 256 + lane * 4;
      const f32x4 gv = *(const f32x4*)(g0 + c); const f32x4 h = *(const f32x4*)(xc + c) * rc * gv, hp = *(const f32x4*)(xpv + c) * rp * gv, hn = *(const f32x4*)(xnv + c) * rn * gv;
      const f32x4 xx = (hp + hn) * 0.5f - h;
      const f32x4 a = h + xx * *(const f32x4*)(mu + sel0 * DM + c), b = h + xx * *(const f32x4*)(mu + sel1 * DM + c), d = h + xx * *(const f32x4*)(mu + sel2 * DM + c);
      uint2 w; w.x = pg8::cvt_pk_bf16(a[0], a[1]); w.y = pg8::cvt_pk_bf16(a[2], a[3]); *(uint2*)(m0 + (size_t)t * DM + c) = w;
      w.x = pg8::cvt_pk_bf16(b[0], b[1]); w.y = pg8::cvt_pk_bf16(b[2], b[3]); *(uint2*)(m1 + (size_t)t * DM + c) = w;
      w.x = pg8::cvt_pk_bf16(d[0], d[1]); w.y = pg8::cvt_pk_bf16(d[2], d[3]); *(uint2*)(m2 + (size_t)t * DM + c) = w; }
  }
}
__device__ __forceinline__ float sum8(float x) { x += __shfl_xor(x, 1); x += __shfl_xor(x, 2); x += __shfl_xor(x, 4); return x; }
__device__ __forceinline__ void postscan_phase(const Params& p, int i) {
  const int lane = tidx() & 63, gw = blockIdx.x * 8 + (tidx() >> 6), nw = gridDim.x * 8;
  bf16_t* y0 = (bf16_t*)(p.ws + O_RH); const bf16_t* y1 = (const bf16_t*)(p.ws + O_RF);
  const bf16_t* r = (const bf16_t*)(p.ws + O_RA); const bf16_t* k = (const bf16_t*)(p.ws + O_RB); const bf16_t* v = (const bf16_t*)(p.ws + O_RC); const bf16_t* g = (const bf16_t*)(p.ws + O_RD);
  const float* lnw = p.ln_w + (size_t)i * DM; const float* lnb = p.ln_b + (size_t)i * DM; const float* rk = p.r_k + (size_t)i * DM;
  for (int t = gw; t < T; t += nw) {
#pragma unroll 2
    for (int hg = 0; hg < 4; ++hg) { const int c = hg * 512 + lane * 8; const size_t ix = (size_t)t * DM + c;
      const bf16x8 a0 = *(const bf16x8*)(y0 + ix), a1 = *(const bf16x8*)(y1 + ix), rv = *(const bf16x8*)(r + ix), kv = *(const bf16x8*)(k + ix), vv = *(const bf16x8*)(v + ix), gv = *(const bf16x8*)(g + ix);
      const f32x4 w0 = *(const f32x4*)(lnw + c), w1 = *(const f32x4*)(lnw + c + 4), b0 = *(const f32x4*)(lnb + c), b1 = *(const f32x4*)(lnb + c + 4), q0 = *(const f32x4*)(rk + c), q1 = *(const f32x4*)(rk + c + 4);
      float y[8]; float s = 0.f, bs = 0.f;
#pragma unroll
      for (int e = 0; e < 8; ++e) { y[e] = bf2f((bf16_t)a0[e]) + bf2f((bf16_t)a1[e]); s += y[e]; bs += bf2f((bf16_t)rv[e]) * bf2f((bf16_t)kv[e]) * (e < 4 ? q0[e & 3] : q1[e & 3]); }
      const float mean = sum8(s) * (1.f / 64); const float bonus = sum8(bs);
      float vs = 0.f;
#pragma unroll
      for (int e = 0; e < 8; ++e) { y[e] -= mean; vs += y[e] * y[e]; }
      const float rstd = rsqrtf(sum8(vs) * (1.f / 64) + 64e-5f);
      float o[8];
#pragma unroll
      for (int e = 0; e < 8; ++e) { const float wv = e < 4 ? w0[e & 3] : w1[e & 3], bv = e < 4 ? b0[e & 3] : b1[e & 3];
        o[e] = (y[e] * rstd * wv + bv + bonus * bf2f((bf16_t)vv[e])) * bf2f((bf16_t)gv[e]); }
      u32x4 w; w.x = pg8::cvt_pk_bf16(o[0], o[1]); w.y = pg8::cvt_pk_bf16(o[2], o[3]); w.z = pg8::cvt_pk_bf16(o[4], o[5]); w.w = pg8::cvt_pk_bf16(o[6], o[7]);
      *(u32x4*)(y0 + ix) = w; }
  }
}
__device__ __forceinline__ void combine_phase(const Params& p) {
  const bf16_t* Op = (const bf16_t*)(p.ws + O_RX); const float* lse = (const float*)(p.ws + S_LSE); bf16_t* cat = (bf16_t*)(p.ws + O_RF);
  const size_t n = (size_t)T * 128;
  for (size_t it = (size_t)blockIdx.x * NTHR + tidx(); it < n; it += (size_t)gridDim.x * NTHR) {
    const int t = (int)(it >> 7), c8 = (int)(it & 127) * 8, h = c8 >> 7;
    const float l0 = lse[((size_t)0 * T + t) * 8 + h], l1 = lse[((size_t)1 * T + t) * 8 + h], l2 = lse[((size_t)2 * T + t) * 8 + h];
    const float m = fmaxf(l0, fmaxf(l1, l2)); float w0 = __builtin_amdgcn_exp2f(l0 - m), w1 = __builtin_amdgcn_exp2f(l1 - m), w2 = __builtin_amdgcn_exp2f(l2 - m);
    const float inv = 1.f / (w0 + w1 + w2); w0 *= inv; w1 *= inv; w2 *= inv;
    const bf16x8 a = *(const bf16x8*)(Op + ((size_t)0 * T + t) * 1024 + c8), b = *(const bf16x8*)(Op + ((size_t)1 * T + t) * 1024 + c8), d = *(const bf16x8*)(Op + ((size_t)2 * T + t) * 1024 + c8);
    float o[8];
#pragma unroll
    for (int e = 0; e < 8; ++e) o[e] = w0 * bf2f((bf16_t)a[e]) + w1 * bf2f((bf16_t)b[e]) + w2 * bf2f((bf16_t)d[e]);
    u32x4 w; w.x = pg8::cvt_pk_bf16(o[0], o[1]); w.y = pg8::cvt_pk_bf16(o[2], o[3]); w.z = pg8::cvt_pk_bf16(o[4], o[5]); w.w = pg8::cvt_pk_bf16(o[6], o[7]);
    *(u32x4*)(cat + (size_t)t * DM + 1024 + c8) = w;
  }
}
__device__ __forceinline__ void tables_phase(const Params& p) {
  float* cs = (float*)(p.ws + S_COS); float* sn = (float*)(p.ws + S_SIN); float* bt = (float*)(p.ws + S_BIAS);
  for (int it = blockIdx.x * NTHR + tidx(); it < 16384 * 32; it += gridDim.x * NTHR) { const int pos = it >> 5, i = it & 31;
    const float inv = __builtin_amdgcn_exp2f(-(float)i * (13.287712379549449f / 32.f)); const float ang = (float)pos * inv;
    const double rev = (double)ang * 0.15915494309189535; const float fr = (float)(rev - __builtin_rint(rev));
    cs[it] = __builtin_amdgcn_cosf(fr); sn[it] = __builtin_amdgcn_sinf(fr); }
  for (int it = blockIdx.x * NTHR + tidx(); it < 3 * 8 * 129; it += gridDim.x * NTHR) { const int pat = it / (8 * 129), rem = it - pat * 8 * 129, h = rem / 129, rl = rem - h * 129 - 64;
    const int dil = pat == 0 ? 1 : (pat == 1 ? 4 : 16); const int rel = rl * dil; const int n = rel < 0 ? -rel : rel;
    int bucket = rel > 0 ? 16 : 0;
    if (n < 8) bucket += n; else { int lg = 8 + (int)(__log2f((float)n * 0.125f) * (8.f / 7.f)); bucket += lg < 15 ? lg : 15; }
    bt[it] = p.rel_bias[bucket * 8 + h] * 1.4426950408889634f; }
}
constexpr int SCH = 32;
constexpr int SC_AM = 0, SC_B = 8192, SC_W = 16384, SC_KD = 24576, SC_R = 32768, SC_V = 40960, SC_Y = 45056, SC_BUF = 49152;
static_assert(2 * SC_BUF <= LDS_BYTES, "scan LDS");
__device__ __forceinline__ void scan_phase(const Params& p, int i, unsigned char* lds) {
  const int tid = tidx(), wid = tid >> 6, lane = tid & 63;
  const bf16_t* rB = (const bf16_t*)(p.ws + O_RA); const bf16_t* kB = (const bf16_t*)(p.ws + O_RB); const bf16_t* vB = (const bf16_t*)(p.ws + O_RC);
  const bf16_t* eB = (const bf16_t*)(p.ws + O_RD); const bf16_t* aB = (const bf16_t*)(p.ws + O_RX);
  const float* kkw = p.k_k + (size_t)i * DM; const float* kaw = p.k_a + (size_t)i * DM;
  for (int wk = blockIdx.x; wk < 256; wk += gridDim.x) {
    for (int q = 0; q < 2; ++q) {
      int s0, len, head, dir, rowbase; const bool qm = (q == 0);
      if (qm) { const int u = wk >> 2; rowbase = (wk & 3) * 16; dir = u & 1; head = u >> 1; s0 = 8192; len = 16384; }
      else { const int u = wk >> 1; rowbase = (wk & 1) * 32; dir = u & 1; head = (u >> 1) & 31; s0 = (u >> 6) * 4096; len = 4096; }
      bf16_t* yB = (bf16_t*)(p.ws + (dir ? O_RF : O_RH));
      const int nch = len / SCH;
      const int rp = lane >> 4, kq = lane & 15;
      float S0[4] = {0.f, 0.f, 0.f, 0.f}, S1[4] = {0.f, 0.f, 0.f, 0.f};
      const int pw = wid - 4, st = lane >> 3, l8 = lane & 7, c8 = l8 * 8;
      f32x4 kkc[2], kac[2], w0c[2], a0c[2];
      if (wid >= 4) {
#pragma unroll
        for (int e = 0; e < 2; ++e) { const int cc = head * 64 + c8 + e * 4;
          kkc[e] = *(const f32x4*)(kkw + cc); kac[e] = *(const f32x4*)(kaw + cc);
          w0c[e] = *(const f32x4*)(p.w0 + (size_t)(i * 2 + dir) * DM + cc); a0c[e] = *(const f32x4*)(p.a0 + (size_t)(i * 2 + dir) * DM + cc); }
      }
      auto fill = [&](int c, int b) {
        unsigned char* B = lds + b * SC_BUF;
        const int sl = pw * 8 + st; const int s = c * SCH + sl; const int t = dir ? len - 1 - s : s; const size_t tok = (size_t)(s0 + t);
        const bf16x8 kv = *(const bf16x8*)(kB + tok * DM + head * 64 + c8), rv = *(const bf16x8*)(rB + tok * DM + head * 64 + c8);
        const bf16x8 ev = *(const bf16x8*)(eB + tok * 4096 + dir * 2048 + head * 64 + c8), av = *(const bf16x8*)(aB + tok * 4096 + dir * 2048 + head * 64 + c8);
        uint2 vv = make_uint2(0u, 0u); if (!qm || l8 < 4) vv = *(const uint2*)(vB + tok * DM + head * 64 + rowbase + l8 * 4);
        float kf[8], kk[8]; float ss = 0.f;
#pragma unroll
        for (int e = 0; e < 8; ++e) { kf[e] = bf2f((bf16_t)kv[e]); kk[e] = kf[e] * kkc[e >> 2][e & 3]; ss += kk[e] * kk[e]; }
        ss += __shfl_xor(ss, 1); ss += __shfl_xor(ss, 2); ss += __shfl_xor(ss, 4);
        const float inv = rsqrtf(ss + 1e-12f);
        f32x4 oam[2], ob[2], ow[2], okd[2], orr[2];
#pragma unroll
        for (int e = 0; e < 8; ++e) { const int q4 = e >> 2, j = e & 3;
          const float af = pg8::fsig(a0c[q4][j] + bf2f((bf16_t)av[e])); const float ef = 0.6065306597f * pg8::fsig(w0c[q4][j] + bf2f((bf16_t)ev[e]));
          const float kn = kk[e] * inv;
          oam[q4][j] = -kn; ob[q4][j] = kn * af; ow[q4][j] = __expf(-ef); okd[q4][j] = kf[e] * (1.f + (af - 1.f) * kac[q4][j]); orr[q4][j] = bf2f((bf16_t)rv[e]); }
        const int o4 = sl * 16 + l8 * 2;
#pragma unroll
        for (int e = 0; e < 2; ++e) { ((f32x4*)(B + SC_AM))[o4 + e] = oam[e]; ((f32x4*)(B + SC_B))[o4 + e] = ob[e]; ((f32x4*)(B + SC_W))[o4 + e] = ow[e];
          ((f32x4*)(B + SC_KD))[o4 + e] = okd[e]; ((f32x4*)(B + SC_R))[o4 + e] = orr[e]; }
        f32x4 vf; vf[0] = __uint_as_float(vv.x << 16); vf[1] = __uint_as_float(vv.x & 0xffff0000u); vf[2] = __uint_as_float(vv.y << 16); vf[3] = __uint_as_float(vv.y & 0xffff0000u);
        ((f32x4*)(B + SC_V))[sl * 8 + l8] = vf;
      };
      auto flush = [&](int c, int b) {
        const unsigned char* B = lds + b * SC_BUF;
        const int sl = pw * 8 + st; const int s = c * SCH + sl; const int t = dir ? len - 1 - s : s;
        const f32x4 y = ((const f32x4*)(B + SC_Y))[sl * 8 + l8];
        uint2 w; w.x = pg8::cvt_pk_bf16(y[0], y[1]); w.y = pg8::cvt_pk_bf16(y[2], y[3]);
        if (!qm || l8 < 4) *(uint2*)(yB + (size_t)(s0 + t) * DM + head * 64 + rowbase + l8 * 4) = w;
      };
      if (wid >= 4) fill(0, 0);
      __syncthreads();
      for (int c = 0; c < nch; ++c) {
        if (wid < 4) {
          const unsigned char* B = lds + (c & 1) * SC_BUF;
          const f32x4* pAM = (const f32x4*)(B + SC_AM) + kq; const f32x4* pB = (const f32x4*)(B + SC_B) + kq; const f32x4* pW = (const f32x4*)(B + SC_W) + kq;
          const f32x4* pKD = (const f32x4*)(B + SC_KD) + kq; const f32x4* pR = (const f32x4*)(B + SC_R) + kq;
          const float2* pV = (const float2*)(B + SC_V) + wid * 4 + rp; float2* pY = (float2*)(B + SC_Y) + wid * 4 + rp;
          if (!qm) {
          f32x4 am = pAM[0], bb = pB[0], ww = pW[0], kd = pKD[0], rr = pR[0]; float2 vv = pV[0]; float yq0 = 0.f, yq1 = 0.f, yk0 = 0.f, yk1 = 0.f;
#pragma unroll 4
          for (int s = 0; s < SCH; ++s) {
            const int sn = (s + 1 < SCH ? s + 1 : s) * 16;
            const f32x4 am_n = pAM[sn], bb_n = pB[sn], ww_n = pW[sn], kd_n = pKD[sn], rr_n = pR[sn]; const float2 vv_n = pV[sn];
            float sa0 = (S0[0] * am[0] + S0[1] * am[1]) + (S0[2] * am[2] + S0[3] * am[3]);
            float sa1 = (S1[0] * am[0] + S1[1] * am[1]) + (S1[2] * am[2] + S1[3] * am[3]);
            float u0[4], u1[4];
#pragma unroll
            for (int j = 0; j < 4; ++j) { u0[j] = fmaf(S0[j], ww[j], vv.x * kd[j]); u1[j] = fmaf(S1[j], ww[j], vv.y * kd[j]); }
            sa0 += dpp_f<0x128>(sa0); sa1 += dpp_f<0x128>(sa1); yq0 += dpp_f<0x128>(yq0); yq1 += dpp_f<0x128>(yq1);
            sa0 += dpp_f<0x124>(sa0); sa1 += dpp_f<0x124>(sa1); yq0 += dpp_f<0x124>(yq0); yq1 += dpp_f<0x124>(yq1);
            sa0 += dpp_f<0x122>(sa0); sa1 += dpp_f<0x122>(sa1); yq0 += dpp_f<0x122>(yq0); yq1 += dpp_f<0x122>(yq1);
            sa0 += dpp_f<0x121>(sa0); sa1 += dpp_f<0x121>(sa1); yq0 += dpp_f<0x121>(yq0); yq1 += dpp_f<0x121>(yq1);
            { const bool me = kq == ((s - 1) & 15); yk0 = me ? yq0 : yk0; yk1 = me ? yq1 : yk1; }
            if (s == 16) pY[kq * 16] = make_float2(yk0, yk1);
#pragma unroll
            for (int j = 0; j < 4; ++j) { S0[j] = fmaf(sa0, bb[j], u0[j]); S1[j] = fmaf(sa1, bb[j], u1[j]); }
            yq0 = (S0[0] * rr[0] + S0[1] * rr[1]) + (S0[2] * rr[2] + S0[3] * rr[3]);
            yq1 = (S1[0] * rr[0] + S1[1] * rr[1]) + (S1[2] * rr[2] + S1[3] * rr[3]);
            am = am_n; bb = bb_n; ww = ww_n; kd = kd_n; rr = rr_n; vv = vv_n;
          }
          yq0 = row16_sum(yq0); yq1 = row16_sum(yq1);
          if (kq == 15) { yk0 = yq0; yk1 = yq1; }
          pY[(16 + kq) * 16] = make_float2(yk0, yk1);
          } else {
          const float* pV1 = (const float*)(B + SC_V) + wid * 4 + rp; float* pY1 = (float*)(B + SC_Y) + wid * 4 + rp;
          f32x4 am = pAM[0], bb = pB[0], ww = pW[0], kd = pKD[0], rr = pR[0]; float vv = pV1[0]; float yq = 0.f, yk = 0.f;
#pragma unroll 4
          for (int s = 0; s < SCH; ++s) {
            const int sn = (s + 1 < SCH ? s + 1 : s);
            const f32x4 am_n = pAM[sn * 16], bb_n = pB[sn * 16], ww_n = pW[sn * 16], kd_n = pKD[sn * 16], rr_n = pR[sn * 16]; const float vv_n = pV1[sn * 32];
            float sa0 = (S0[0] * am[0] + S0[1] * am[1]) + (S0[2] * am[2] + S0[3] * am[3]);
            float u0[4];
#pragma unroll
            for (int j = 0; j < 4; ++j) u0[j] = fmaf(S0[j], ww[j], vv * kd[j]);
            sa0 += dpp_f<0x128>(sa0); yq += dpp_f<0x128>(yq);
            sa0 += dpp_f<0x124>(sa0); yq += dpp_f<0x124>(yq);
            sa0 += dpp_f<0x122>(sa0); yq += dpp_f<0x122>(yq);
            sa0 += dpp_f<0x121>(sa0); yq += dpp_f<0x121>(yq);
            yk = (kq == ((s - 1) & 15)) ? yq : yk;
            if (s == 16) pY1[kq * 32] = yk;
#pragma unroll
            for (int j = 0; j < 4; ++j) S0[j] = fmaf(sa0, bb[j], u0[j]);
            yq = (S0[0] * rr[0] + S0[1] * rr[1]) + (S0[2] * rr[2] + S0[3] * rr[3]);
            am = am_n; bb = bb_n; ww = ww_n; kd = kd_n; rr = rr_n; vv = vv_n;
          }
          yq = row16_sum(yq);
          if (kq == 15) yk = yq;
          pY1[(16 + kq) * 32] = yk;
          }
        } else {
          if (c + 1 < nch) fill(c + 1, (c + 1) & 1);
          if (c >= 1) flush(c - 1, (c - 1) & 1);
        }
        __syncthreads();
      }
      if (wid >= 4) flush(nch - 1, (nch - 1) & 1);
      __syncthreads();
    }
  }
}

__device__ __forceinline__ void dilated_phase(const Params& p, char* lds) {
  const bf16_t* qb = (const bf16_t*)(p.ws + O_RD); const bf16_t* kb = qb + (size_t)T * 1024; const bf16_t* vb = kb + (size_t)T * 1024;
  bf16_t* Op = (bf16_t*)(p.ws + O_RX); float* lse = (float*)(p.ws + S_LSE); const float* bt = (const float*)(p.ws + S_BIAS);
  for (int it = blockIdx.x; it < 3 * 8 * 96; it += gridDim.x) {
    const int pat = it / 768, rem = it - pat * 768, h = rem / 96, blk = rem - h * 96;
    const int dil = pat == 0 ? 1 : (pat == 1 ? 4 : 16);
    int s0, len, b = blk;
    if (b < 16) { s0 = 0; len = 4096; } else if (b < 32) { s0 = 4096; len = 4096; b -= 16; } else { s0 = 8192; len = 16384; b -= 32; }
    const int L = len / dil, nbl = L / 256; const int res = b / nbl, j0 = (b - res * nbl) * 256;
    const size_t tok0 = (size_t)(s0 + res);
    at::Args A;
    A.Q = qb + (tok0 + (size_t)j0 * dil) * 1024 + h * 128;
    A.K = kb + tok0 * 1024 + h * 128; A.Kr = nullptr;
    A.V = vb + tok0 * 1024 + h * 128;
    A.O = Op + ((size_t)pat * T + tok0 + (size_t)j0 * dil) * 1024 + h * 128;
    A.lse = lse + ((size_t)pat * T + tok0 + (size_t)j0 * dil) * 8 + h; A.ldlse = (long)dil * 8;
    A.nt = 6; A.kb0 = j0 - 64; A.L = L; A.biasG = bt + (pat * 8 + h) * 129;
    A.C = 0.08838834764831845f * 1.4426950408889634f; A.thr = 11.5f;
    if (pat == 0) at::attn_body<8, true, 1024, 1024, 1024>(A, lds);
    else if (pat == 1) at::attn_body<8, true, 4096, 4096, 4096>(A, lds);
    else at::attn_body<8, true, 16384, 16384, 16384>(A, lds);
  }
}
__device__ __forceinline__ void mla_phase(const Params& p, char* lds) {
  const bf16_t* Qp = (const bf16_t*)(p.ws + O_RB); const bf16_t* kv = (const bf16_t*)(p.ws + O_RH); const bf16_t* kr = (const bf16_t*)(p.ws + O_RA) + (size_t)T * 1024;
  bf16_t* cat = (bf16_t*)(p.ws + O_RF);
  for (int it = blockIdx.x; it < 512 + 256; it += gridDim.x) {
    int s0, len, h, qb_;
    { const int rnd = it >> 8, v = it & 255, slot = v >> 3; h = v & 7;
      if (rnd < 2) { s0 = 8192; len = 16384; qb_ = rnd * 32 + slot; }
      else { s0 = (slot >> 4) * 4096; len = 4096; qb_ = slot & 15; } }
    at::Args A;
    A.Q = Qp + (size_t)(s0 + qb_ * 256) * 1536 + h * 192;
    A.K = kv + (size_t)s0 * 2048 + h * 256; A.Kr = kr + (size_t)s0 * 64;
    A.V = A.K + 128;
    A.O = cat + (size_t)(s0 + qb_ * 256) * 2048 + h * 128;
    A.lse = nullptr; A.ldlse = 0; A.nt = len / 64; A.kb0 = 0; A.L = len; A.biasG = nullptr;
    A.C = 0.07216878364870322f * 1.4426950408889634f; A.thr = 8.f / 0.07216878364870322f;
    at::attn_body<12, false, 1536, 2048, 2048>(A, lds);
  }
}

template <class Epi>
__device__ __forceinline__ void gemm_simple(unsigned char* lds, const pg8::Gemm g, const pg8::StaticOrder& S, const Epi& E) {
  using namespace pg8;
  const int tid = tidx(), wid = tid >> 6, lane = tid & 63, wr = wid >> 2, wc = wid & 3, fr = lane & 15, fq = lane >> 4;
  const int K = g.K, nt = K / BK;
  unsigned offA[2], offB[2];
#pragma unroll
  for (int i = 0; i < 2; ++i) { int R, C; stage_rc(tid * 16 + i * 8192, R, C); const int Rb = Epi::PERM ? ((R & ~31) + perm32(R & 31)) : R;
    offA[i] = (unsigned)(R * K + C); offB[i] = (unsigned)(Rb * K + C); }
  const int aoff = lds_byte(wr * 64 + fr, fq * 8), boff = lds_byte(wc * 32 + fr, fq * 8);
  unsigned char* myst = lds + tid * 16;
  Unit u;
  for (int ui = 0; S.next(ui, u); ++ui) {
    f32x4 acc[2][2][4][2];
#pragma unroll
    for (int a = 0; a < 2; ++a)
#pragma unroll
      for (int b = 0; b < 2; ++b)
#pragma unroll
        for (int m = 0; m < 4; ++m)
#pragma unroll
          for (int n = 0; n < 2; ++n) acc[a][b][m][n] = (f32x4){0.f, 0.f, 0.f, 0.f};
    const bf16_t* Ab = g.A + (size_t)u.pm * 256 * K; const bf16_t* Bb = g.Bt + (size_t)u.pn * 256 * K;
    const size_t hK = (size_t)128 * K;
    bf16x8 sg[2][2];
#define GLOADX(P, off, kt) do { _Pragma("unroll") for (int h = 0; h < 2; ++h) _Pragma("unroll") for (int i = 0; i < 2; ++i) \
      sg[h][i] = *(const bf16x8*)((P) + h * hK + (off)[i] + (size_t)(kt) * BK); } while (0)
#define SWRITEX(base, b) do { _Pragma("unroll") for (int h = 0; h < 2; ++h) _Pragma("unroll") for (int i = 0; i < 2; ++i) \
      *(bf16x8*)(myst + ((base) + (b) * 2 + h) * HTB + i * 8192) = sg[h][i]; } while (0)
    GLOADX(Ab, offA, 0); SWRITEX(0, 0); GLOADX(Bb, offB, 0); SWRITEX(4, 0); __syncthreads();
    for (int kt = 0; kt < nt; ++kt) {
      const int b = kt & 1; const bool more = kt + 1 < nt;
#pragma unroll
      for (int k = 0; k < 2; ++k) {
        if (more) { if (k == 0) GLOADX(Ab, offA, kt + 1); else GLOADX(Bb, offB, kt + 1); }
        __builtin_amdgcn_sched_barrier(0);
        bf16x8 B0[2], B1[2];
#pragma unroll
        for (int n = 0; n < 2; ++n) { B0[n] = *(const bf16x8*)(lds + (4 + b * 2 + 0) * HTB + boff + n * 2048 + k * 1024); B1[n] = *(const bf16x8*)(lds + (4 + b * 2 + 1) * HTB + boff + n * 2048 + k * 1024); }
#pragma unroll
        for (int ai = 0; ai < 2; ++ai) {
#pragma unroll
          for (int m = 0; m < 4; ++m) {
            const bf16x8 At = *(const bf16x8*)(lds + (b * 2 + ai) * HTB + aoff + m * 2048 + k * 1024);
#pragma unroll
            for (int n = 0; n < 2; ++n) {
              acc[ai][0][m][n] = __builtin_amdgcn_mfma_f32_16x16x32_bf16(B0[n], At, acc[ai][0][m][n], 0, 0, 0);
              acc[ai][1][m][n] = __builtin_amdgcn_mfma_f32_16x16x32_bf16(B1[n], At, acc[ai][1][m][n], 0, 0, 0); }
          }
          __builtin_amdgcn_sched_barrier(0);
        }
        if (more) { if (k == 0) SWRITEX(0, b ^ 1); else SWRITEX(4, b ^ 1); }
      }
      __syncthreads();
    }
#undef GLOADX
#undef SWRITEX
    E(acc, u, wr, wc, fr, fq);
  }
}
template <class Epi> __device__ __forceinline__ void run_gemm(unsigned char* lds, const bf16_t* A, const bf16_t* Bt, int N, int K, const Epi& E) {
  pg8::Gemm g{A, Bt, T, N, K}; pg8::StaticOrder S;
  S.init(T, N, (int)gridDim.x, (int)blockIdx.x);
  pg8::gemm_phase<Epi, pg8::StaticOrder, false>((PG8_LAS unsigned char*)lds, g, S, E, nullptr);
  __syncthreads();
}
template <class Epi> __device__ __forceinline__ void run_gemm_small(unsigned char* lds, const bf16_t* A, const bf16_t* Bt, int N, int K, const Epi& E) {
  pg8::Gemm g{A, Bt, T, N, K}; pg8::StaticOrder S;
  S.init(T, N, (int)gridDim.x, (int)blockIdx.x);
  gemm_simple<Epi>(lds, g, S, E);
  __syncthreads();
}

__device__ __forceinline__ Params ldp() { auto k = __builtin_amdgcn_kernarg_segment_ptr(); asm volatile("" : "+s"(k)); Params q; __builtin_memcpy(&q, k, sizeof(Params)); return q; }
__device__ __forceinline__ void gbar(unsigned* ctr, unsigned target) {
  __syncthreads();
  if (threadIdx.x == 0) {
    __threadfence();
    __hip_atomic_fetch_add(ctr, 1u, __ATOMIC_RELAXED, __HIP_MEMORY_SCOPE_AGENT);
    while (__hip_atomic_load(ctr, __ATOMIC_RELAXED, __HIP_MEMORY_SCOPE_AGENT) < target) __builtin_amdgcn_s_sleep(2);
    __threadfence();
  }
  __syncthreads();
}
#define PHASE(...) do { if (ph >= pk.ph_lo && ph < pk.ph_hi) { const Params p = ldp(); unsigned char* ws = p.ws; WSPTRS; __VA_ARGS__; } ++ph; \
    if (ph > pk.ph_lo && ph < pk.ph_hi) { gbar((unsigned*)(pk.ws + WS_END), (unsigned)ph * gridDim.x); } } while (0)
#define WSPTRS bf16_t* WM = (bf16_t*)(ws + O_WM); bf16_t* WF = (bf16_t*)(ws + O_RF); \
  float* rinv = (float*)(ws + S_RINV); float* rinvq = (float*)(ws + S_RINVQ); float* rinvkv = (float*)(ws + S_RINVKV); \
  const float* cs = (const float*)(ws + S_COS); const float* sn = (const float*)(ws + S_SIN); \
  bf16_t* mix = (bf16_t*)(ws + O_RA); bf16_t* xb = (bf16_t*)(ws + O_RC); bf16_t* act = (bf16_t*)(ws + O_RD); \
  const int i = layer >> 1; const float* ng = p.norm_g + (size_t)layer * 4 * DM; const float* mu = p.mu + (size_t)i * 6 * DM; \
  bf16_t* cq = (bf16_t*)(ws + O_RA); bf16_t* ckv = cq + (size_t)T * 512; bf16_t* kr = cq + (size_t)T * 1024; \
  bf16_t* qb = (bf16_t*)(ws + O_RD); bf16_t* kb = qb + (size_t)T * 1024; bf16_t* vb = kb + (size_t)T * 1024; \
  bf16_t* Qp = (bf16_t*)(ws + O_RB); bf16_t* kv = (bf16_t*)(ws + O_RH); bf16_t* cat = (bf16_t*)(ws + O_RF); \
  bf16_t* m0 = (bf16_t*)(ws + O_RD); bf16_t* m1 = (bf16_t*)(ws + O_RE); bf16_t* m2 = (bf16_t*)(ws + O_RX); \
  bf16_t* rB = (bf16_t*)(ws + O_RA); bf16_t* kB = (bf16_t*)(ws + O_RB); bf16_t* vB = (bf16_t*)(ws + O_RC); \
  bf16_t* gl = (bf16_t*)(ws + S_GL); bf16_t* wl = (bf16_t*)(ws + S_WL); bf16_t* al = (bf16_t*)(ws + S_AL); \
  bf16_t* eB = (bf16_t*)(ws + O_RD); bf16_t* aB = (bf16_t*)(ws + O_RX); bf16_t* gB = (bf16_t*)(ws + O_RD); bf16_t* yg = (bf16_t*)(ws + O_RH); \
  (void)WM; (void)WF; (void)rinv; (void)rinvq; (void)rinvkv; (void)cs; (void)sn; (void)mix; (void)xb; (void)act; (void)i; (void)ng; (void)mu; (void)cq; (void)ckv; (void)kr; (void)qb; (void)kb; (void)vb; \
  (void)Qp; (void)kv; (void)cat; (void)m0; (void)m1; (void)m2; (void)rB; (void)kB; (void)vB; (void)gl; (void)wl; (void)al; (void)eB; (void)aB; (void)gB; (void)yg
template <int layer> __device__ __forceinline__ void layer_fn(const Params& pk, unsigned char* lds, cg::grid_group& grid, int& ph) {
    if constexpr ((layer & 1) == 0) {
      PHASE(pg8::EpiIn E{cq, ckv, qb, kb, vb, kr, rinv, cs, sn}; run_gemm(lds, xb, WM + WA_IN, 4352, 2048, E));
      PHASE(rownorm_phase(p); dilated_phase(p, (char*)lds));
      PHASE(pg8::EpiUQ E1{Qp, rinvq, cs, sn}; run_gemm(lds, cq, WM + WA_UQ, 1536, 512, E1);
            pg8::EpiB<0> E2{kv, 2048, nullptr, rinvkv}; run_gemm(lds, ckv, WM + WA_UKV, 2048, 512, E2));
      PHASE(mla_phase(p, (char*)lds); combine_phase(p));
      PHASE(pg8::EpiB<0> E{mix, 2048, nullptr, nullptr}; run_gemm(lds, cat, WM + WA_OUT, 2048, 2048, E));
    } else {
      PHASE(mix_phase(p, ng, mu, 1, 4, 5));
      PHASE(pg8::EpiLora E{wl, al, gl}; pg8::Gemm g3{m0, WM + WR_W1, 3 * T, 768, 2048}; pg8::LoraOrder S3{(int)blockIdx.x};
            pg8::gemm_phase<pg8::EpiLora, pg8::LoraOrder, false>((PG8_LAS unsigned char*)lds, g3, S3, E, nullptr); __syncthreads());
      PHASE(mix_phase(p, ng, mu, 0, 2, 3));
      PHASE(pg8::EpiB<0> E1{rB, 2048, nullptr, nullptr}; run_gemm(lds, m0, WM + WR_R, 2048, 2048, E1);
            pg8::EpiB<0> E2{kB, 2048, nullptr, nullptr}; run_gemm(lds, m1, WM + WR_K, 2048, 2048, E2);
            pg8::EpiB<0> E3{vB, 2048, nullptr, nullptr}; run_gemm(lds, m2, WM + WR_V, 2048, 2048, E3));
      PHASE(pg8::EpiB<0> E1{eB, 4096, nullptr, nullptr}; run_gemm(lds, wl, WM + WR_W2, 4096, 256, E1);
            pg8::EpiB<0> E2{aB, 4096, nullptr, nullptr}; run_gemm(lds, al, WM + WR_A2, 4096, 256, E2));
      PHASE(scan_phase(p, i, lds));
      PHASE(pg8::EpiB<0> E{gB, 2048, nullptr, nullptr}; run_gemm(lds, gl, WM + WR_G2, 2048, 256, E));
      PHASE(postscan_phase(p, i));
      PHASE(pg8::EpiB<0> E{mix, 2048, nullptr, nullptr}; run_gemm(lds, yg, WM + WR_O, 2048, 2048, E));
    }
    PHASE(resid_phase(p, mix, ng + DM); convert_ffn_weights(p, layer, (float*)lds));
    PHASE(pg8::EpiSwi E{act, rinv}; run_gemm(lds, xb, WF + WF_GU, 11264, 2048, E));
    PHASE(pg8::EpiB<0> E{mix, 2048, nullptr, nullptr}; run_gemm(lds, act, WF + WF_DN, 2048, 5632, E));
    PHASE(resid_phase(p, mix, ng + 3 * DM); if (layer < 3) convert_mixer_weights(p, layer + 1, (float*)lds));
  }
__global__ void __launch_bounds__(512, 2) mega(Params pk) {
  constexpr int layer = 0;
  extern __shared__ __attribute__((aligned(16))) unsigned char lds[];
  cg::grid_group grid = cg::this_grid();
  int ph = 0;
  grid.sync();
  PHASE(resid_phase(p, nullptr, nullptr); tables_phase(p); convert_mixer_weights(p, 0, (float*)lds));
  layer_fn<0>(pk, lds, grid, ph); layer_fn<1>(pk, lds, grid, ph); layer_fn<2>(pk, lds, grid, ph); layer_fn<3>(pk, lds, grid, ph);
}
#undef PHASE
#undef WSPTRS

extern "C" void kernel_launch(void* const* d_in, const int* in_sizes, int n_in, void* d_out, int out_size, void* d_ws, size_t ws_size, hipStream_t stream) {
  static int grid_blocks = 0;
  if (!grid_blocks) {
    int dev = 0, cus = 0, per_cu = 0;
    (void)hipGetDevice(&dev);
    (void)hipDeviceGetAttribute(&cus, hipDeviceAttributeMultiprocessorCount, dev);
    (void)hipFuncSetAttribute((const void*)mega, hipFuncAttributeMaxDynamicSharedMemorySize, LDS_BYTES);
    (void)hipOccupancyMaxActiveBlocksPerMultiprocessor(&per_cu, mega, 512, LDS_BYTES);
    if (per_cu < 1) { fprintf(stderr, "occupancy query returned %d\n", per_cu); per_cu = 1; }
    grid_blocks = cus;
  }
  if (n_in != 31 || ws_size < WS_END + 256) { fprintf(stderr, "kernel_launch: unexpected n_in %d / ws_size %zu\n", n_in, ws_size); return; }
  Params p{};
  const float** f = (const float**)&p;
  for (int k = 0; k < 31; ++k) f[k] = (const float*)d_in[k];
  p.out = (float*)d_out; p.ws = (unsigned char*)d_ws; p.ph_lo = 0; p.ph_hi = 1000;
#ifdef MULTI_LAUNCH
  for (int ph = 0; ph < NPH_RUN; ++ph) { p.ph_lo = ph; p.ph_hi = ph + 1; hipLaunchKernelGGL(mega, dim3(grid_blocks), dim3(512), LDS_BYTES, stream, p); }
#else
  (void)hipMemsetAsync((unsigned char*)d_ws + WS_END, 0, 256, stream);
  void* args[] = {&p};
  hipError_t e = hipLaunchCooperativeKernel((void*)mega, dim3(grid_blocks), dim3(512), args, LDS_BYTES, stream);
  if (e != hipSuccess) fprintf(stderr, "cooperative launch failed: %s (grid %d)\n", hipGetErrorString(e), grid_blocks);
#endif
}
```

```cpp
#include <hip/hip_runtime.h>
#include <hip/hip_cooperative_groups.h>
#include <cstdio>
#include <cstdint>
namespace cg = cooperative_groups;
__device__ __forceinline__ int tidx() { int t = threadIdx.x; asm volatile("" : "+v"(t)); return t; }
namespace pg8 {
#define PG8_LAS __attribute__((address_space(3)))
typedef unsigned short bf16_t;
typedef short bf16x8 __attribute__((ext_vector_type(8)));
typedef float f32x4 __attribute__((ext_vector_type(4)));
typedef unsigned u32x4 __attribute__((ext_vector_type(4)));
constexpr int BM = 256, BK = 64, HALF = 128, HTB = HALF * BK * 2  , STAGE_BYTES = 8 * HTB, NXCD = 8, WGM = 8;

__host__ __device__ __forceinline__ int lds_byte(int r, int c) { const int st = (r >> 4) * 2 + (c >> 5), rr = r & 15, cc = c & 31, ob = rr * 64 + cc * 2; return st * 1024 + (ob ^ (((ob >> 9) & 1) << 5)); }
__host__ __device__ __forceinline__ void stage_rc(int b, int& R, int& C) { const int st = b / 1024, sb = b % 1024, swz = sb ^ (((sb >> 9) & 1) << 5); R = (st >> 1) * 16 + swz / 64; C = (st & 1) * 32 + (swz % 64) / 2; }
__host__ __device__ __forceinline__ int perm32(int rho) { const int n = rho >> 4, i = rho & 15; return 8 * (i >> 2) + 4 * n + (i & 3); }

struct Unit { int pm, pn; };
struct Gemm { const bf16_t* A; const bf16_t* Bt; int M, N, K; };

struct StaticOrder {
    int nM, nN, nwg, G, c;
    __host__ __device__ void init(int M, int N, int G_, int c_) { nM = M / BM; nN = N / BM; nwg = nM * nN; G = G_; c = c_; }
    __host__ __device__ bool next(int i, Unit& u) const {
        const long L = (long)i * G + c; if (L >= nwg) return false;
        int wgid = (int)L; { const int q = nwg / NXCD, r = nwg % NXCD, xcd = wgid % NXCD, off = wgid / NXCD; wgid = (xcd < r ? xcd * (q + 1) : r * (q + 1) + (xcd - r) * q) + off; }
        const int nig = WGM * nN, gid = wgid / nig, fm = gid * WGM, gsz = (nM - fm) < WGM ? (nM - fm) : WGM;
        u.pm = fm + ((wgid % nig) % gsz); u.pn = (wgid % nig) / gsz; return true;
    }
    __device__ __forceinline__ void a_ready(const Unit&) const {}
    __device__ __forceinline__ void done(const Unit&) const {}
};
__device__ __forceinline__ unsigned cvt_pk_bf16(float lo, float hi) { unsigned r; asm volatile("v_cvt_pk_bf16_f32 %0, %1, %2" : "=v"(r) : "v"(lo), "v"(hi)); return r; }
typedef float f32x2 __attribute__((ext_vector_type(2)));
template <class Epi, class Sched, bool STAMP = false>
__device__ __forceinline__ void gemm_phase(PG8_LAS unsigned char* lds, const Gemm g, const Sched& S, const Epi& E, unsigned long long* stamps) {
    const int tid = tidx(), wid = __builtin_amdgcn_readfirstlane(tid >> 6), lane = tid & 63, wr = wid >> 2, wc = wid & 3, fr = lane & 15, fq = lane >> 4;
    const int K = g.K, nt = K / BK;
    int ts_lo = 0, ts_hi = 0, nts = 0; const unsigned long long rt_entry = STAMP ? (unsigned long long)wall_clock64() : 0ull;
#define PG8_STAMP() do { if (STAMP && wid == 0 && nts < 64) { const unsigned long long _c = (unsigned long long)clock64(); \
        ts_lo = (lane == nts) ? (int)(unsigned)_c : ts_lo; ts_hi = (lane == nts) ? (int)(unsigned)(_c >> 32) : ts_hi; ++nts; } } while (0)
    PG8_STAMP();
    unsigned voffA[2], voffB[2];
#pragma unroll
    for (int i = 0; i < 2; ++i) { int R, C; stage_rc(tid * 16 + i * 8192, R, C); const int Rb = Epi::PERM ? ((R & ~31) + perm32(R & 31)) : R;
        voffA[i] = (unsigned)(R * K + C) * 2u; voffB[i] = (unsigned)(Rb * K + C) * 2u; }
    const size_t kstep = (size_t)(BK * 2);
    const size_t hstep = (size_t)HALF * K * 2;
    const size_t tstep = 2 * hstep;
    const unsigned ldsw = (unsigned)wid * 1024u;
    const int aoff = lds_byte(wr * 64 + fr, fq * 8), boff = lds_byte(wc * 32 + fr, fq * 8);
#define PG8_SA(b, h) (((b) * 2 + (h)) * HTB)
#define PG8_SB(b, h) ((4 + (b) * 2 + (h)) * HTB)
#define PG8_STAGE(bufoff, gbase, voff) do { _Pragma("unroll") for (int _i = 0; _i < 2; ++_i) \
        __builtin_amdgcn_global_load_lds((const unsigned*)((const char*)(gbase) + (voff)[_i]), (PG8_LAS unsigned*)(lds + (bufoff) + ldsw + _i * 8192), 16, 0, 0); } while (0)
#define PG8_LDA(dst, b, h) do { _Pragma("unroll") for (int m = 0; m < 4; ++m) _Pragma("unroll") for (int k = 0; k < 2; ++k) dst[m][k] = *(const PG8_LAS bf16x8*)(lds + PG8_SA(b, h) + aoff + m * 2048 + k * 1024); } while (0)
#define PG8_LDB(dst, b, h) do { _Pragma("unroll") for (int n = 0; n < 2; ++n) _Pragma("unroll") for (int k = 0; k < 2; ++k) dst[n][k] = *(const PG8_LAS bf16x8*)(lds + PG8_SB(b, h) + boff + n * 2048 + k * 1024); } while (0)
#define PG8_MMA(ai, bj, At, Bt) do { __builtin_amdgcn_s_setprio(1); _Pragma("unroll") for (int m = 0; m < 4; ++m) _Pragma("unroll") for (int n = 0; n < 2; ++n) _Pragma("unroll") for (int k = 0; k < 2; ++k) \
        acc[ai][bj][m][n] = __builtin_amdgcn_mfma_f32_16x16x32_bf16(Bt[n][k], At[m][k], acc[ai][bj][m][n], 0, 0, 0); __builtin_amdgcn_s_setprio(0); } while (0)
#define PG8_WAIT_V(n) asm volatile("s_waitcnt vmcnt(" #n ")" ::: "memory")
#define PG8_WAIT_L(n) asm volatile("s_waitcnt lgkmcnt(" #n ")" ::: "memory")
#define PG8_BAR __builtin_amdgcn_s_barrier()
#define PG8_SCHED __builtin_amdgcn_sched_barrier(0)
    Unit cur, nxt; int ui = 0;
    if (!S.next(0, cur)) return;
    f32x4 acc[2][2][4][2];
#pragma unroll
    for (int a = 0; a < 2; ++a)
#pragma unroll
        for (int b = 0; b < 2; ++b)
#pragma unroll
            for (int m = 0; m < 4; ++m)
#pragma unroll
                for (int n = 0; n < 2; ++n) acc[a][b][m][n] = (f32x4){0.f, 0.f, 0.f, 0.f};
    bf16x8 At[4][2], B0[2][2], B1[2][2];
    const char* cA = (const char*)g.A + (size_t)cur.pm * tstep; const char* cB = (const char*)g.Bt + (size_t)cur.pn * tstep;
    S.a_ready(cur);
    PG8_STAGE(PG8_SB(0, 0), cB, voffB); PG8_STAGE(PG8_SA(0, 0), cA, voffA); PG8_STAGE(PG8_SB(0, 1), cB + hstep, voffB); PG8_STAGE(PG8_SA(0, 1), cA + hstep, voffA);
    if (wr == 1) PG8_BAR;
    PG8_WAIT_V(4); PG8_BAR;
    PG8_STAGE(PG8_SB(1, 0), cB + kstep, voffB); PG8_STAGE(PG8_SA(1, 0), cA + kstep, voffA); PG8_STAGE(PG8_SB(1, 1), cB + hstep + kstep, voffB);
    PG8_WAIT_V(6); PG8_BAR;
    PG8_STAMP();
    for (;;) {
        const bool has_next = S.next(ui + 1, nxt);
        const char* nA = has_next ? (const char*)g.A + (size_t)nxt.pm * tstep : cA; const char* nB = has_next ? (const char*)g.Bt + (size_t)nxt.pn * tstep : cB;
        for (int t = 0; t < nt; t += 2) {
            const bool last = (t == nt - 2);
            const char* a1 = cA + (size_t)(t + 1) * kstep;
            const char* a2 = last ? nA : cA + (size_t)(t + 2) * kstep; const char* b2 = last ? nB : cB + (size_t)(t + 2) * kstep;
            const char* a3 = a2 + kstep; const char* b3 = b2 + kstep;
            if (last && has_next) S.a_ready(nxt);
            PG8_LDB(B0, 0, 0); PG8_SCHED; PG8_LDA(At, 0, 0); PG8_STAGE(PG8_SA(1, 1), a1 + hstep, voffA);
            PG8_WAIT_L(8); PG8_BAR; PG8_WAIT_L(0); PG8_MMA(0, 0, At, B0); PG8_BAR; PG8_SCHED;
            PG8_LDB(B1, 0, 1); PG8_STAGE(PG8_SB(0, 0), b2, voffB);
            PG8_BAR; PG8_WAIT_L(0); PG8_MMA(0, 1, At, B1); PG8_BAR;
            PG8_LDA(At, 0, 1); PG8_STAGE(PG8_SA(0, 0), a2, voffA);
            PG8_BAR; PG8_WAIT_L(0); PG8_MMA(1, 0, At, B0); PG8_BAR; PG8_SCHED;
            PG8_STAGE(PG8_SB(0, 1), b2 + hstep, voffB);
            PG8_WAIT_V(6); PG8_BAR; PG8_MMA(1, 1, At, B1); PG8_BAR;
            PG8_LDB(B0, 1, 0); PG8_SCHED; PG8_LDA(At, 1, 0); PG8_STAGE(PG8_SA(0, 1), a2 + hstep, voffA);
            PG8_WAIT_L(8); PG8_BAR; PG8_WAIT_L(0); PG8_MMA(0, 0, At, B0); PG8_BAR; PG8_SCHED;
            PG8_LDB(B1, 1, 1); PG8_STAGE(PG8_SB(1, 0), b3, voffB);
            PG8_BAR; PG8_WAIT_L(0); PG8_MMA(0, 1, At, B1); PG8_BAR;
            PG8_LDA(At, 1, 1); PG8_STAGE(PG8_SA(1, 0), a3, voffA);
            PG8_BAR; PG8_WAIT_L(0); PG8_MMA(1, 0, At, B0); PG8_BAR; PG8_SCHED;
            PG8_STAGE(PG8_SB(1, 1), b3 + hstep, voffB);
            PG8_WAIT_V(6); PG8_BAR; PG8_MMA(1, 1, At, B1); PG8_BAR;
        }
        PG8_STAMP();
        if constexpr (!Epi::AFTER_DRAIN) { E(acc, cur, wr, wc, fr, fq); S.done(cur); }
        PG8_STAMP();
        if (!has_next) break;
#pragma unroll
        for (int a = 0; a < 2; ++a)
#pragma unroll
            for (int b = 0; b < 2; ++b)
#pragma unroll
                for (int m = 0; m < 4; ++m)
#pragma unroll
                    for (int n = 0; n < 2; ++n) acc[a][b][m][n] = (f32x4){0.f, 0.f, 0.f, 0.f};
        cur = nxt; cA = nA; cB = nB; ++ui;
    }
    PG8_WAIT_V(0);
    if (wr == 0) PG8_BAR;
    PG8_BAR;
    if constexpr (Epi::AFTER_DRAIN) { E.fused(acc, cur, wr, wc, fr, fq, lds, wid, lane); S.done(cur); }
    PG8_STAMP();
    if (STAMP && wid == 0) { stamps[lane] = lane < nts ? (((unsigned long long)(unsigned)ts_hi << 32) | (unsigned)ts_lo) : 0ull;
        if (lane == 62) stamps[62] = rt_entry; if (lane == 63) stamps[63] = (unsigned long long)wall_clock64(); }
#undef PG8_STAMP
#undef PG8_SA
#undef PG8_SB
#undef PG8_STAGE
#undef PG8_LDA
#undef PG8_LDB
#undef PG8_MMA
#undef PG8_WAIT_V
#undef PG8_WAIT_L
#undef PG8_BAR
#undef PG8_SCHED
}
}
namespace pg8 {
__device__ __forceinline__ float fsig(float x) { return __builtin_amdgcn_rcpf(1.f + __expf(-x)); }
__device__ __forceinline__ float ftanh(float x) { return 1.f - 2.f * __builtin_amdgcn_rcpf(1.f + __expf(2.f * x)); }
__device__ __forceinline__ int seq_start(int t) { return t < 4096 ? 0 : (t < 8192 ? 4096 : 8192); }

struct EpiF32 {
    static constexpr bool PERM = false, AFTER_DRAIN = false;
    float* C; int ldc;
    __device__ __forceinline__ void operator()(const f32x4 (&acc)[2][2][4][2], const Unit& u, int wr, int wc, int fr, int fq) const {
        const int row0 = u.pm * BM + wr * 64 + fr, col0 = u.pn * BM + wc * 32 + 4 * fq;
#pragma unroll
        for (int ai = 0; ai < 2; ++ai)
#pragma unroll
            for (int m = 0; m < 4; ++m) { float* rowp = C + (size_t)(row0 + ai * HALF + m * 16) * ldc + col0;
#pragma unroll
                for (int bj = 0; bj < 2; ++bj)
#pragma unroll
                    for (int n = 0; n < 2; ++n) *(f32x4*)(rowp + bj * HALF + n * 16) = acc[ai][bj][m][n]; }
    }
};
template <int ACT> struct EpiB {
    static constexpr bool PERM = true, AFTER_DRAIN = false;
    bf16_t* O; int ldc; const float* bias; const float* rs;
    __device__ __forceinline__ f32x4 actf(f32x4 v) const {
#pragma unroll
        for (int j = 0; j < 4; ++j) {
            if (ACT == 1) v[j] = 0.5f + 0.5f * ftanh(0.5f * v[j]);
            if (ACT == 2) v[j] = ftanh(v[j]);
            if (ACT == 3) v[j] = 0.6065306597f * fsig(v[j]); }
        return v; }
    __device__ __forceinline__ void operator()(const f32x4 (&acc)[2][2][4][2], const Unit& u, int wr, int wc, int fr, int fq) const {
        const int row0 = u.pm * BM + wr * 64 + fr; const int col0 = u.pn * BM + wc * 32 + 8 * fq;
#pragma unroll
        for (int bj = 0; bj < 2; ++bj) {
#pragma unroll
            for (int ai = 0; ai < 2; ++ai)
#pragma unroll
                for (int m = 0; m < 4; ++m) { const int row = row0 + ai * HALF + m * 16; const float s = rs ? rs[row] : 1.f;
                    f32x4 v0 = acc[ai][bj][m][0] * s; if (bias) v0 += *(const f32x4*)(bias + col0 + bj * HALF); v0 = actf(v0);
                    u32x4 w; w.x = cvt_pk_bf16(v0[0], v0[1]); w.y = cvt_pk_bf16(v0[2], v0[3]);
                    f32x4 v1 = acc[ai][bj][m][1] * s; if (bias) v1 += *(const f32x4*)(bias + col0 + bj * HALF + 4); v1 = actf(v1);
                    w.z = cvt_pk_bf16(v1[0], v1[1]); w.w = cvt_pk_bf16(v1[2], v1[3]);
                    *(u32x4*)(O + (size_t)row * ldc + col0 + bj * HALF) = w; __builtin_amdgcn_sched_barrier(0); } }
    }
};
struct EpiIn {
    static constexpr bool PERM = true, AFTER_DRAIN = false;
    bf16_t *cq, *ckv, *qb, *kb, *vb, *kr; const float* rs; const float* cs; const float* sn;
    __device__ __forceinline__ void operator()(const f32x4 (&acc)[2][2][4][2], const Unit& u, int wr, int wc, int fr, int fq) const {
        const int row0 = u.pm * BM + wr * 64 + fr; const int pn = u.pn;
        if (pn < 16) {
            bf16_t* base; int ldc, colt;
            if (pn < 2) { base = cq; ldc = 512; colt = pn * 256; } else if (pn < 4) { base = ckv; ldc = 512; colt = (pn - 2) * 256; }
            else if (pn < 8) { base = qb; ldc = 1024; colt = (pn - 4) * 256; } else if (pn < 12) { base = kb; ldc = 1024; colt = (pn - 8) * 256; }
            else { base = vb; ldc = 1024; colt = (pn - 12) * 256; }
            const int col0 = colt + wc * 32 + 8 * fq;
#pragma unroll
            for (int ai = 0; ai < 2; ++ai)
#pragma unroll
                for (int m = 0; m < 4; ++m) { const int row = row0 + ai * HALF + m * 16; const float s = rs[row];
                    bf16_t* rowp = base + (size_t)row * ldc + col0;
#pragma unroll
                    for (int bj = 0; bj < 2; ++bj) { const f32x4 v0 = acc[ai][bj][m][0] * s, v1 = acc[ai][bj][m][1] * s;
                        u32x4 w; w.x = cvt_pk_bf16(v0[0], v0[1]); w.y = cvt_pk_bf16(v0[2], v0[3]); w.z = cvt_pk_bf16(v1[0], v1[1]); w.w = cvt_pk_bf16(v1[2], v1[3]);
                        *(u32x4*)(rowp + bj * HALF) = w; } }
        } else if (wc < 2) {
            const int q = wc * 4 + fq;
#pragma unroll
            for (int ai = 0; ai < 2; ++ai)
#pragma unroll
                for (int m = 0; m < 4; ++m) { const int row = row0 + ai * HALF + m * 16; const float s = rs[row]; const int pos = row - seq_start(row);
                    const f32x4 c = *(const f32x4*)(cs + (size_t)pos * 32 + 4 * q), sv = *(const f32x4*)(sn + (size_t)pos * 32 + 4 * q);
                    const f32x4 x1 = acc[ai][0][m][0] * s, x2 = acc[ai][0][m][1] * s;
                    const f32x4 y1 = x1 * c - x2 * sv, y2 = x2 * c + x1 * sv;
                    u32x4 w; w.x = cvt_pk_bf16(y1[0], y1[1]); w.y = cvt_pk_bf16(y1[2], y1[3]); w.z = cvt_pk_bf16(y2[0], y2[1]); w.w = cvt_pk_bf16(y2[2], y2[3]);
                    *(u32x4*)(kr + (size_t)row * 64 + 8 * q) = w; }
        }
    }
};
struct EpiUQ {
    static constexpr bool PERM = true, AFTER_DRAIN = false;
    bf16_t* O; const float* rs; const float* cs; const float* sn;
    __device__ __forceinline__ void operator()(const f32x4 (&acc)[2][2][4][2], const Unit& u, int wr, int wc, int fr, int fq) const {
        const int row0 = u.pm * BM + wr * 64 + fr; const int col0 = u.pn * BM + wc * 32 + 8 * fq;
        const int q = (wc & 1) * 4 + fq;
#pragma unroll
        for (int ai = 0; ai < 2; ++ai)
#pragma unroll
            for (int m = 0; m < 4; ++m) { const int row = row0 + ai * HALF + m * 16; const float s = rs[row]; const int pos = row - seq_start(row);
                bf16_t* rowp = O + (size_t)row * 1536 + col0;
#pragma unroll
                for (int bj = 0; bj < 2; ++bj) { f32x4 v0 = acc[ai][bj][m][0] * s, v1 = acc[ai][bj][m][1] * s;
                    const int blk = u.pn * 4 + bj * 2 + (wc >> 1);
                    if (blk % 3 == 2) {
                        const f32x4 c = *(const f32x4*)(cs + (size_t)pos * 32 + 4 * q), sv = *(const f32x4*)(sn + (size_t)pos * 32 + 4 * q);
                        const f32x4 y1 = v0 * c - v1 * sv, y2 = v1 * c + v0 * sv; v0 = y1; v1 = y2; }
                    u32x4 w; w.x = cvt_pk_bf16(v0[0], v0[1]); w.y = cvt_pk_bf16(v0[2], v0[3]); w.z = cvt_pk_bf16(v1[0], v1[1]); w.w = cvt_pk_bf16(v1[2], v1[3]);
                    *(u32x4*)(rowp + bj * HALF) = w; } __builtin_amdgcn_sched_barrier(0); }
    }
};
struct EpiSwi {
    static constexpr bool PERM = true, AFTER_DRAIN = false;
    bf16_t* O; const float* rs;
    __device__ __forceinline__ void operator()(const f32x4 (&acc)[2][2][4][2], const Unit& u, int wr, int wc, int fr, int fq) const {
        const int row0 = u.pm * BM + wr * 64 + fr; const int col0 = u.pn * 128 + wc * 16 + 4 * fq;
#pragma unroll
        for (int ai = 0; ai < 2; ++ai)
#pragma unroll
            for (int m = 0; m < 4; ++m) { const int row = row0 + ai * HALF + m * 16; const float s = rs[row];
                bf16_t* rowp = O + (size_t)row * 5632 + col0;
#pragma unroll
                for (int bj = 0; bj < 2; ++bj) { const f32x4 g = acc[ai][bj][m][0] * s, up = acc[ai][bj][m][1] * s; f32x4 o;
#pragma unroll
                    for (int j = 0; j < 4; ++j) o[j] = g[j] * fsig(g[j]) * up[j];
                    uint2 w; w.x = cvt_pk_bf16(o[0], o[1]); w.y = cvt_pk_bf16(o[2], o[3]);
                    *(uint2*)(rowp + bj * 64) = w; } }
    }
};
}

namespace pg8 {
struct LoraOrder {
    int c;
    __device__ bool next(int i, Unit& u) const { if (c >= 144 || i >= 2) return false; const int id = c * 2 + i; u.pm = id; u.pn = id / 96; return true; }
    __device__ __forceinline__ void a_ready(const Unit&) const {}
    __device__ __forceinline__ void done(const Unit&) const {}
};
struct EpiLora {
    static constexpr bool PERM = true, AFTER_DRAIN = false;
    bf16_t *wl, *al, *gl;
    __device__ __forceinline__ void operator()(const f32x4 (&acc)[2][2][4][2], const Unit& u, int wr, int wc, int fr, int fq) const {
        const int pn = u.pn; bf16_t* base = pn == 0 ? wl : (pn == 1 ? al : gl);
        const int row0 = u.pm * BM - pn * 24576 + wr * 64 + fr; const int col0 = wc * 32 + 8 * fq;
        const float sc = pn == 2 ? 0.5f : 1.f, ka = pn == 2 ? 0.5f : 1.f, kb = pn == 2 ? 0.5f : 0.f;
#pragma unroll
        for (int bj = 0; bj < 2; ++bj)
#pragma unroll
            for (int ai = 0; ai < 2; ++ai)
#pragma unroll
                for (int m = 0; m < 4; ++m) { const int row = row0 + ai * HALF + m * 16;
                    f32x4 v0 = acc[ai][bj][m][0], v1 = acc[ai][bj][m][1];
#pragma unroll
                    for (int j = 0; j < 4; ++j) { const float t0 = kb + ka * ftanh(v0[j] * sc), t1 = kb + ka * ftanh(v1[j] * sc); v0[j] = pn == 1 ? v0[j] : t0; v1[j] = pn == 1 ? v1[j] : t1; }
                    u32x4 w; w.x = cvt_pk_bf16(v0[0], v0[1]); w.y = cvt_pk_bf16(v0[2], v0[3]); w.z = cvt_pk_bf16(v1[0], v1[1]); w.w = cvt_pk_bf16(v1[2], v1[3]);
                    *(u32x4*)(base + (size_t)row * 256 + col0 + bj * HALF) = w; __builtin_amdgcn_sched_barrier(0); }
    }
};
}
namespace at {
using pg8::bf16_t; using pg8::bf16x8; using pg8::u32x4;
typedef short s16x4 __attribute__((ext_vector_type(4)));
typedef float f32x16 __attribute__((ext_vector_type(16)));
constexpr int NW = 8, QBLK = 32, KVBLK = 64;
constexpr int SHM_V = KVBLK * 128 * 2, SHM_K = KVBLK * 128 * 2, SHM_R = KVBLK * 64 * 2;
constexpr int OFF_V = 0, OFF_K = 2 * SHM_V, OFF_R = OFF_K + 2 * SHM_K, OFF_WS = OFF_R + 2 * SHM_R, OFF_BIAS = OFF_WS + NW * 64 * 4, OFF_QR = OFF_BIAS + 1024, ATT_LDS = OFF_QR + 256 * 128;
#define KSWZ(row, colB) ((row) * 256 + ((colB) ^ (((row) & 7) << 4)))
#define RSWZ(row, colB) ((row) * 128 + ((colB) ^ (((row) & 7) << 4)))
#define SBAR() __builtin_amdgcn_sched_barrier(0)
__device__ __forceinline__ int crow(int r, int hi) { return (r & 3) + 8 * (r >> 2) + 4 * hi; }
__device__ __forceinline__ unsigned cvtpk(float lo, float hi) { unsigned r; asm volatile("v_cvt_pk_bf16_f32 %0, %1, %2" : "=v"(r) : "v"(lo), "v"(hi)); return r; }
__device__ __forceinline__ bf16x8 ld8(const bf16_t* p) { return *reinterpret_cast<const bf16x8*>(p); }

__device__ __forceinline__ void partialSM(f32x16& p0, f32x16& p1, float& m_reg, float& mn, float& alpha, const float C, const float thr) {
  float pmax = p0[0];
#pragma unroll
  for (int r = 1; r < 16; ++r) pmax = fmaxf(pmax, p0[r]);
#pragma unroll
  for (int r = 0; r < 16; ++r) pmax = fmaxf(pmax, p1[r]);
  { auto rr = __builtin_amdgcn_permlane32_swap(__float_as_uint(pmax), __float_as_uint(pmax), false, false);
    pmax = fmaxf(__uint_as_float(rr[0]), __uint_as_float(rr[1])); }
  if (__builtin_expect(__all(pmax - m_reg <= thr), 1)) { mn = m_reg; alpha = 1.f; }
  else { mn = fmaxf(m_reg, pmax); alpha = __builtin_amdgcn_exp2f((m_reg - mn) * C); m_reg = mn; }
  const float mnC = -mn * C;
#pragma unroll
  for (int r = 0; r < 16; ++r) p0[r] = fmaf(p0[r], C, mnC);
#pragma unroll
  for (int r = 0; r < 16; ++r) p1[r] = fmaf(p1[r], C, mnC);
#pragma unroll
  for (int r = 0; r < 16; ++r) p0[r] = __builtin_amdgcn_exp2f(p0[r]);
}
__device__ __forceinline__ void finishSM(f32x16& p0, f32x16& p1, float alpha, float& l_reg, bf16x8& pa0, bf16x8& pa1, bf16x8& pa2, bf16x8& pa3) {
#pragma unroll
  for (int r = 0; r < 16; ++r) p1[r] = __builtin_amdgcn_exp2f(p1[r]);
  float ps = 0;
#pragma unroll
  for (int r = 0; r < 16; ++r) ps += p0[r];
#pragma unroll
  for (int r = 0; r < 16; ++r) ps += p1[r];
  { auto rr = __builtin_amdgcn_permlane32_swap(__float_as_uint(ps), __float_as_uint(ps), false, false);
    ps = __uint_as_float(rr[0]) + __uint_as_float(rr[1]); }
  l_reg = l_reg * alpha + ps;
#define PK4(P, BASE, OUT) do { unsigned a0 = cvtpk(P[BASE + 0], P[BASE + 1]), a1 = cvtpk(P[BASE + 2], P[BASE + 3]);   \
    unsigned b0 = cvtpk(P[BASE + 4], P[BASE + 5]), b1 = cvtpk(P[BASE + 6], P[BASE + 7]);                              \
    auto r0 = __builtin_amdgcn_permlane32_swap(a0, b0, false, false); auto r1 = __builtin_amdgcn_permlane32_swap(a1, b1, false, false); \
    u32x4 w = {r0[0], r1[0], r0[1], r1[1]}; OUT = *reinterpret_cast<bf16x8*>(&w); } while (0)
  PK4(p0, 0, pa0); PK4(p0, 8, pa1); PK4(p1, 0, pa2); PK4(p1, 8, pa3);
#undef PK4
}
template <int NQD>
__device__ __forceinline__ void qkt(f32x16& p0, f32x16& p1, const char* Ks, const char* Rs, const bf16x8* qr, const char* Qrs, int qrow, int r32, int hi) {
  p0 = f32x16{}; p1 = f32x16{};
#pragma unroll
  for (int d0 = 0; d0 < 8; ++d0) { const int cb = (d0 * 16 + hi * 8) * 2;
    bf16x8 b0 = *reinterpret_cast<const bf16x8*>(Ks + KSWZ(r32, cb));
    bf16x8 b1 = *reinterpret_cast<const bf16x8*>(Ks + KSWZ(32 + r32, cb));
    p0 = __builtin_amdgcn_mfma_f32_32x32x16_bf16(b0, qr[d0], p0, 0, 0, 0);
    p1 = __builtin_amdgcn_mfma_f32_32x32x16_bf16(b1, qr[d0], p1, 0, 0, 0); }
  if constexpr (NQD > 8) {
#pragma unroll
    for (int d0 = 8; d0 < NQD; ++d0) { const int cb = ((d0 - 8) * 16 + hi * 8) * 2;
      bf16x8 b0 = *reinterpret_cast<const bf16x8*>(Rs + RSWZ(r32, cb));
      bf16x8 b1 = *reinterpret_cast<const bf16x8*>(Rs + RSWZ(32 + r32, cb));
      const bf16x8 qv = *reinterpret_cast<const bf16x8*>(Qrs + RSWZ(qrow, cb));
      p0 = __builtin_amdgcn_mfma_f32_32x32x16_bf16(b0, qv, p0, 0, 0, 0);
      p1 = __builtin_amdgcn_mfma_f32_32x32x16_bf16(b1, qv, p1, 0, 0, 0); }
  }
}
__device__ __forceinline__ int v_st(int k, int c) { const int kk = (k & ~0xC) | ((k & 4) << 1) | ((k & 8) >> 1); return ((kk >> 3) * 4 + (c >> 5)) * 512 + ((kk & 7) * 32 + (c & 31)) * 2; }
__device__ __forceinline__ int v_rd_base(int lane) { return ((lane & 3) << 3) | (((lane >> 2) & 3) << 6) | (((lane >> 4) & 1) << 5) | (((lane >> 5) & 1) << 8); }
constexpr int v_rd_off(int d0, int ks, int half) { return d0 * 512 + ks * 4096 + half * 2048; }
template <int OFF> __device__ __forceinline__ s16x4 tr_read(int vb) {
  s16x4 r; asm volatile("ds_read_b64_tr_b16 %0, %1 offset:%2" : "=&v"(r) : "v"(vb), "i"(OFF) : "memory"); return r;
}
template <int D0> __device__ __forceinline__ void pv_one(f32x16& od, int vb, bf16x8 pa0, bf16x8 pa1, bf16x8 pa2, bf16x8 pa3) {
  const s16x4 l0 = tr_read<v_rd_off(D0, 0, 0)>(vb), h0 = tr_read<v_rd_off(D0, 0, 1)>(vb), l1 = tr_read<v_rd_off(D0, 1, 0)>(vb), h1 = tr_read<v_rd_off(D0, 1, 1)>(vb);
  const s16x4 l2 = tr_read<v_rd_off(D0, 2, 0)>(vb), h2 = tr_read<v_rd_off(D0, 2, 1)>(vb), l3 = tr_read<v_rd_off(D0, 3, 0)>(vb), h3 = tr_read<v_rd_off(D0, 3, 1)>(vb);
  asm volatile("s_waitcnt lgkmcnt(0)" ::: "memory"); SBAR();
#define PK(L, H) (bf16x8){L[0], L[1], L[2], L[3], H[0], H[1], H[2], H[3]}
  od = __builtin_amdgcn_mfma_f32_32x32x16_bf16(pa0, PK(l0, h0), od, 0, 0, 0);
  od = __builtin_amdgcn_mfma_f32_32x32x16_bf16(pa1, PK(l1, h1), od, 0, 0, 0);
  od = __builtin_amdgcn_mfma_f32_32x32x16_bf16(pa2, PK(l2, h2), od, 0, 0, 0);
  od = __builtin_amdgcn_mfma_f32_32x32x16_bf16(pa3, PK(l3, h3), od, 0, 0, 0);
#undef PK
}
__device__ __forceinline__ void pv_d0(f32x16* o, int vb, bf16x8 pa0, bf16x8 pa1, bf16x8 pa2, bf16x8 pa3) {
  pv_one<0>(o[0], vb, pa0, pa1, pa2, pa3); pv_one<1>(o[1], vb, pa0, pa1, pa2, pa3); pv_one<2>(o[2], vb, pa0, pa1, pa2, pa3); pv_one<3>(o[3], vb, pa0, pa1, pa2, pa3);
}

struct Args {
  const bf16_t* Q;
  const bf16_t* K;
  const bf16_t* Kr;
  const bf16_t* V;
  bf16_t* O;
  float* lse; long ldlse;
  int nt;
  int kb0, L;
  const float* biasG;
  float C, thr;
};

template <int NQD, bool DIL, long LDQ, long LDK, long LDO>
__device__ __forceinline__ void attn_body(const Args& A, char* lds) {
  const int tid = tidx(), wid = tid >> 6, lane = tid & 63, r32 = lane & 31, hi = lane >> 5;
  char* V_lds = lds + OFF_V; char* K_lds = lds + OFF_K; char* R_lds = lds + OFF_R;
  float* ws = (float*)(lds + OFF_WS) + wid * 64; float* li_l = ws; float* al_l = ws + 32;
  float* biasL = (float*)(lds + OFF_BIAS);
  char* Qr_lds = lds + OFF_QR;
  float m_reg = -1e30f, l_reg = 0; f32x16 o[4] = {}; bf16x8 qr[8];
  const bf16_t* Qw = A.Q + (long)(wid * QBLK + r32) * LDQ + hi * 8;
#pragma unroll
  for (int d0 = 0; d0 < 8; ++d0) qr[d0] = ld8(Qw + d0 * 16);
  if constexpr (NQD > 8) {
#pragma unroll
    for (int d0 = 8; d0 < NQD; ++d0) *(bf16x8*)(Qr_lds + RSWZ(wid * 32 + r32, ((d0 - 8) * 16 + hi * 8) * 2)) = ld8(Qw + d0 * 16);
  }
  if constexpr (DIL) { if (tid < 129) biasL[tid] = A.biasG[tid]; }
  const int sr = tid >> 4, sc = (tid & 15) * 8, vst0 = v_st(sr, sc), vst1 = v_st(32 + sr, sc);
  const int rr_ = tid >> 3, rc_ = (tid & 7) * 8;
  const int vb0 = (int)(uintptr_t)V_lds + v_rd_base(lane);
  bf16x8 vs0, vs1, ks0, ks1, rs0;
  const int Lm1 = A.L - 1;
#define SLOAD(i) do { long ra, rb; if constexpr (DIL) { int a_ = A.kb0 + (i) * 64 + sr, b_ = a_ + 32; a_ = a_ < 0 ? 0 : (a_ > Lm1 ? Lm1 : a_); b_ = b_ < 0 ? 0 : (b_ > Lm1 ? Lm1 : b_); ra = a_; rb = b_; } \
      else { ra = (i) * 64 + sr; rb = ra + 32; } \
    vs0 = ld8(A.V + ra * LDK + sc); vs1 = ld8(A.V + rb * LDK + sc); ks0 = ld8(A.K + ra * LDK + sc); ks1 = ld8(A.K + rb * LDK + sc); \
    if constexpr (NQD > 8) rs0 = ld8(A.Kr + (long)((i) * 64 + rr_) * 64 + rc_); } while (0)
#define SWRITE(b) do { *(bf16x8*)(V_lds + (b) * SHM_V + vst0) = vs0; *(bf16x8*)(V_lds + (b) * SHM_V + vst1) = vs1; const int kc = sc * 2; \
    *(bf16x8*)(K_lds + (b) * SHM_K + KSWZ(sr, kc)) = ks0; *(bf16x8*)(K_lds + (b) * SHM_K + KSWZ(32 + sr, kc)) = ks1; \
    if constexpr (NQD > 8) *(bf16x8*)(R_lds + (b) * SHM_R + RSWZ(rr_, rc_ * 2)) = rs0; } while (0)
#define SWAIT() asm volatile("s_waitcnt vmcnt(0)" ::: "memory")
#define RESC(a) do { if (__any((a) < 1.f)) { if (hi == 0) al_l[r32] = (a); asm volatile("s_waitcnt lgkmcnt(0)" ::: "memory"); \
    _Pragma("unroll") for (int d = 0; d < 4; ++d) _Pragma("unroll") for (int r = 0; r < 16; ++r) o[d][r] *= al_l[crow(r, hi)]; } } while (0)
#define MASK(P0, P1, i) do { if constexpr (DIL) { const int relb = 64 * ((i) - 1) - (wid * 32 + r32); const int kpb = A.kb0 + 64 * (i); \
    _Pragma("unroll") for (int r = 0; r < 16; ++r) { const int key = crow(r, hi); \
      { const int rel = relb + key, kp = kpb + key; const bool ok = rel >= -64 && rel <= 64 && kp >= 0 && kp <= Lm1; const int ix = ok ? rel + 64 : 0; P0[r] = ok ? fmaf(P0[r], A.C, biasL[ix]) : -1e30f; } \
      { const int rel = relb + key + 32, kp = kpb + key + 32; const bool ok = rel >= -64 && rel <= 64 && kp >= 0 && kp <= Lm1; const int ix = ok ? rel + 64 : 0; P1[r] = ok ? fmaf(P1[r], A.C, biasL[ix]) : -1e30f; } } } } while (0)
  const float Csm = DIL ? 1.f : A.C; const float thr = A.thr;
  f32x16 pA0, pA1; float mnA, alA; bf16x8 pa0, pa1, pa2, pa3; const int NT = A.nt;
  {
    SLOAD(0); SWAIT(); SWRITE(0); __syncthreads();
    for (int i = 0; i < NT; ++i) {
      if constexpr (!DIL) { if (i + 1 < NT) SLOAD(i + 1); }
      SBAR();
      bool live = true;
      if constexpr (DIL) { const int k0 = 64 * (i - 1), q0 = wid * 32; live = (k0 - (q0 + 31) <= 64) && (q0 - (k0 + 63) <= 64) && (A.kb0 + 64 * i + 63 >= 0) && (A.kb0 + 64 * i <= Lm1); }
      if (live) {
      qkt<NQD>(pA0, pA1, K_lds + (i & 1) * SHM_K, R_lds + (i & 1) * SHM_R, qr, Qr_lds, wid * 32 + r32, r32, hi); MASK(pA0, pA1, i); partialSM(pA0, pA1, m_reg, mnA, alA, Csm, thr);
      RESC(alA);
      finishSM(pA0, pA1, alA, l_reg, pa0, pa1, pa2, pa3); SBAR();
      pv_d0(o, vb0 + (i & 1) * SHM_V, pa0, pa1, pa2, pa3);
      }
      if (i + 1 < NT) { if constexpr (DIL) SLOAD(i + 1); SWAIT(); SWRITE((i + 1) & 1); }
      __syncthreads();
    }
  }
  if (hi == 0) li_l[r32] = l_reg; asm volatile("s_waitcnt lgkmcnt(0)" ::: "memory");
  if constexpr (DIL) { if (hi == 0) A.lse[(long)(wid * QBLK + r32) * A.ldlse] = m_reg + __log2f(l_reg); }
  float rli[16];
#pragma unroll
  for (int r = 0; r < 16; ++r) rli[r] = __builtin_amdgcn_rcpf(li_l[crow(r, hi)]);
  bf16_t* Ow = A.O + (long)(wid * QBLK) * LDO;
#pragma unroll
  for (int r = 0; r < 16; ++r) { const int orow = crow(r, hi);
#pragma unroll
    for (int d0 = 0; d0 < 4; ++d0) { const float v = o[d0][r] * rli[r]; Ow[(long)orow * LDO + d0 * 32 + r32] = (bf16_t)(cvtpk(v, v) & 0xffffu); } }
  __syncthreads();
#undef SLOAD
#undef SWRITE
#undef SWAIT
#undef RESC
#undef MASK
}
}
using pg8::bf16_t; using pg8::bf16x8; using pg8::f32x4; using pg8::u32x4;
constexpr int T = 24576, DM = 2048, FH = 5632, NTHR = 512;
constexpr size_t MiB = 1048576;
constexpr size_t O_WM = 0, O_SM = 40 * MiB, O_RF = 104 * MiB, O_RA = 200 * MiB, O_RB = 296 * MiB, O_RC = 392 * MiB, O_RD = 488 * MiB, O_RE = 584 * MiB, O_RX = 680 * MiB,
                 O_RG = 776 * MiB, O_RH = 872 * MiB, WS_END = 968 * MiB;
constexpr size_t S_RINV = O_SM, S_RINVQ = S_RINV + 131072, S_RINVKV = S_RINVQ + 131072, S_LSE = S_RINVKV + 131072  , S_COS = S_LSE + 2359296  ,
                 S_SIN = S_COS + 2 * MiB, S_BIAS = S_SIN + 2 * MiB  , S_GL = S_BIAS + 16384  , S_WL = S_GL + 12 * MiB, S_AL = S_WL + 12 * MiB, S_END = S_AL + 12 * MiB;
static_assert(S_END <= O_RF, "small region overflow");
constexpr int LDS_BYTES = 131072;
static_assert(at::ATT_LDS <= LDS_BYTES, "attention LDS");

struct Params {
  const float *xp, *xs, *norm_g, *rel_bias, *w_in, *q_norm, *kv_norm, *w_uq, *w_ukv, *w_out, *mu, *w_r, *w_k, *w_v, *w_o, *w0, *w1, *w2, *a0, *a1, *a2, *g1, *g2, *k_k, *k_a, *r_k, *ln_w, *ln_b,
              *w_gate, *w_up, *w_down;
  float* out; unsigned char* ws; int ph_lo, ph_hi;
};

__device__ __forceinline__ float bf2f(bf16_t b) { return __uint_as_float(((unsigned)b) << 16); }
__device__ __forceinline__ bf16_t f2bf(float f) { unsigned u = __float_as_uint(f); u += 0x7FFFu + ((u >> 16) & 1u); return (bf16_t)(u >> 16); }
__device__ __forceinline__ float wave_sum(float x) {
#pragma unroll
  for (int o = 32; o >= 1; o >>= 1) x += __shfl_xor(x, o);
  return x;
}
template <int CTRL> __device__ __forceinline__ float dpp_f(float x) { return __int_as_float(__builtin_amdgcn_update_dpp(0, __float_as_int(x), CTRL, 0xF, 0xF, false)); }
__device__ __forceinline__ float row16_sum(float x) { x += dpp_f<0x128>(x); x += dpp_f<0x124>(x); x += dpp_f<0x122>(x); x += dpp_f<0x121>(x); return x; }

struct WMap { const float* s0; const float* s1; const float* gain; int ld; int mode; };
__device__ __forceinline__ int rope_dim(int p) { const int q = p >> 3, w = p & 7; return w < 4 ? 4 * q + w : 32 + 4 * q + (w - 4); }
__device__ __forceinline__ float wmap_get(const WMap& m, int k, int n) {
  float g = m.gain ? m.gain[k] : 1.f;
  switch (m.mode) {
    case 0: return m.s0[(size_t)k * m.ld + n] * g;
    case 1: { int col; if (n < 1024) col = n; else if (n < 4096) col = n + 64; else if (n < 4160) col = 1024 + rope_dim(n - 4096); else return 0.f; return m.s0[(size_t)k * 4160 + col] * g; }
    case 2: { const int h = n / 192, c = n - h * 192; const int col = c < 128 ? n : h * 192 + 128 + rope_dim(c - 128); return m.s0[(size_t)k * 1536 + col] * g; }
    case 3: { const int g8 = n >> 3, w = n & 7; return (w < 4 ? m.s0[(size_t)k * FH + g8 * 4 + w] : m.s1[(size_t)k * FH + g8 * 4 + w - 4]) * g; }
    case 4: { if (n < 96) return m.s0[(size_t)k * 96 + n]; if (n < 192) return m.s1[(size_t)k * 96 + n - 96]; return 0.f; }
    default: { const int d = n >> 11, kk = k - d * 96; if (kk < 0 || kk >= 96) return 0.f; return (d ? m.s1 : m.s0)[(size_t)kk * 2048 + (n & 2047)]; }
  }
}
__device__ __forceinline__ void convert_T(const WMap& m, bf16_t* dst, int N, int K, float* tile  ) {
  const int tid = tidx(), ntn = N >> 6, ntk = K >> 6, nt = ntn * ntk;
  for (int t = blockIdx.x; t < nt; t += gridDim.x) {
    const int n0 = (t % ntn) << 6, k0 = (t / ntn) << 6;
    { const int j = tid & 63, i0 = tid >> 6;
#pragma unroll
      for (int kk = 0; kk < 8; ++kk) { const int kl = i0 * 8 + kk; tile[kl * 65 + j] = wmap_get(m, k0 + kl, n0 + j); } }
    __syncthreads();
    { const int nl = tid >> 3, kc = (tid & 7) * 8; float v[8];
#pragma unroll
      for (int e = 0; e < 8; ++e) v[e] = tile[(kc + e) * 65 + nl];
      u32x4 w; w.x = pg8::cvt_pk_bf16(v[0], v[1]); w.y = pg8::cvt_pk_bf16(v[2], v[3]); w.z = pg8::cvt_pk_bf16(v[4], v[5]); w.w = pg8::cvt_pk_bf16(v[6], v[7]);
      *(u32x4*)(dst + (size_t)(n0 + nl) * K + k0 + kc) = w; }
    __syncthreads();
  }
}
__device__ __forceinline__ void convert_attn_weights(const Params& p, int i, int layer, float* tile) {
  bf16_t* W = (bf16_t*)(p.ws + O_WM);
  { WMap m{p.w_in + (size_t)i * 2048 * 4160, nullptr, p.norm_g + (size_t)(layer * 4 + 0) * DM, 4160, 1}; convert_T(m, W, 4352, 2048, tile); }
  { WMap m{p.w_uq + (size_t)i * 512 * 1536, nullptr, p.q_norm + (size_t)i * 512, 1536, 2}; convert_T(m, W + 8912896, 1536, 512, tile); }
  { WMap m{p.w_ukv + (size_t)i * 512 * 2048, nullptr, p.kv_norm + (size_t)i * 512, 2048, 0}; convert_T(m, W + 8912896 + 786432, 2048, 512, tile); }
  { WMap m{p.w_out + (size_t)i * 2048 * 2048, nullptr, nullptr, 2048, 0}; convert_T(m, W + 8912896 + 786432 + 1048576, 2048, 2048, tile); }
}
constexpr size_t WA_IN = 0, WA_UQ = 8912896, WA_UKV = WA_UQ + 786432, WA_OUT = WA_UKV + 1048576;
constexpr size_t WR_R = 0, WR_K = 4194304, WR_V = 2 * 4194304, WR_O = 3 * 4194304, WR_W1 = 4 * 4194304, WR_A1 = WR_W1 + 524288, WR_G1 = WR_A1 + 524288, WR_G2 = WR_G1 + 524288,
                 WR_W2 = WR_G2 + 524288, WR_A2 = WR_W2 + 1048576;
static_assert((WR_A2 + 1048576) * 2 == 40 * MiB, "rwkv weights size");
__device__ __forceinline__ void convert_rwkv_weights(const Params& p, int i, float* tile) {
  bf16_t* W = (bf16_t*)(p.ws + O_WM); const size_t DD = (size_t)DM * DM;
  { WMap m{p.w_r + i * DD, nullptr, nullptr, 2048, 0}; convert_T(m, W + WR_R, 2048, 2048, tile); }
  { WMap m{p.w_k + i * DD, nullptr, nullptr, 2048, 0}; convert_T(m, W + WR_K, 2048, 2048, tile); }
  { WMap m{p.w_v + i * DD, nullptr, nullptr, 2048, 0}; convert_T(m, W + WR_V, 2048, 2048, tile); }
  { WMap m{p.w_o + i * DD, nullptr, nullptr, 2048, 0}; convert_T(m, W + WR_O, 2048, 2048, tile); }
  { WMap m{p.w1 + (size_t)(i * 2) * 2048 * 96, p.w1 + (size_t)(i * 2 + 1) * 2048 * 96, nullptr, 96, 4}; convert_T(m, W + WR_W1, 256, 2048, tile); }
  { WMap m{p.a1 + (size_t)(i * 2) * 2048 * 96, p.a1 + (size_t)(i * 2 + 1) * 2048 * 96, nullptr, 96, 4}; convert_T(m, W + WR_A1, 256, 2048, tile); }
  { WMap m{p.g1 + (size_t)i * 2048 * 256, nullptr, nullptr, 256, 0}; convert_T(m, W + WR_G1, 256, 2048, tile); }
  { WMap m{p.g2 + (size_t)i * 256 * 2048, nullptr, nullptr, 2048, 0}; convert_T(m, W + WR_G2, 2048, 256, tile); }
  { WMap m{p.w2 + (size_t)(i * 2) * 96 * 2048, p.w2 + (size_t)(i * 2 + 1) * 96 * 2048, nullptr, 2048, 5}; convert_T(m, W + WR_W2, 4096, 256, tile); }
  { WMap m{p.a2 + (size_t)(i * 2) * 96 * 2048, p.a2 + (size_t)(i * 2 + 1) * 96 * 2048, nullptr, 2048, 5}; convert_T(m, W + WR_A2, 4096, 256, tile); }
}
constexpr size_t WF_GU = 0, WF_DN = (size_t)11264 * 2048;
__device__ __forceinline__ void convert_ffn_weights(const Params& p, int layer, float* tile) {
  bf16_t* W = (bf16_t*)(p.ws + O_RF); const size_t DF = (size_t)DM * FH;
  { WMap m{p.w_gate + layer * DF, p.w_up + layer * DF, p.norm_g + (size_t)(layer * 4 + 2) * DM, FH, 3}; convert_T(m, W + WF_GU, 11264, 2048, tile); }
  { WMap m{p.w_down + layer * DF, nullptr, nullptr, 2048, 0}; convert_T(m, W + WF_DN, 2048, 5632, tile); }
}
__device__ __forceinline__ void convert_mixer_weights(const Params& p, int layer, float* tile) { if (layer & 1) convert_rwkv_weights(p, layer >> 1, tile); else convert_attn_weights(p, layer >> 1, layer, tile); }

__device__ __forceinline__ void resid_phase(const Params& p, const bf16_t* mix, const float* g) {
  const int lane = tidx() & 63, gw = blockIdx.x * 8 + (tidx() >> 6), nw = gridDim.x * 8;
  bf16_t* xb = (bf16_t*)(p.ws + O_RC); float* rinv = (float*)(p.ws + S_RINV);
  for (int t = gw; t < T; t += nw) {
    float* xr = p.out + (size_t)t * DM; float xv[4][8];
    if (mix) {
      const bf16_t* mr = mix + (size_t)t * DM; float mv[4][8]; float ss = 0;
#pragma unroll
      for (int i = 0; i < 4; ++i) { const bf16x8 m8 = *(const bf16x8*)(mr + i * 512 + lane * 8);
#pragma unroll
        for (int e = 0; e < 8; ++e) { mv[i][e] = bf2f((bf16_t)m8[e]); ss += mv[i][e] * mv[i][e]; } }
      ss = wave_sum(ss); const float sc = rsqrtf(ss * (1.f / DM) + 1e-6f);
#pragma unroll
      for (int i = 0; i < 4; ++i) { const f32x4 g0 = *(const f32x4*)(g + i * 512 + lane * 8), g1 = *(const f32x4*)(g + i * 512 + lane * 8 + 4);
        const f32x4 x0 = *(const f32x4*)(xr + i * 512 + lane * 8), x1 = *(const f32x4*)(xr + i * 512 + lane * 8 + 4);
#pragma unroll
        for (int e = 0; e < 4; ++e) { xv[i][e] = x0[e] + mv[i][e] * sc * g0[e]; xv[i][4 + e] = x1[e] + mv[i][4 + e] * sc * g1[e]; } }
    } else {
      const float* src = t < 8192 ? p.xp + (size_t)t * DM : p.xs + (size_t)(t - 8192) * DM;
#pragma unroll
      for (int i = 0; i < 4; ++i) { const f32x4 x0 = *(const f32x4*)(src + i * 512 + lane * 8), x1 = *(const f32x4*)(src + i * 512 + lane * 8 + 4);
#pragma unroll
        for (int e = 0; e < 4; ++e) { xv[i][e] = x0[e]; xv[i][4 + e] = x1[e]; } }
    }
    float s2 = 0;
#pragma unroll
    for (int i = 0; i < 4; ++i) {
#pragma unroll
      for (int e = 0; e < 8; ++e) s2 += xv[i][e] * xv[i][e];
      *(f32x4*)(xr + i * 512 + lane * 8) = (f32x4){xv[i][0], xv[i][1], xv[i][2], xv[i][3]}; *(f32x4*)(xr + i * 512 + lane * 8 + 4) = (f32x4){xv[i][4], xv[i][5], xv[i][6], xv[i][7]};
      u32x4 w; w.x = pg8::cvt_pk_bf16(xv[i][0], xv[i][1]); w.y = pg8::cvt_pk_bf16(xv[i][2], xv[i][3]); w.z = pg8::cvt_pk_bf16(xv[i][4], xv[i][5]); w.w = pg8::cvt_pk_bf16(xv[i][6], xv[i][7]);
      *(u32x4*)(xb + (size_t)t * DM + i * 512 + lane * 8) = w; }
    s2 = wave_sum(s2); if (lane == 0) rinv[t] = rsqrtf(s2 * (1.f / DM) + 1e-6f);
  }
}
__device__ __forceinline__ void rownorm_phase(const Params& p) {
  const int lane = tidx() & 63, gw = blockIdx.x * 8 + (tidx() >> 6), nw = gridDim.x * 8;
  const bf16_t* cq = (const bf16_t*)(p.ws + O_RA); const bf16_t* ckv = cq + (size_t)T * 512;
  float* rq = (float*)(p.ws + S_RINVQ); float* rkv = (float*)(p.ws + S_RINVKV);
  for (int t = gw; t < 2 * T; t += nw) { const int tt = t >= T ? t - T : t; const bf16_t* src = (t >= T ? ckv : cq) + (size_t)tt * 512 + lane * 8;
    const bf16x8 v = *(const bf16x8*)src; float ss = 0;
#pragma unroll
    for (int e = 0; e < 8; ++e) { const float f = bf2f((bf16_t)v[e]); ss += f * f; }
    ss = wave_sum(ss); if (lane == 0) (t >= T ? rkv : rq)[tt] = rsqrtf(ss * (1.f / 512) + 1e-6f); }
}
__device__ __forceinline__ void mix_phase(const Params& p, const float* g0, const float* mu  , int sel0, int sel1, int sel2) {
  const int lane = tidx() & 63, gw = blockIdx.x * 8 + (tidx() >> 6), nw = gridDim.x * 8;
  const float* rinv = (const float*)(p.ws + S_RINV);
  bf16_t* m0 = (bf16_t*)(p.ws + O_RD); bf16_t* m1 = (bf16_t*)(p.ws + O_RE); bf16_t* m2 = (bf16_t*)(p.ws + O_RX);
  for (int t = gw; t < T; t += nw) {
    const int s0 = pg8::seq_start(t), len = s0 == 8192 ? 16384 : 4096; const bool hasp = t > s0, hasn = t < s0 + len - 1;
    const float rc = rinv[t], rp = hasp ? rinv[t - 1] : 0.f, rn = hasn ? rinv[t + 1] : 0.f;
    const float* xc = p.out + (size_t)t * DM; const float* xpv = hasp ? xc - DM : xc; const float* xnv = hasn ? xc + DM : xc;
#pragma unroll 2
    for (int i = 0; i < 8; ++i) { const int c = i * 256 + lane * 4;
      const f32x4 gv = *(const f32x4*)(g0 + c); const f32x4 h = *(const f32x4*)(xc + c) * rc * gv, hp = *(const f32x4*)(xpv + c) * rp * gv, hn = *(const f32x4*)(xnv + c) * rn * gv;
      const f32x4 xx = (hp + hn) * 0.5f - h;
      const f32x4 a = h + xx * *(const f32x4*)(mu + sel0 * DM + c), b = h + xx * *(const f32x4*)(mu + sel1 * DM + c), d = h + xx * *(const f32x4*)(mu + sel2 * DM + c);
      uint2 w; w.x = pg8::cvt_pk_bf16(a[0], a[1]); w.y = pg8::cvt_pk_bf16(a[2], a[3]); *(uint2*)(m0 + (size_t)t * DM + c) = w;
      w.x = pg8::cvt_pk_bf16(b[0], b[1]); w.y = pg8::cvt_pk_bf16(b[2], b[3]); *(uint2*)(m1 + (size_t)t * DM + c) = w;
      w.x = pg8::cvt_pk_bf16(d[0], d[1]); w.y = pg8::cvt_pk_bf16(d[2], d[3]); *(uint2*)(m2 + (size_t)t * DM + c) = w; }
  }
}
__device__ __forceinline__ float sum8(float x) { x += __shfl_xor(x, 1); x += __shfl_xor(x, 2); x += __shfl_xor(x, 4); return x; }
__device__ __forceinline__ void postscan_phase(const Params& p, int i) {
  const int lane = tidx() & 63, gw = blockIdx.x * 8 + (tidx() >> 6), nw = gridDim.x * 8;
  bf16_t* y0 = (bf16_t*)(p.ws + O_RH); const bf16_t* y1 = (const bf16_t*)(p.ws + O_RF);
  const bf16_t* r = (const bf16_t*)(p.ws + O_RA); const bf16_t* k = (const bf16_t*)(p.ws + O_RB); const bf16_t* v = (const bf16_t*)(p.ws + O_RC); const bf16_t* g = (const bf16_t*)(p.ws + O_RD);
  const float* lnw = p.ln_w + (size_t)i * DM; const float* lnb = p.ln_b + (size_t)i * DM; const float* rk = p.r_k + (size_t)i * DM;
  for (int t = gw; t < T; t += nw) {
#pragma unroll 2
    for (int hg = 0; hg < 4; ++hg) { const int c = hg * 512 + lane * 8; const size_t ix = (size_t)t * DM + c;
      const bf16x8 a0 = *(const bf16x8*)(y0 + ix), a1 = *(const bf16x8*)(y1 + ix), rv = *(const bf16x8*)(r + ix), kv = *(const bf16x8*)(k + ix), vv = *(const bf16x8*)(v + ix), gv = *(const bf16x8*)(g + ix);
      const f32x4 w0 = *(const f32x4*)(lnw + c), w1 = *(const f32x4*)(lnw + c + 4), b0 = *(const f32x4*)(lnb + c), b1 = *(const f32x4*)(lnb + c + 4), q0 = *(const f32x4*)(rk + c), q1 = *(const f32x4*)(rk + c + 4);
      float y[8]; float s = 0.f, bs = 0.f;
#pragma unroll
      for (int e = 0; e < 8; ++e) { y[e] = bf2f((bf16_t)a0[e]) + bf2f((bf16_t)a1[e]); s += y[e]; bs += bf2f((bf16_t)rv[e]) * bf2f((bf16_t)kv[e]) * (e < 4 ? q0[e & 3] : q1[e & 3]); }
      const float mean = sum8(s) * (1.f / 64); const float bonus = sum8(bs);
      float vs = 0.f;
#pragma unroll
      for (int e = 0; e < 8; ++e) { y[e] -= mean; vs += y[e] * y[e]; }
      const float rstd = rsqrtf(sum8(vs) * (1.f / 64) + 64e-5f);
      float o[8];
#pragma unroll
      for (int e = 0; e < 8; ++e) { const float wv = e < 4 ? w0[e & 3] : w1[e & 3], bv = e < 4 ? b0[e & 3] : b1[e & 3];
        o[e] = (y[e] * rstd * wv + bv + bonus * bf2f((bf16_t)vv[e])) * bf2f((bf16_t)gv[e]); }
      u32x4 w; w.x = pg8::cvt_pk_bf16(o[0], o[1]); w.y = pg8::cvt_pk_bf16(o[2], o[3]); w.z = pg8::cvt_pk_bf16(o[4], o[5]); w.w = pg8::cvt_pk_bf16(o[6], o[7]);
      *(u32x4*)(y0 + ix) = w; }
  }
}
__device__ __forceinline__ void combine_phase(const Params& p) {
  const bf16_t* Op = (const bf16_t*)(p.ws + O_RX); const float* lse = (const float*)(p.ws + S_LSE); bf16_t* cat = (bf16_t*)(p.ws + O_RF);
  const size_t n = (size_t)T * 128;
  for (size_t it = (size_t)blockIdx.x * NTHR + tidx(); it < n; it += (size_t)gridDim.x * NTHR) {
    const int t = (int)(it >> 7), c8 = (int)(it & 127) * 8, h = c8 >> 7;
    const float l0 = lse[((size_t)0 * T + t) * 8 + h], l1 = lse[((size_t)1 * T + t) * 8 + h], l2 = lse[((size_t)2 * T + t) * 8 + h];
    const float m = fmaxf(l0, fmaxf(l1, l2)); float w0 = __builtin_amdgcn_exp2f(l0 - m), w1 = __builtin_amdgcn_exp2f(l1 - m), w2 = __builtin_amdgcn_exp2f(l2 - m);
    const float inv = 1.f / (w0 + w1 + w2); w0 *= inv; w1 *= inv; w2 *= inv;
    const bf16x8 a = *(const bf16x8*)(Op + ((size_t)0 * T + t) * 1024 + c8), b = *(const bf16x8*)(Op + ((size_t)1 * T + t) * 1024 + c8), d = *(const bf16x8*)(Op + ((size_t)2 * T + t) * 1024 + c8);
    float o[8];
#pragma unroll
    for (int e = 0; e < 8; ++e) o[e] = w0 * bf2f((bf16_t)a[e]) + w1 * bf2f((bf16_t)b[e]) + w2 * bf2f((bf16_t)d[e]);
    u32x4 w; w.x = pg8::cvt_pk_bf16(o[0], o[1]); w.y = pg8::cvt_pk_bf16(o[2], o[3]); w.z = pg8::cvt_pk_bf16(o[4], o[5]); w.w = pg8::cvt_pk_bf16(o[6], o[7]);
    *(u32x4*)(cat + (size_t)t * DM + 1024 + c8) = w;
  }
}
__device__ __forceinline__ void tables_phase(const Params& p) {
  float* cs = (float*)(p.ws + S_COS); float* sn = (float*)(p.ws + S_SIN); float* bt = (float*)(p.ws + S_BIAS);
  for (int it = blockIdx.x * NTHR + tidx(); it < 16384 * 32; it += gridDim.x * NTHR) { const int pos = it >> 5, i = it & 31;
    const float inv = __builtin_amdgcn_exp2f(-(float)i * (13.287712379549449f / 32.f)); const float ang = (float)pos * inv;
    const double rev = (double)ang * 0.15915494309189535; const float fr = (float)(rev - __builtin_rint(rev));
    cs[it] = __builtin_amdgcn_cosf(fr); sn[it] = __builtin_amdgcn_sinf(fr); }
  for (int it = blockIdx.x * NTHR + tidx(); it < 3 * 8 * 129; it += gridDim.x * NTHR) { const int pat = it / (8 * 129), rem = it - pat * 8 * 129, h = rem / 129, rl = rem - h * 129 - 64;
    const int dil = pat == 0 ? 1 : (pat == 1 ? 4 : 16); const int rel = rl * dil; const int n = rel < 0 ? -rel : rel;
    int bucket = rel > 0 ? 16 : 0;
    if (n < 8) bucket += n; else { int lg = 8 + (int)(__log2f((float)n * 0.125f) * (8.f / 7.f)); bucket += lg < 15 ? lg : 15; }
    bt[it] = p.rel_bias[bucket * 8 + h] * 1.4426950408889634f; }
}
constexpr int SCH = 32;
constexpr int SC_AM = 0, SC_B = 8192, SC_W = 16384, SC_KD = 24576, SC_R = 32768, SC_V = 40960, SC_Y = 45056, SC_BUF = 49152;
static_assert(2 * SC_BUF <= LDS_BYTES, "scan LDS");
__device__ __forceinline__ void scan_phase(const Params& p, int i, unsigned char* lds) {
  const int tid = tidx(), wid = tid >> 6, lane = tid & 63;
  const bf16_t* rB = (const bf16_t*)(p.ws + O_RA); const bf16_t* kB = (const bf16_t*)(p.ws + O_RB); const bf16_t* vB = (const bf16_t*)(p.ws + O_RC);
  const bf16_t* eB = (const bf16_t*)(p.ws + O_RD); const bf16_t* aB = (const bf16_t*)(p.ws + O_RX);
  const float* kkw = p.k_k + (size_t)i * DM; const float* kaw = p.k_a + (size_t)i * DM;
  for (int wk = blockIdx.x; wk < 256; wk += gridDim.x) {
    for (int q = 0; q < 2; ++q) {
      int s0, len, head, dir, rowbase; const bool qm = (q == 0);
      if (qm) { const int u = wk >> 2; rowbase = (wk & 3) * 16; dir = u & 1; head = u >> 1; s0 = 8192; len = 16384; }
      else { const int u = wk >> 1; rowbase = (wk & 1) * 32; dir = u & 1; head = (u >> 1) & 31; s0 = (u >> 6) * 4096; len = 4096; }
      bf16_t* yB = (bf16_t*)(p.ws + (dir ? O_RF : O_RH));
      const int nch = len / SCH;
      const int rp = lane >> 4, kq = lane & 15;
      float S0[4] = {0.f, 0.f, 0.f, 0.f}, S1[4] = {0.f, 0.f, 0.f, 0.f};
      const int pw = wid - 4, st = lane >> 3, l8 = lane & 7, c8 = l8 * 8;
      f32x4 kkc[2], kac[2], w0c[2], a0c[2];
      if (wid >= 4) {
#pragma unroll
        for (int e = 0; e < 2; ++e) { const int cc = head * 64 + c8 + e * 4;
          kkc[e] = *(const f32x4*)(kkw + cc); kac[e] = *(const f32x4*)(kaw + cc);
          w0c[e] = *(const f32x4*)(p.w0 + (size_t)(i * 2 + dir) * DM + cc); a0c[e] = *(const f32x4*)(p.a0 + (size_t)(i * 2 + dir) * DM + cc); }
      }
      auto fill = [&](int c, int b) {
        unsigned char* B = lds + b * SC_BUF;
        const int sl = pw * 8 + st; const int s = c * SCH + sl; const int t = dir ? len - 1 - s : s; const size_t tok = (size_t)(s0 + t);
        const bf16x8 kv = *(const bf16x8*)(kB + tok * DM + head * 64 + c8), rv = *(const bf16x8*)(rB + tok * DM + head * 64 + c8);
        const bf16x8 ev = *(const bf16x8*)(eB + tok * 4096 + dir * 2048 + head * 64 + c8), av = *(const bf16x8*)(aB + tok * 4096 + dir * 2048 + head * 64 + c8);
        uint2 vv = make_uint2(0u, 0u); if (!qm || l8 < 4) vv = *(const uint2*)(vB + tok * DM + head * 64 + rowbase + l8 * 4);
        float kf[8], kk[8]; float ss = 0.f;
#pragma unroll
        for (int e = 0; e < 8; ++e) { kf[e] = bf2f((bf16_t)kv[e]); kk[e] = kf[e] * kkc[e >> 2][e & 3]; ss += kk[e] * kk[e]; }
        ss += __shfl_xor(ss, 1); ss += __shfl_xor(ss, 2); ss += __shfl_xor(ss, 4);
        const float inv = rsqrtf(ss + 1e-12f);
        f32x4 oam[2], ob[2], ow[2], okd[2], orr[2];
#pragma unroll
        for (int e = 0; e < 8; ++e) { const int q4 = e >> 2, j = e & 3;
          const float af = pg8::fsig(a0c[q4][j] + bf2f((bf16_t)av[e])); const float ef = 0.6065306597f * pg8::fsig(w0c[q4][j] + bf2f((bf16_t)ev[e]));
          const float kn = kk[e] * inv;
          oam[q4][j] = -kn; ob[q4][j] = kn * af; ow[q4][j] = __expf(-ef); okd[q4][j] = kf[e] * (1.f + (af - 1.f) * kac[q4][j]); orr[q4][j] = bf2f((bf16_t)rv[e]); }
        const int o4 = sl * 16 + l8 * 2;
#pragma unroll
        for (int e = 0; e < 2; ++e) { ((f32x4*)(B + SC_AM))[o4 + e] = oam[e]; ((f32x4*)(B + SC_B))[o4 + e] = ob[e]; ((f32x4*)(B + SC_W))[o4 + e] = ow[e];
          ((f32x4*)(B + SC_KD))[o4 + e] = okd[e]; ((f32x4*)(B + SC_R))[o4 + e] = orr[e]; }
        f32x4 vf; vf[0] = __uint_as_float(vv.x << 16); vf[1] = __uint_as_float(vv.x & 0xffff0000u); vf[2] = __uint_as_float(vv.y << 16); vf[3] = __uint_as_float(vv.y & 0xffff0000u);
        ((f32x4*)(B + SC_V))[sl * 8 + l8] = vf;
      };
      auto flush = [&](int c, int b) {
        const unsigned char* B = lds + b * SC_BUF;
        const int sl = pw * 8 + st; const int s = c * SCH + sl; const int t = dir ? len - 1 - s : s;
        const f32x4 y = ((const f32x4*)(B + SC_Y))[sl * 8 + l8];
        uint2 w; w.x = pg8::cvt_pk_bf16(y[0], y[1]); w.y = pg8::cvt_pk_bf16(y[2], y[3]);
        if (!qm || l8 < 4) *(uint2*)(yB + (size_t)(s0 + t) * DM + head * 64 + rowbase + l8 * 4) = w;
      };
      if (wid >= 4) fill(0, 0);
      __syncthreads();
      for (int c = 0; c < nch; ++c) {
        if (wid < 4) {
          const unsigned char* B = lds + (c & 1) * SC_BUF;
          const f32x4* pAM = (const f32x4*)(B + SC_AM) + kq; const f32x4* pB = (const f32x4*)(B + SC_B) + kq; const f32x4* pW = (const f32x4*)(B + SC_W) + kq;
          const f32x4* pKD = (const f32x4*)(B + SC_KD) + kq; const f32x4* pR = (const f32x4*)(B + SC_R) + kq;
          const float2* pV = (const float2*)(B + SC_V) + wid * 4 + rp; float2* pY = (float2*)(B + SC_Y) + wid * 4 + rp;
          if (!qm) {
          f32x4 am = pAM[0], bb = pB[0], ww = pW[0], kd = pKD[0], rr = pR[0]; float2 vv = pV[0]; float yq0 = 0.f, yq1 = 0.f, yk0 = 0.f, yk1 = 0.f;
#pragma unroll 4
          for (int s = 0; s < SCH; ++s) {
            const int sn = (s + 1 < SCH ? s + 1 : s) * 16;
            const f32x4 am_n = pAM[sn], bb_n = pB[sn], ww_n = pW[sn], kd_n = pKD[sn], rr_n = pR[sn]; const float2 vv_n = pV[sn];
            float sa0 = (S0[0] * am[0] + S0[1] * am[1]) + (S0[2] * am[2] + S0[3] * am[3]);
            float sa1 = (S1[0] * am[0] + S1[1] * am[1]) + (S1[2] * am[2] + S1[3] * am[3]);
            float u0[4], u1[4];
#pragma unroll
            for (int j = 0; j < 4; ++j) { u0[j] = fmaf(S0[j], ww[j], vv.x * kd[j]); u1[j] = fmaf(S1[j], ww[j], vv.y * kd[j]); }
            sa0 += dpp_f<0x128>(sa0); sa1 += dpp_f<0x128>(sa1); yq0 += dpp_f<0x128>(yq0); yq1 += dpp_f<0x128>(yq1);
            sa0 += dpp_f<0x124>(sa0); sa1 += dpp_f<0x124>(sa1); yq0 += dpp_f<0x124>(yq0); yq1 += dpp_f<0x124>(yq1);
            sa0 += dpp_f<0x122>(sa0); sa1 += dpp_f<0x122>(sa1); yq0 += dpp_f<0x122>(yq0); yq1 += dpp_f<0x122>(yq1);
            sa0 += dpp_f<0x121>(sa0); sa1 += dpp_f<0x121>(sa1); yq0 += dpp_f<0x121>(yq0); yq1 += dpp_f<0x121>(yq1);
            { const bool me = kq == ((s - 1) & 15); yk0 = me ? yq0 : yk0; yk1 = me ? yq1 : yk1; }
            if (s == 16) pY[kq * 16] = make_float2(yk0, yk1);
#pragma unroll
            for (int j = 0; j < 4; ++j) { S0[j] = fmaf(sa0, bb[j], u0[j]); S1[j] = fmaf(sa1, bb[j], u1[j]); }
            yq0 = (S0[0] * rr[0] + S0[1] * rr[1]) + (S0[2] * rr[2] + S0[3] * rr[3]);
            yq1 = (S1[0] * rr[0] + S1[1] * rr[1]) + (S1[2] * rr[2] + S1[3] * rr[3]);
            am = am_n; bb = bb_n; ww = ww_n; kd = kd_n; rr = rr_n; vv = vv_n;
          }
          yq0 = row16_sum(yq0); yq1 = row16_sum(yq1);
          if (kq == 15) { yk0 = yq0; yk1 = yq1; }
          pY[(16 + kq) * 16] = make_float2(yk0, yk1);
          } else {
          const float* pV1 = (const float*)(B + SC_V) + wid * 4 + rp; float* pY1 = (float*)(B + SC_Y) + wid * 4 + rp;
          f32x4 am = pAM[0], bb = pB[0], ww = pW[0], kd = pKD[0], rr = pR[0]; float vv = pV1[0]; float yq = 0.f, yk = 0.f;
#pragma unroll 4
          for (int s = 0; s < SCH; ++s) {
            const int sn = (s + 1 < SCH ? s + 1 : s);
            const f32x4 am_n = pAM[sn * 16], bb_n = pB[sn * 16], ww_n = pW[sn * 16], kd_n = pKD[sn * 16], rr_n = pR[sn * 16]; const float vv_n = pV1[sn * 32];
            float sa0 = (S0[0] * am[0] + S0[1] * am[1]) + (S0[2] * am[2] + S0[3] * am[3]);
            float u0[4];
#pragma unroll
            for (int j = 0; j < 4; ++j) u0[j] = fmaf(S0[j], ww[j], vv * kd[j]);
            sa0 += dpp_f<0x128>(sa0); yq += dpp_f<0x128>(yq);
            sa0 += dpp_f<0x124>(sa0); yq += dpp_f<0x124>(yq);
            sa0 += dpp_f<0x122>(sa0); yq += dpp_f<0x122>(yq);
            sa0 += dpp_f<0x121>(sa0); yq += dpp_f<0x121>(yq);
            yk = (kq == ((s - 1) & 15)) ? yq : yk;
            if (s == 16) pY1[kq * 32] = yk;
#pragma unroll
            for (int j = 0; j < 4; ++j) S0[j] = fmaf(sa0, bb[j], u0[j]);
            yq = (S0[0] * rr[0] + S0[1] * rr[1]) + (S0[2] * rr[2] + S0[3] * rr[3]);
            am = am_n; bb = bb_n; ww = ww_n; kd = kd_n; rr = rr_n; vv = vv_n;
          }
          yq = row16_sum(yq);
          if (kq == 15) yk = yq;
          pY1[(16 + kq) * 32] = yk;
          }
        } else {
          if (c + 1 < nch) fill(c + 1, (c + 1) & 1);
          if (c >= 1) flush(c - 1, (c - 1) & 1);
        }
        __syncthreads();
      }
      if (wid >= 4) flush(nch - 1, (nch - 1) & 1);
      __syncthreads();
    }
  }
}

__device__ __forceinline__ void dilated_phase(const Params& p, char* lds) {
  const bf16_t* qb = (const bf16_t*)(p.ws + O_RD); const bf16_t* kb = qb + (size_t)T * 1024; const bf16_t* vb = kb + (size_t)T * 1024;
  bf16_t* Op = (bf16_t*)(p.ws + O_RX); float* lse = (float*)(p.ws + S_LSE); const float* bt = (const float*)(p.ws + S_BIAS);
  for (int it = blockIdx.x; it < 3 * 8 * 96; it += gridDim.x) {
    const int pat = it / 768, rem = it - pat * 768, h = rem / 96, blk = rem - h * 96;
    const int dil = pat == 0 ? 1 : (pat == 1 ? 4 : 16);
    int s0, len, b = blk;
    if (b < 16) { s0 = 0; len = 4096; } else if (b < 32) { s0 = 4096; len = 4096; b -= 16; } else { s0 = 8192; len = 16384; b -= 32; }
    const int L = len / dil, nbl = L / 256; const int res = b / nbl, j0 = (b - res * nbl) * 256;
    const size_t tok0 = (size_t)(s0 + res);
    at::Args A;
    A.Q = qb + (tok0 + (size_t)j0 * dil) * 1024 + h * 128;
    A.K = kb + tok0 * 1024 + h * 128; A.Kr = nullptr;
    A.V = vb + tok0 * 1024 + h * 128;
    A.O = Op + ((size_t)pat * T + tok0 + (size_t)j0 * dil) * 1024 + h * 128;
    A.lse = lse + ((size_t)pat * T + tok0 + (size_t)j0 * dil) * 8 + h; A.ldlse = (long)dil * 8;
    A.nt = 6; A.kb0 = j0 - 64; A.L = L; A.biasG = bt + (pat * 8 + h) * 129;
    A.C = 0.08838834764831845f * 1.4426950408889634f; A.thr = 11.5f;
    if (pat == 0) at::attn_body<8, true, 1024, 1024, 1024>(A, lds);
    else if (pat == 1) at::attn_body<8, true, 4096, 4096, 4096>(A, lds);
    else at::attn_body<8, true, 16384, 16384, 16384>(A, lds);
  }
}
__device__ __forceinline__ void mla_phase(const Params& p, char* lds) {
  const bf16_t* Qp = (const bf16_t*)(p.ws + O_RB); const bf16_t* kv = (const bf16_t*)(p.ws + O_RH); const bf16_t* kr = (const bf16_t*)(p.ws + O_RA) + (size_t)T * 1024;
  bf16_t* cat = (bf16_t*)(p.ws + O_RF);
  for (int it = blockIdx.x; it < 512 + 256; it += gridDim.x) {
    int s0, len, h, qb_;
    { const int rnd = it >> 8, v = it & 255, slot = v >> 3; h = v & 7;
      if (rnd < 2) { s0 = 8192; len = 16384; qb_ = rnd * 32 + slot; }
      else { s0 = (slot >> 4) * 4096; len = 4096; qb_ = slot & 15; } }
    at::Args A;
    A.Q = Qp + (size_t)(s0 + qb_ * 256) * 1536 + h * 192;
    A.K = kv + (size_t)s0 * 2048 + h * 256; A.Kr = kr + (size_t)s0 * 64;
    A.V = A.K + 128;
    A.O = cat + (size_t)(s0 + qb_ * 256) * 2048 + h * 128;
    A.lse = nullptr; A.ldlse = 0; A.nt = len / 64; A.kb0 = 0; A.L = len; A.biasG = nullptr;
    A.C = 0.07216878364870322f * 1.4426950408889634f; A.thr = 8.f / 0.07216878364870322f;
    at::attn_body<12, false, 1536, 2048, 2048>(A, lds);
  }
}

template <class Epi>
__device__ __forceinline__ void gemm_simple(unsigned char* lds, const pg8::Gemm g, const pg8::StaticOrder& S, const Epi& E) {
  using namespace pg8;
  const int tid = tidx(), wid = tid >> 6, lane = tid & 63, wr = wid >> 2, wc = wid & 3, fr = lane & 15, fq = lane >> 4;
  const int K = g.K, nt = K / BK;
  unsigned offA[2], offB[2];
#pragma unroll
  for (int i = 0; i < 2; ++i) { int R, C; stage_rc(tid * 16 + i * 8192, R, C); const int Rb = Epi::PERM ? ((R & ~31) + perm32(R & 31)) : R;
    offA[i] = (unsigned)(R * K + C); offB[i] = (unsigned)(Rb * K + C); }
  const int aoff = lds_byte(wr * 64 + fr, fq * 8), boff = lds_byte(wc * 32 + fr, fq * 8);
  unsigned char* myst = lds + tid * 16;
  Unit u;
  for (int ui = 0; S.next(ui, u); ++ui) {
    f32x4 acc[2][2][4][2];
#pragma unroll
    for (int a = 0; a < 2; ++a)
#pragma unroll
      for (int b = 0; b < 2; ++b)
#pragma unroll
        for (int m = 0; m < 4; ++m)
#pragma unroll
          for (int n = 0; n < 2; ++n) acc[a][b][m][n] = (f32x4){0.f, 0.f, 0.f, 0.f};
    const bf16_t* Ab = g.A + (size_t)u.pm * 256 * K; const bf16_t* Bb = g.Bt + (size_t)u.pn * 256 * K;
    const size_t hK = (size_t)128 * K;
    bf16x8 sg[2][2];
#define GLOADX(P, off, kt) do { _Pragma("unroll") for (int h = 0; h < 2; ++h) _Pragma("unroll") for (int i = 0; i < 2; ++i) \
      sg[h][i] = *(const bf16x8*)((P) + h * hK + (off)[i] + (size_t)(kt) * BK); } while (0)
#define SWRITEX(base, b) do { _Pragma("unroll") for (int h = 0; h < 2; ++h) _Pragma("unroll") for (int i = 0; i < 2; ++i) \
      *(bf16x8*)(myst + ((base) + (b) * 2 + h) * HTB + i * 8192) = sg[h][i]; } while (0)
    GLOADX(Ab, offA, 0); SWRITEX(0, 0); GLOADX(Bb, offB, 0); SWRITEX(4, 0); __syncthreads();
    for (int kt = 0; kt < nt; ++kt) {
      const int b = kt & 1; const bool more = kt + 1 < nt;
#pragma unroll
      for (int k = 0; k < 2; ++k) {
        if (more) { if (k == 0) GLOADX(Ab, offA, kt + 1); else GLOADX(Bb, offB, kt + 1); }
        __builtin_amdgcn_sched_barrier(0);
        bf16x8 B0[2], B1[2];
#pragma unroll
        for (int n = 0; n < 2; ++n) { B0[n] = *(const bf16x8*)(lds + (4 + b * 2 + 0) * HTB + boff + n * 2048 + k * 1024); B1[n] = *(const bf16x8*)(lds + (4 + b * 2 + 1) * HTB + boff + n * 2048 + k * 1024); }
#pragma unroll
        for (int ai = 0; ai < 2; ++ai) {
#pragma unroll
          for (int m = 0; m < 4; ++m) {
            const bf16x8 At = *(const bf16x8*)(lds + (b * 2 + ai) * HTB + aoff + m * 2048 + k * 1024);
#pragma unroll
            for (int n = 0; n < 2; ++n) {
              acc[ai][0][m][n] = __builtin_amdgcn_mfma_f32_16x16x32_bf16(B0[n], At, acc[ai][0][m][n], 0, 0, 0);
              acc[ai][1][m][n] = __builtin_amdgcn_mfma_f32_16x16x32_bf16(B1[n], At, acc[ai][1][m][n], 0, 0, 0); }
          }
          __builtin_amdgcn_sched_barrier(0);
        }
        if (more) { if (k == 0) SWRITEX(0, b ^ 1); else SWRITEX(4, b ^ 1); }
      }
      __syncthreads();
    }
#undef GLOADX
#undef SWRITEX
    E(acc, u, wr, wc, fr, fq);
  }
}
template <class Epi> __device__ __forceinline__ void run_gemm(unsigned char* lds, const bf16_t* A, const bf16_t* Bt, int N, int K, const Epi& E) {
  pg8::Gemm g{A, Bt, T, N, K}; pg8::StaticOrder S;
  S.init(T, N, (int)gridDim.x, (int)blockIdx.x);
  pg8::gemm_phase<Epi, pg8::StaticOrder, false>((PG8_LAS unsigned char*)lds, g, S, E, nullptr);
  __syncthreads();
}
template <class Epi> __device__ __forceinline__ void run_gemm_small(unsigned char* lds, const bf16_t* A, const bf16_t* Bt, int N, int K, const Epi& E) {
  pg8::Gemm g{A, Bt, T, N, K}; pg8::StaticOrder S;
  S.init(T, N, (int)gridDim.x, (int)blockIdx.x);
  gemm_simple<Epi>(lds, g, S, E);
  __syncthreads();
}

__device__ __forceinline__ Params ldp() { auto k = __builtin_amdgcn_kernarg_segment_ptr(); asm volatile("" : "+s"(k)); Params q; __builtin_memcpy(&q, k, sizeof(Params)); return q; }
__device__ __forceinline__ void gbar(unsigned* ctr, unsigned target) {
  __syncthreads();
  if (threadIdx.x == 0) {
    __builtin_amdgcn_fence(__ATOMIC_RELEASE, "agent");
    __hip_atomic_fetch_add(ctr, 1u, __ATOMIC_RELAXED, __HIP_MEMORY_SCOPE_AGENT);
    while (__hip_atomic_load(ctr, __ATOMIC_RELAXED, __HIP_MEMORY_SCOPE_AGENT) < target) __builtin_amdgcn_s_sleep(2);
    __builtin_amdgcn_fence(__ATOMIC_ACQUIRE, "agent");
  }
  __syncthreads();
}
#define PHASE(...) do { if (ph >= pk.ph_lo && ph < pk.ph_hi) { const Params p = ldp(); unsigned char* ws = p.ws; WSPTRS; __VA_ARGS__; } ++ph; \
    if (ph > pk.ph_lo && ph < pk.ph_hi) { gbar((unsigned*)(pk.ws + WS_END), (unsigned)ph * gridDim.x); } } while (0)
#define WSPTRS bf16_t* WM = (bf16_t*)(ws + O_WM); bf16_t* WF = (bf16_t*)(ws + O_RF); \
  float* rinv = (float*)(ws + S_RINV); float* rinvq = (float*)(ws + S_RINVQ); float* rinvkv = (float*)(ws + S_RINVKV); \
  const float* cs = (const float*)(ws + S_COS); const float* sn = (const float*)(ws + S_SIN); \
  bf16_t* mix = (bf16_t*)(ws + O_RA); bf16_t* xb = (bf16_t*)(ws + O_RC); bf16_t* act = (bf16_t*)(ws + O_RD); \
  const int i = layer >> 1; const float* ng = p.norm_g + (size_t)layer * 4 * DM; const float* mu = p.mu + (size_t)i * 6 * DM; \
  bf16_t* cq = (bf16_t*)(ws + O_RA); bf16_t* ckv = cq + (size_t)T * 512; bf16_t* kr = cq + (size_t)T * 1024; \
  bf16_t* qb = (bf16_t*)(ws + O_RD); bf16_t* kb = qb + (size_t)T * 1024; bf16_t* vb = kb + (size_t)T * 1024; \
  bf16_t* Qp = (bf16_t*)(ws + O_RB); bf16_t* kv = (bf16_t*)(ws + O_RH); bf16_t* cat = (bf16_t*)(ws + O_RF); \
  bf16_t* m0 = (bf16_t*)(ws + O_RD); bf16_t* m1 = (bf16_t*)(ws + O_RE); bf16_t* m2 = (bf16_t*)(ws + O_RX); \
  bf16_t* rB = (bf16_t*)(ws + O_RA); bf16_t* kB = (bf16_t*)(ws + O_RB); bf16_t* vB = (bf16_t*)(ws + O_RC); \
  bf16_t* gl = (bf16_t*)(ws + S_GL); bf16_t* wl = (bf16_t*)(ws + S_WL); bf16_t* al = (bf16_t*)(ws + S_AL); \
  bf16_t* eB = (bf16_t*)(ws + O_RD); bf16_t* aB = (bf16_t*)(ws + O_RX); bf16_t* gB = (bf16_t*)(ws + O_RD); bf16_t* yg = (bf16_t*)(ws + O_RH); \
  (void)WM; (void)WF; (void)rinv; (void)rinvq; (void)rinvkv; (void)cs; (void)sn; (void)mix; (void)xb; (void)act; (void)i; (void)ng; (void)mu; (void)cq; (void)ckv; (void)kr; (void)qb; (void)kb; (void)vb; \
  (void)Qp; (void)kv; (void)cat; (void)m0; (void)m1; (void)m2; (void)rB; (void)kB; (void)vB; (void)gl; (void)wl; (void)al; (void)eB; (void)aB; (void)gB; (void)yg
template <int layer> __device__ __forceinline__ void layer_fn(const Params& pk, unsigned char* lds, cg::grid_group& grid, int& ph) {
    if constexpr ((layer & 1) == 0) {
      PHASE(pg8::EpiIn E{cq, ckv, qb, kb, vb, kr, rinv, cs, sn}; run_gemm(lds, xb, WM + WA_IN, 4352, 2048, E));
      PHASE(rownorm_phase(p); dilated_phase(p, (char*)lds));
      PHASE(pg8::EpiUQ E1{Qp, rinvq, cs, sn}; run_gemm(lds, cq, WM + WA_UQ, 1536, 512, E1);
            pg8::EpiB<0> E2{kv, 2048, nullptr, rinvkv}; run_gemm(lds, ckv, WM + WA_UKV, 2048, 512, E2));
      PHASE(mla_phase(p, (char*)lds); combine_phase(p));
      PHASE(pg8::EpiB<0> E{mix, 2048, nullptr, nullptr}; run_gemm(lds, cat, WM + WA_OUT, 2048, 2048, E));
    } else {
      PHASE(mix_phase(p, ng, mu, 1, 4, 5));
      PHASE(pg8::EpiLora E{wl, al, gl}; pg8::Gemm g3{m0, WM + WR_W1, 3 * T, 768, 2048}; pg8::LoraOrder S3{(int)blockIdx.x};
            pg8::gemm_phase<pg8::EpiLora, pg8::LoraOrder, false>((PG8_LAS unsigned char*)lds, g3, S3, E, nullptr); __syncthreads());
      PHASE(mix_phase(p, ng, mu, 0, 2, 3));
      PHASE(pg8::EpiB<0> E1{rB, 2048, nullptr, nullptr}; run_gemm(lds, m0, WM + WR_R, 2048, 2048, E1);
            pg8::EpiB<0> E2{kB, 2048, nullptr, nullptr}; run_gemm(lds, m1, WM + WR_K, 2048, 2048, E2);
            pg8::EpiB<0> E3{vB, 2048, nullptr, nullptr}; run_gemm(lds, m2, WM + WR_V, 2048, 2048, E3));
      PHASE(pg8::EpiB<0> E1{eB, 4096, nullptr, nullptr}; run_gemm(lds, wl, WM + WR_W2, 4096, 256, E1);
            pg8::EpiB<0> E2{aB, 4096, nullptr, nullptr}; run_gemm(lds, al, WM + WR_A2, 4096, 256, E2));
      PHASE(scan_phase(p, i, lds));
      PHASE(pg8::EpiB<0> E{gB, 2048, nullptr, nullptr}; run_gemm(lds, gl, WM + WR_G2, 2048, 256, E));
      PHASE(postscan_phase(p, i));
      PHASE(pg8::EpiB<0> E{mix, 2048, nullptr, nullptr}; run_gemm(lds, yg, WM + WR_O, 2048, 2048, E));
    }
    PHASE(resid_phase(p, mix, ng + DM); convert_ffn_weights(p, layer, (float*)lds));
    PHASE(pg8::EpiSwi E{act, rinv}; run_gemm(lds, xb, WF + WF_GU, 11264, 2048, E));
    PHASE(pg8::EpiB<0> E{mix, 2048, nullptr, nullptr}; run_gemm(lds, act, WF + WF_DN, 2048, 5632, E));
    PHASE(resid_phase(p, mix, ng + 3 * DM); if (layer < 3) convert_mixer_weights(p, layer + 1, (float*)lds));
  }
__global__ void __launch_bounds__(512, 2) mega(Params pk) {
  constexpr int layer = 0;
  extern __shared__ __attribute__((aligned(16))) unsigned char lds[];
  cg::grid_group grid = cg::this_grid();
  int ph = 0;
  grid.sync();
  PHASE(resid_phase(p, nullptr, nullptr); tables_phase(p); convert_mixer_weights(p, 0, (float*)lds));
  layer_fn<0>(pk, lds, grid, ph); layer_fn<1>(pk, lds, grid, ph); layer_fn<2>(pk, lds, grid, ph); layer_fn<3>(pk, lds, grid, ph);
}
#undef PHASE
#undef WSPTRS

extern "C" void kernel_launch(void* const* d_in, const int* in_sizes, int n_in, void* d_out, int out_size, void* d_ws, size_t ws_size, hipStream_t stream) {
  static int grid_blocks = 0;
  if (!grid_blocks) {
    int dev = 0, cus = 0, per_cu = 0;
    (void)hipGetDevice(&dev);
    (void)hipDeviceGetAttribute(&cus, hipDeviceAttributeMultiprocessorCount, dev);
    (void)hipFuncSetAttribute((const void*)mega, hipFuncAttributeMaxDynamicSharedMemorySize, LDS_BYTES);
    (void)hipOccupancyMaxActiveBlocksPerMultiprocessor(&per_cu, mega, 512, LDS_BYTES);
    if (per_cu < 1) { fprintf(stderr, "occupancy query returned %d\n", per_cu); per_cu = 1; }
    grid_blocks = cus;
  }
  if (n_in != 31 || ws_size < WS_END + 256) { fprintf(stderr, "kernel_launch: unexpected n_in %d / ws_size %zu\n", n_in, ws_size); return; }
  Params p{};
  const float** f = (const float**)&p;
  for (int k = 0; k < 31; ++k) f[k] = (const float*)d_in[k];
  p.out = (float*)d_out; p.ws = (unsigned char*)d_ws; p.ph_lo = 0; p.ph_hi = 1000;
#ifdef MULTI_LAUNCH
  for (int ph = 0; ph < NPH_RUN; ++ph) { p.ph_lo = ph; p.ph_hi = ph + 1; hipLaunchKernelGGL(mega, dim3(grid_blocks), dim3(512), LDS_BYTES, stream, p); }
#else
  (void)hipMemsetAsync((unsigned char*)d_ws + WS_END, 0, 256, stream);
  void* args[] = {&p};
  hipError_t e = hipLaunchCooperativeKernel((void*)mega, dim3(grid_blocks), dim3(512), args, LDS_BYTES, stream);
  if (e != hipSuccess) fprintf(stderr, "cooperative launch failed: %s (grid %d)\n", hipGetErrorString(e), grid_blocks);
#endif
}
```

```cpp
#include <hip/hip_runtime.h>
#include <hip/hip_cooperative_groups.h>
#include <cstdio>
#include <cstdint>
namespace cg = cooperative_groups;
__device__ __forceinline__ int tidx() { int t = threadIdx.x; asm volatile("" : "+v"(t)); return t; }
namespace pg8 {
#define PG8_LAS __attribute__((address_space(3)))
typedef unsigned short bf16_t;
typedef short bf16x8 __attribute__((ext_vector_type(8)));
typedef float f32x4 __attribute__((ext_vector_type(4)));
typedef unsigned u32x4 __attribute__((ext_vector_type(4)));
constexpr int BM = 256, BK = 64, HALF = 128, HTB = HALF * BK * 2  , STAGE_BYTES = 8 * HTB, NXCD = 8, WGM = 8;

__host__ __device__ __forceinline__ int lds_byte(int r, int c) { const int st = (r >> 4) * 2 + (c >> 5), rr = r & 15, cc = c & 31, ob = rr * 64 + cc * 2; return st * 1024 + (ob ^ (((ob >> 9) & 1) << 5)); }
__host__ __device__ __forceinline__ void stage_rc(int b, int& R, int& C) { const int st = b / 1024, sb = b % 1024, swz = sb ^ (((sb >> 9) & 1) << 5); R = (st >> 1) * 16 + swz / 64; C = (st & 1) * 32 + (swz % 64) / 2; }
__host__ __device__ __forceinline__ int perm32(int rho) { const int n = rho >> 4, i = rho & 15; return 8 * (i >> 2) + 4 * n + (i & 3); }

struct Unit { int pm, pn; };
struct Gemm { const bf16_t* A; const bf16_t* Bt; int M, N, K; };

struct StaticOrder {
    int nM, nN, nwg, G, c;
    __host__ __device__ void init(int M, int N, int G_, int c_) { nM = M / BM; nN = N / BM; nwg = nM * nN; G = G_; c = c_; }
    __host__ __device__ bool next(int i, Unit& u) const {
        const long L = (long)i * G + c; if (L >= nwg) return false;
        int wgid = (int)L; { const int q = nwg / NXCD, r = nwg % NXCD, xcd = wgid % NXCD, off = wgid / NXCD; wgid = (xcd < r ? xcd * (q + 1) : r * (q + 1) + (xcd - r) * q) + off; }
        const int nig = WGM * nN, gid = wgid / nig, fm = gid * WGM, gsz = (nM - fm) < WGM ? (nM - fm) : WGM;
        u.pm = fm + ((wgid % nig) % gsz); u.pn = (wgid % nig) / gsz; return true;
    }
    __device__ __forceinline__ void a_ready(const Unit&) const {}
    __device__ __forceinline__ void done(const Unit&) const {}
};
__device__ __forceinline__ unsigned cvt_pk_bf16(float lo, float hi) { unsigned r; asm volatile("v_cvt_pk_bf16_f32 %0, %1, %2" : "=v"(r) : "v"(lo), "v"(hi)); return r; }
typedef float f32x2 __attribute__((ext_vector_type(2)));
template <class Epi, class Sched, bool STAMP = false>
__device__ __forceinline__ void gemm_phase(PG8_LAS unsigned char* lds, const Gemm g, const Sched& S, const Epi& E, unsigned long long* stamps) {
    const int tid = tidx(), wid = __builtin_amdgcn_readfirstlane(tid >> 6), lane = tid & 63, wr = wid >> 2, wc = wid & 3, fr = lane & 15, fq = lane >> 4;
    const int K = g.K, nt = K / BK;
    int ts_lo = 0, ts_hi = 0, nts = 0; const unsigned long long rt_entry = STAMP ? (unsigned long long)wall_clock64() : 0ull;
#define PG8_STAMP() do { if (STAMP && wid == 0 && nts < 64) { const unsigned long long _c = (unsigned long long)clock64(); \
        ts_lo = (lane == nts) ? (int)(unsigned)_c : ts_lo; ts_hi = (lane == nts) ? (int)(unsigned)(_c >> 32) : ts_hi; ++nts; } } while (0)
    PG8_STAMP();
    unsigned voffA[2], voffB[2];
#pragma unroll
    for (int i = 0; i < 2; ++i) { int R, C; stage_rc(tid * 16 + i * 8192, R, C); const int Rb = Epi::PERM ? ((R & ~31) + perm32(R & 31)) : R;
        voffA[i] = (unsigned)(R * K + C) * 2u; voffB[i] = (unsigned)(Rb * K + C) * 2u; }
    const size_t kstep = (size_t)(BK * 2);
    const size_t hstep = (size_t)HALF * K * 2;
    const size_t tstep = 2 * hstep;
    const unsigned ldsw = (unsigned)wid * 1024u;
    const int aoff = lds_byte(wr * 64 + fr, fq * 8), boff = lds_byte(wc * 32 + fr, fq * 8);
#define PG8_SA(b, h) (((b) * 2 + (h)) * HTB)
#define PG8_SB(b, h) ((4 + (b) * 2 + (h)) * HTB)
#define PG8_STAGE(bufoff, gbase, voff) do { _Pragma("unroll") for (int _i = 0; _i < 2; ++_i) \
        __builtin_amdgcn_global_load_lds((const unsigned*)((const char*)(gbase) + (voff)[_i]), (PG8_LAS unsigned*)(lds + (bufoff) + ldsw + _i * 8192), 16, 0, 0); } while (0)
#define PG8_LDA(dst, b, h) do { _Pragma("unroll") for (int m = 0; m < 4; ++m) _Pragma("unroll") for (int k = 0; k < 2; ++k) dst[m][k] = *(const PG8_LAS bf16x8*)(lds + PG8_SA(b, h) + aoff + m * 2048 + k * 1024); } while (0)
#define PG8_LDB(dst, b, h) do { _Pragma("unroll") for (int n = 0; n < 2; ++n) _Pragma("unroll") for (int k = 0; k < 2; ++k) dst[n][k] = *(const PG8_LAS bf16x8*)(lds + PG8_SB(b, h) + boff + n * 2048 + k * 1024); } while (0)
#define PG8_MMA(ai, bj, At, Bt) do { __builtin_amdgcn_s_setprio(1); _Pragma("unroll") for (int m = 0; m < 4; ++m) _Pragma("unroll") for (int n = 0; n < 2; ++n) _Pragma("unroll") for (int k = 0; k < 2; ++k) \
        acc[ai][bj][m][n] = __builtin_amdgcn_mfma_f32_16x16x32_bf16(Bt[n][k], At[m][k], acc[ai][bj][m][n], 0, 0, 0); __builtin_amdgcn_s_setprio(0); } while (0)
#define PG8_WAIT_V(n) asm volatile("s_waitcnt vmcnt(" #n ")" ::: "memory")
#define PG8_WAIT_L(n) asm volatile("s_waitcnt lgkmcnt(" #n ")" ::: "memory")
#define PG8_BAR __builtin_amdgcn_s_barrier()
#define PG8_SCHED __builtin_amdgcn_sched_barrier(0)
    Unit cur, nxt; int ui = 0;
    if (!S.next(0, cur)) return;
    f32x4 acc[2][2][4][2];
#pragma unroll
    for (int a = 0; a < 2; ++a)
#pragma unroll
        for (int b = 0; b < 2; ++b)
#pragma unroll
            for (int m = 0; m < 4; ++m)
#pragma unroll
                for (int n = 0; n < 2; ++n) acc[a][b][m][n] = (f32x4){0.f, 0.f, 0.f, 0.f};
    bf16x8 At[4][2], B0[2][2], B1[2][2];
    const char* cA = (const char*)g.A + (size_t)cur.pm * tstep; const char* cB = (const char*)g.Bt + (size_t)cur.pn * tstep;
    S.a_ready(cur);
    PG8_STAGE(PG8_SB(0, 0), cB, voffB); PG8_STAGE(PG8_SA(0, 0), cA, voffA); PG8_STAGE(PG8_SB(0, 1), cB + hstep, voffB); PG8_STAGE(PG8_SA(0, 1), cA + hstep, voffA);
    if (wr == 1) PG8_BAR;
    PG8_WAIT_V(4); PG8_BAR;
    PG8_STAGE(PG8_SB(1, 0), cB + kstep, voffB); PG8_STAGE(PG8_SA(1, 0), cA + kstep, voffA); PG8_STAGE(PG8_SB(1, 1), cB + hstep + kstep, voffB);
    PG8_WAIT_V(6); PG8_BAR;
    PG8_STAMP();
    for (;;) {
        const bool has_next = S.next(ui + 1, nxt);
        const char* nA = has_next ? (const char*)g.A + (size_t)nxt.pm * tstep : cA; const char* nB = has_next ? (const char*)g.Bt + (size_t)nxt.pn * tstep : cB;
        for (int t = 0; t < nt; t += 2) {
            const bool last = (t == nt - 2);
            const char* a1 = cA + (size_t)(t + 1) * kstep;
            const char* a2 = last ? nA : cA + (size_t)(t + 2) * kstep; const char* b2 = last ? nB : cB + (size_t)(t + 2) * kstep;
            const char* a3 = a2 + kstep; const char* b3 = b2 + kstep;
            if (last && has_next) S.a_ready(nxt);
            PG8_LDB(B0, 0, 0); PG8_SCHED; PG8_LDA(At, 0, 0); PG8_STAGE(PG8_SA(1, 1), a1 + hstep, voffA);
            PG8_WAIT_L(8); PG8_BAR; PG8_WAIT_L(0); PG8_MMA(0, 0, At, B0); PG8_BAR; PG8_SCHED;
            PG8_LDB(B1, 0, 1); PG8_STAGE(PG8_SB(0, 0), b2, voffB);
            PG8_BAR; PG8_WAIT_L(0); PG8_MMA(0, 1, At, B1); PG8_BAR;
            PG8_LDA(At, 0, 1); PG8_STAGE(PG8_SA(0, 0), a2, voffA);
            PG8_BAR; PG8_WAIT_L(0); PG8_MMA(1, 0, At, B0); PG8_BAR; PG8_SCHED;
            PG8_STAGE(PG8_SB(0, 1), b2 + hstep, voffB);
            PG8_WAIT_V(6); PG8_BAR; PG8_MMA(1, 1, At, B1); PG8_BAR;
            PG8_LDB(B0, 1, 0); PG8_SCHED; PG8_LDA(At, 1, 0); PG8_STAGE(PG8_SA(0, 1), a2 + hstep, voffA);
            PG8_WAIT_L(8); PG8_BAR; PG8_WAIT_L(0); PG8_MMA(0, 0, At, B0); PG8_BAR; PG8_SCHED;
            PG8_LDB(B1, 1, 1); PG8_STAGE(PG8_SB(1, 0), b3, voffB);
            PG8_BAR; PG8_WAIT_L(0); PG8_MMA(0, 1, At, B1); PG8_BAR;
            PG8_LDA(At, 1, 1); PG8_STAGE(PG8_SA(1, 0), a3, voffA);
            PG8_BAR; PG8_WAIT_L(0); PG8_MMA(1, 0, At, B0); PG8_BAR; PG8_SCHED;
            PG8_STAGE(PG8_SB(1, 1), b3 + hstep, voffB);
            PG8_WAIT_V(6); PG8_BAR; PG8_MMA(1, 1, At, B1); PG8_BAR;
        }
        PG8_STAMP();
        if constexpr (!Epi::AFTER_DRAIN) { E(acc, cur, wr, wc, fr, fq); S.done(cur); }
        PG8_STAMP();
        if (!has_next) break;
#pragma unroll
        for (int a = 0; a < 2; ++a)
#pragma unroll
            for (int b = 0; b < 2; ++b)
#pragma unroll
                for (int m = 0; m < 4; ++m)
#pragma unroll
                    for (int n = 0; n < 2; ++n) acc[a][b][m][n] = (f32x4){0.f, 0.f, 0.f, 0.f};
        cur = nxt; cA = nA; cB = nB; ++ui;
    }
    PG8_WAIT_V(0);
    if (wr == 0) PG8_BAR;
    PG8_BAR;
    if constexpr (Epi::AFTER_DRAIN) { E.fused(acc, cur, wr, wc, fr, fq, lds, wid, lane); S.done(cur); }
    PG8_STAMP();
    if (STAMP && wid == 0) { stamps[lane] = lane < nts ? (((unsigned long long)(unsigned)ts_hi << 32) | (unsigned)ts_lo) : 0ull;
        if (lane == 62) stamps[62] = rt_entry; if (lane == 63) stamps[63] = (unsigned long long)wall_clock64(); }
#undef PG8_STAMP
#undef PG8_SA
#undef PG8_SB
#undef PG8_STAGE
#undef PG8_LDA
#undef PG8_LDB
#undef PG8_MMA
#undef PG8_WAIT_V
#undef PG8_WAIT_L
#undef PG8_BAR
#undef PG8_SCHED
}
}
namespace pg8 {
__device__ __forceinline__ float fsig(float x) { return __builtin_amdgcn_rcpf(1.f + __expf(-x)); }
__device__ __forceinline__ float ftanh(float x) { return 1.f - 2.f * __builtin_amdgcn_rcpf(1.f + __expf(2.f * x)); }
__device__ __forceinline__ int seq_start(int t) { return t < 4096 ? 0 : (t < 8192 ? 4096 : 8192); }

struct EpiF32 {
    static constexpr bool PERM = false, AFTER_DRAIN = false;
    float* C; int ldc;
    __device__ __forceinline__ void operator()(const f32x4 (&acc)[2][2][4][2], const Unit& u, int wr, int wc, int fr, int fq) const {
        const int row0 = u.pm * BM + wr * 64 + fr, col0 = u.pn * BM + wc * 32 + 4 * fq;
#pragma unroll
        for (int ai = 0; ai < 2; ++ai)
#pragma unroll
            for (int m = 0; m < 4; ++m) { float* rowp = C + (size_t)(row0 + ai * HALF + m * 16) * ldc + col0;
#pragma unroll
                for (int bj = 0; bj < 2; ++bj)
#pragma unroll
                    for (int n = 0; n < 2; ++n) *(f32x4*)(rowp + bj * HALF + n * 16) = acc[ai][bj][m][n]; }
    }
};
template <int ACT> struct EpiB {
    static constexpr bool PERM = true, AFTER_DRAIN = false;
    bf16_t* O; int ldc; const float* bias; const float* rs;
    __device__ __forceinline__ f32x4 actf(f32x4 v) const {
#pragma unroll
        for (int j = 0; j < 4; ++j) {
            if (ACT == 1) v[j] = 0.5f + 0.5f * ftanh(0.5f * v[j]);
            if (ACT == 2) v[j] = ftanh(v[j]);
            if (ACT == 3) v[j] = 0.6065306597f * fsig(v[j]); }
        return v; }
    __device__ __forceinline__ void operator()(const f32x4 (&acc)[2][2][4][2], const Unit& u, int wr, int wc, int fr, int fq) const {
        const int row0 = u.pm * BM + wr * 64 + fr; const int col0 = u.pn * BM + wc * 32 + 8 * fq;
#pragma unroll
        for (int bj = 0; bj < 2; ++bj) {
#pragma unroll
            for (int ai = 0; ai < 2; ++ai)
#pragma unroll
                for (int m = 0; m < 4; ++m) { const int row = row0 + ai * HALF + m * 16; const float s = rs ? rs[row] : 1.f;
                    f32x4 v0 = acc[ai][bj][m][0] * s; if (bias) v0 += *(const f32x4*)(bias + col0 + bj * HALF); v0 = actf(v0);
                    u32x4 w; w.x = cvt_pk_bf16(v0[0], v0[1]); w.y = cvt_pk_bf16(v0[2], v0[3]);
                    f32x4 v1 = acc[ai][bj][m][1] * s; if (bias) v1 += *(const f32x4*)(bias + col0 + bj * HALF + 4); v1 = actf(v1);
                    w.z = cvt_pk_bf16(v1[0], v1[1]); w.w = cvt_pk_bf16(v1[2], v1[3]);
                    *(u32x4*)(O + (size_t)row * ldc + col0 + bj * HALF) = w; __builtin_amdgcn_sched_barrier(0); } }
    }
};
struct EpiIn {
    static constexpr bool PERM = true, AFTER_DRAIN = false;
    bf16_t *cq, *ckv, *qb, *kb, *vb, *kr; const float* rs; const float* cs; const float* sn;
    __device__ __forceinline__ void operator()(const f32x4 (&acc)[2][2][4][2], const Unit& u, int wr, int wc, int fr, int fq) const {
        const int row0 = u.pm * BM + wr * 64 + fr; const int pn = u.pn;
        if (pn < 16) {
            bf16_t* base; int ldc, colt;
            if (pn < 2) { base = cq; ldc = 512; colt = pn * 256; } else if (pn < 4) { base = ckv; ldc = 512; colt = (pn - 2) * 256; }
            else if (pn < 8) { base = qb; ldc = 1024; colt = (pn - 4) * 256; } else if (pn < 12) { base = kb; ldc = 1024; colt = (pn - 8) * 256; }
            else { base = vb; ldc = 1024; colt = (pn - 12) * 256; }
            const int col0 = colt + wc * 32 + 8 * fq;
#pragma unroll
            for (int ai = 0; ai < 2; ++ai)
#pragma unroll
                for (int m = 0; m < 4; ++m) { const int row = row0 + ai * HALF + m * 16; const float s = rs[row];
                    bf16_t* rowp = base + (size_t)row * ldc + col0;
#pragma unroll
                    for (int bj = 0; bj < 2; ++bj) { const f32x4 v0 = acc[ai][bj][m][0] * s, v1 = acc[ai][bj][m][1] * s;
                        u32x4 w; w.x = cvt_pk_bf16(v0[0], v0[1]); w.y = cvt_pk_bf16(v0[2], v0[3]); w.z = cvt_pk_bf16(v1[0], v1[1]); w.w = cvt_pk_bf16(v1[2], v1[3]);
                        *(u32x4*)(rowp + bj * HALF) = w; } }
        } else if (wc < 2) {
            const int q = wc * 4 + fq;
#pragma unroll
            for (int ai = 0; ai < 2; ++ai)
#pragma unroll
                for (int m = 0; m < 4; ++m) { const int row = row0 + ai * HALF + m * 16; const float s = rs[row]; const int pos = row - seq_start(row);
                    const f32x4 c = *(const f32x4*)(cs + (size_t)pos * 32 + 4 * q), sv = *(const f32x4*)(sn + (size_t)pos * 32 + 4 * q);
                    const f32x4 x1 = acc[ai][0][m][0] * s, x2 = acc[ai][0][m][1] * s;
                    const f32x4 y1 = x1 * c - x2 * sv, y2 = x2 * c + x1 * sv;
                    u32x4 w; w.x = cvt_pk_bf16(y1[0], y1[1]); w.y = cvt_pk_bf16(y1[2], y1[3]); w.z = cvt_pk_bf16(y2[0], y2[1]); w.w = cvt_pk_bf16(y2[2], y2[3]);
                    *(u32x4*)(kr + (size_t)row * 64 + 8 * q) = w; }
        }
    }
};
struct EpiUQ {
    static constexpr bool PERM = true, AFTER_DRAIN = false;
    bf16_t* O; const float* rs; const float* cs; const float* sn;
    __device__ __forceinline__ void operator()(const f32x4 (&acc)[2][2][4][2], const Unit& u, int wr, int wc, int fr, int fq) const {
        const int row0 = u.pm * BM + wr * 64 + fr; const int col0 = u.pn * BM + wc * 32 + 8 * fq;
        const int q = (wc & 1) * 4 + fq;
#pragma unroll
        for (int ai = 0; ai < 2; ++ai)
#pragma unroll
            for (int m = 0; m < 4; ++m) { const int row = row0 + ai * HALF + m * 16; const float s = rs[row]; const int pos = row - seq_start(row);
                bf16_t* rowp = O + (size_t)row * 1536 + col0;
#pragma unroll
                for (int bj = 0; bj < 2; ++bj) { f32x4 v0 = acc[ai][bj][m][0] * s, v1 = acc[ai][bj][m][1] * s;
                    const int blk = u.pn * 4 + bj * 2 + (wc >> 1);
                    if (blk % 3 == 2) {
                        const f32x4 c = *(const f32x4*)(cs + (size_t)pos * 32 + 4 * q), sv = *(const f32x4*)(sn + (size_t)pos * 32 + 4 * q);
                        const f32x4 y1 = v0 * c - v1 * sv, y2 = v1 * c + v0 * sv; v0 = y1; v1 = y2; }
                    u32x4 w; w.x = cvt_pk_bf16(v0[0], v0[1]); w.y = cvt_pk_bf16(v0[2], v0[3]); w.z = cvt_pk_bf16(v1[0], v1[1]); w.w = cvt_pk_bf16(v1[2], v1[3]);
                    *(u32x4*)(rowp + bj * HALF) = w; } __builtin_amdgcn_sched_barrier(0); }
    }
};
struct EpiSwi {
    static constexpr bool PERM = true, AFTER_DRAIN = false;
    bf16_t* O; const float* rs;
    __device__ __forceinline__ void operator()(const f32x4 (&acc)[2][2][4][2], const Unit& u, int wr, int wc, int fr, int fq) const {
        const int row0 = u.pm * BM + wr * 64 + fr; const int col0 = u.pn * 128 + wc * 16 + 4 * fq;
#pragma unroll
        for (int ai = 0; ai < 2; ++ai)
#pragma unroll
            for (int m = 0; m < 4; ++m) { const int row = row0 + ai * HALF + m * 16; const float s = rs[row];
                bf16_t* rowp = O + (size_t)row * 5632 + col0;
#pragma unroll
                for (int bj = 0; bj < 2; ++bj) { const f32x4 g = acc[ai][bj][m][0] * s, up = acc[ai][bj][m][1] * s; f32x4 o;
#pragma unroll
                    for (int j = 0; j < 4; ++j) o[j] = g[j] * fsig(g[j]) * up[j];
                    uint2 w; w.x = cvt_pk_bf16(o[0], o[1]); w.y = cvt_pk_bf16(o[2], o[3]);
                    *(uint2*)(rowp + bj * 64) = w; } }
    }
};
}

namespace pg8 {
struct LoraOrder {
    int c;
    __device__ bool next(int i, Unit& u) const { if (c >= 144 || i >= 2) return false; const int id = c * 2 + i; u.pm = id; u.pn = id / 96; return true; }
    __device__ __forceinline__ void a_ready(const Unit&) const {}
    __device__ __forceinline__ void done(const Unit&) const {}
};
struct EpiLora {
    static constexpr bool PERM = true, AFTER_DRAIN = false;
    bf16_t *wl, *al, *gl;
    __device__ __forceinline__ void operator()(const f32x4 (&acc)[2][2][4][2], const Unit& u, int wr, int wc, int fr, int fq) const {
        const int pn = u.pn; bf16_t* base = pn == 0 ? wl : (pn == 1 ? al : gl);
        const int row0 = u.pm * BM - pn * 24576 + wr * 64 + fr; const int col0 = wc * 32 + 8 * fq;
        const float sc = pn == 2 ? 0.5f : 1.f, ka = pn == 2 ? 0.5f : 1.f, kb = pn == 2 ? 0.5f : 0.f;
#pragma unroll
        for (int bj = 0; bj < 2; ++bj)
#pragma unroll
            for (int ai = 0; ai < 2; ++ai)
#pragma unroll
                for (int m = 0; m < 4; ++m) { const int row = row0 + ai * HALF + m * 16;
                    f32x4 v0 = acc[ai][bj][m][0], v1 = acc[ai][bj][m][1];
#pragma unroll
                    for (int j = 0; j < 4; ++j) { const float t0 = kb + ka * ftanh(v0[j] * sc), t1 = kb + ka * ftanh(v1[j] * sc); v0[j] = pn == 1 ? v0[j] : t0; v1[j] = pn == 1 ? v1[j] : t1; }
                    u32x4 w; w.x = cvt_pk_bf16(v0[0], v0[1]); w.y = cvt_pk_bf16(v0[2], v0[3]); w.z = cvt_pk_bf16(v1[0], v1[1]); w.w = cvt_pk_bf16(v1[2], v1[3]);
                    *(u32x4*)(base + (size_t)row * 256 + col0 + bj * HALF) = w; __builtin_amdgcn_sched_barrier(0); }
    }
};
}
namespace at {
using pg8::bf16_t; using pg8::bf16x8; using pg8::u32x4;
typedef short s16x4 __attribute__((ext_vector_type(4)));
typedef float f32x16 __attribute__((ext_vector_type(16)));
constexpr int NW = 8, QBLK = 32, KVBLK = 64;
constexpr int SHM_V = KVBLK * 128 * 2, SHM_K = KVBLK * 128 * 2, SHM_R = KVBLK * 64 * 2;
constexpr int OFF_V = 0, OFF_K = 2 * SHM_V, OFF_R = OFF_K + 2 * SHM_K, OFF_WS = OFF_R + 2 * SHM_R, OFF_BIAS = OFF_WS + NW * 64 * 4, OFF_QR = OFF_BIAS + 1024, ATT_LDS = OFF_QR + 256 * 128;
#define KSWZ(row, colB) ((row) * 256 + ((colB) ^ (((row) & 7) << 4)))
#define RSWZ(row, colB) ((row) * 128 + ((colB) ^ (((row) & 7) << 4)))
#define SBAR() __builtin_amdgcn_sched_barrier(0)
__device__ __forceinline__ int crow(int r, int hi) { return (r & 3) + 8 * (r >> 2) + 4 * hi; }
__device__ __forceinline__ unsigned cvtpk(float lo, float hi) { unsigned r; asm volatile("v_cvt_pk_bf16_f32 %0, %1, %2" : "=v"(r) : "v"(lo), "v"(hi)); return r; }
__device__ __forceinline__ bf16x8 ld8(const bf16_t* p) { return *reinterpret_cast<const bf16x8*>(p); }

__device__ __forceinline__ void partialSM(f32x16& p0, f32x16& p1, float& m_reg, float& mn, float& alpha, const float C, const float thr) {
  float pmax = p0[0];
#pragma unroll
  for (int r = 1; r < 16; ++r) pmax = fmaxf(pmax, p0[r]);
#pragma unroll
  for (int r = 0; r < 16; ++r) pmax = fmaxf(pmax, p1[r]);
  { auto rr = __builtin_amdgcn_permlane32_swap(__float_as_uint(pmax), __float_as_uint(pmax), false, false);
    pmax = fmaxf(__uint_as_float(rr[0]), __uint_as_float(rr[1])); }
  if (__builtin_expect(__all(pmax - m_reg <= thr), 1)) { mn = m_reg; alpha = 1.f; }
  else { mn = fmaxf(m_reg, pmax); alpha = __builtin_amdgcn_exp2f((m_reg - mn) * C); m_reg = mn; }
  const float mnC = -mn * C;
#pragma unroll
  for (int r = 0; r < 16; ++r) p0[r] = fmaf(p0[r], C, mnC);
#pragma unroll
  for (int r = 0; r < 16; ++r) p1[r] = fmaf(p1[r], C, mnC);
#pragma unroll
  for (int r = 0; r < 16; ++r) p0[r] = __builtin_amdgcn_exp2f(p0[r]);
}
__device__ __forceinline__ void finishSM(f32x16& p0, f32x16& p1, float alpha, float& l_reg, bf16x8& pa0, bf16x8& pa1, bf16x8& pa2, bf16x8& pa3) {
#pragma unroll
  for (int r = 0; r < 16; ++r) p1[r] = __builtin_amdgcn_exp2f(p1[r]);
  float ps = 0;
#pragma unroll
  for (int r = 0; r < 16; ++r) ps += p0[r];
#pragma unroll
  for (int r = 0; r < 16; ++r) ps += p1[r];
  { auto rr = __builtin_amdgcn_permlane32_swap(__float_as_uint(ps), __float_as_uint(ps), false, false);
    ps = __uint_as_float(rr[0]) + __uint_as_float(rr[1]); }
  l_reg = l_reg * alpha + ps;
#define PK4(P, BASE, OUT) do { unsigned a0 = cvtpk(P[BASE + 0], P[BASE + 1]), a1 = cvtpk(P[BASE + 2], P[BASE + 3]);   \
    unsigned b0 = cvtpk(P[BASE + 4], P[BASE + 5]), b1 = cvtpk(P[BASE + 6], P[BASE + 7]);                              \
    auto r0 = __builtin_amdgcn_permlane32_swap(a0, b0, false, false); auto r1 = __builtin_amdgcn_permlane32_swap(a1, b1, false, false); \
    u32x4 w = {r0[0], r1[0], r0[1], r1[1]}; OUT = *reinterpret_cast<bf16x8*>(&w); } while (0)
  PK4(p0, 0, pa0); PK4(p0, 8, pa1); PK4(p1, 0, pa2); PK4(p1, 8, pa3);
#undef PK4
}
template <int NQD>
__device__ __forceinline__ void qkt(f32x16& p0, f32x16& p1, const char* Ks, const char* Rs, const bf16x8* qr, const char* Qrs, int qrow, int r32, int hi) {
  p0 = f32x16{}; p1 = f32x16{};
#pragma unroll
  for (int d0 = 0; d0 < 8; ++d0) { const int cb = (d0 * 16 + hi * 8) * 2;
    bf16x8 b0 = *reinterpret_cast<const bf16x8*>(Ks + KSWZ(r32, cb));
    bf16x8 b1 = *reinterpret_cast<const bf16x8*>(Ks + KSWZ(32 + r32, cb));
    p0 = __builtin_amdgcn_mfma_f32_32x32x16_bf16(b0, qr[d0], p0, 0, 0, 0);
    p1 = __builtin_amdgcn_mfma_f32_32x32x16_bf16(b1, qr[d0], p1, 0, 0, 0); }
  if constexpr (NQD > 8) {
#pragma unroll
    for (int d0 = 8; d0 < NQD; ++d0) { const int cb = ((d0 - 8) * 16 + hi * 8) * 2;
      bf16x8 b0 = *reinterpret_cast<const bf16x8*>(Rs + RSWZ(r32, cb));
      bf16x8 b1 = *reinterpret_cast<const bf16x8*>(Rs + RSWZ(32 + r32, cb));
      const bf16x8 qv = *reinterpret_cast<const bf16x8*>(Qrs + RSWZ(qrow, cb));
      p0 = __builtin_amdgcn_mfma_f32_32x32x16_bf16(b0, qv, p0, 0, 0, 0);
      p1 = __builtin_amdgcn_mfma_f32_32x32x16_bf16(b1, qv, p1, 0, 0, 0); }
  }
}
__device__ __forceinline__ int v_st(int k, int c) { const int kk = (k & ~0xC) | ((k & 4) << 1) | ((k & 8) >> 1); return ((kk >> 3) * 4 + (c >> 5)) * 512 + ((kk & 7) * 32 + (c & 31)) * 2; }
__device__ __forceinline__ int v_rd_base(int lane) { return ((lane & 3) << 3) | (((lane >> 2) & 3) << 6) | (((lane >> 4) & 1) << 5) | (((lane >> 5) & 1) << 8); }
constexpr int v_rd_off(int d0, int ks, int half) { return d0 * 512 + ks * 4096 + half * 2048; }
template <int OFF> __device__ __forceinline__ s16x4 tr_read(int vb) {
  s16x4 r; asm volatile("ds_read_b64_tr_b16 %0, %1 offset:%2" : "=&v"(r) : "v"(vb), "i"(OFF) : "memory"); return r;
}
template <int D0> __device__ __forceinline__ void pv_one(f32x16& od, int vb, bf16x8 pa0, bf16x8 pa1, bf16x8 pa2, bf16x8 pa3) {
  const s16x4 l0 = tr_read<v_rd_off(D0, 0, 0)>(vb), h0 = tr_read<v_rd_off(D0, 0, 1)>(vb), l1 = tr_read<v_rd_off(D0, 1, 0)>(vb), h1 = tr_read<v_rd_off(D0, 1, 1)>(vb);
  const s16x4 l2 = tr_read<v_rd_off(D0, 2, 0)>(vb), h2 = tr_read<v_rd_off(D0, 2, 1)>(vb), l3 = tr_read<v_rd_off(D0, 3, 0)>(vb), h3 = tr_read<v_rd_off(D0, 3, 1)>(vb);
  asm volatile("s_waitcnt lgkmcnt(0)" ::: "memory"); SBAR();
#define PK(L, H) (bf16x8){L[0], L[1], L[2], L[3], H[0], H[1], H[2], H[3]}
  od = __builtin_amdgcn_mfma_f32_32x32x16_bf16(pa0, PK(l0, h0), od, 0, 0, 0);
  od = __builtin_amdgcn_mfma_f32_32x32x16_bf16(pa1, PK(l1, h1), od, 0, 0, 0);
  od = __builtin_amdgcn_mfma_f32_32x32x16_bf16(pa2, PK(l2, h2), od, 0, 0, 0);
  od = __builtin_amdgcn_mfma_f32_32x32x16_bf16(pa3, PK(l3, h3), od, 0, 0, 0);
#undef PK
}
__device__ __forceinline__ void pv_d0(f32x16* o, int vb, bf16x8 pa0, bf16x8 pa1, bf16x8 pa2, bf16x8 pa3) {
  pv_one<0>(o[0], vb, pa0, pa1, pa2, pa3); pv_one<1>(o[1], vb, pa0, pa1, pa2, pa3); pv_one<2>(o[2], vb, pa0, pa1, pa2, pa3); pv_one<3>(o[3], vb, pa0, pa1, pa2, pa3);
}

struct Args {
  const bf16_t* Q;
  const bf16_t* K;
  const bf16_t* Kr;
  const bf16_t* V;
  bf16_t* O;
  float* lse; long ldlse;
  int nt;
  int kb0, L;
  const float* biasG;
  float C, thr;
};

template <int NQD, bool DIL, long LDQ, long LDK, long LDO>
__device__ __forceinline__ void attn_body(const Args& A, char* lds) {
  const int tid = tidx(), wid = tid >> 6, lane = tid & 63, r32 = lane & 31, hi = lane >> 5;
  char* V_lds = lds + OFF_V; char* K_lds = lds + OFF_K; char* R_lds = lds + OFF_R;
  float* ws = (float*)(lds + OFF_WS) + wid * 64; float* li_l = ws; float* al_l = ws + 32;
  float* biasL = (float*)(lds + OFF_BIAS);
  char* Qr_lds = lds + OFF_QR;
  float m_reg = -1e30f, l_reg = 0; f32x16 o[4] = {}; bf16x8 qr[8];
  const bf16_t* Qw = A.Q + (long)(wid * QBLK + r32) * LDQ + hi * 8;
#pragma unroll
  for (int d0 = 0; d0 < 8; ++d0) qr[d0] = ld8(Qw + d0 * 16);
  if constexpr (NQD > 8) {
#pragma unroll
    for (int d0 = 8; d0 < NQD; ++d0) *(bf16x8*)(Qr_lds + RSWZ(wid * 32 + r32, ((d0 - 8) * 16 + hi * 8) * 2)) = ld8(Qw + d0 * 16);
  }
  if constexpr (DIL) { if (tid < 129) biasL[tid] = A.biasG[tid]; }
  const int sr = tid >> 4, sc = (tid & 15) * 8, vst0 = v_st(sr, sc), vst1 = v_st(32 + sr, sc);
  const int rr_ = tid >> 3, rc_ = (tid & 7) * 8;
  const int vb0 = (int)(uintptr_t)V_lds + v_rd_base(lane);
  bf16x8 vs0, vs1, ks0, ks1, rs0;
  const int Lm1 = A.L - 1;
#define SLOAD(i) do { long ra, rb; if constexpr (DIL) { int a_ = A.kb0 + (i) * 64 + sr, b_ = a_ + 32; a_ = a_ < 0 ? 0 : (a_ > Lm1 ? Lm1 : a_); b_ = b_ < 0 ? 0 : (b_ > Lm1 ? Lm1 : b_); ra = a_; rb = b_; } \
      else { ra = (i) * 64 + sr; rb = ra + 32; } \
    vs0 = ld8(A.V + ra * LDK + sc); vs1 = ld8(A.V + rb * LDK + sc); ks0 = ld8(A.K + ra * LDK + sc); ks1 = ld8(A.K + rb * LDK + sc); \
    if constexpr (NQD > 8) rs0 = ld8(A.Kr + (long)((i) * 64 + rr_) * 64 + rc_); } while (0)
#define SWRITE(b) do { *(bf16x8*)(V_lds + (b) * SHM_V + vst0) = vs0; *(bf16x8*)(V_lds + (b) * SHM_V + vst1) = vs1; const int kc = sc * 2; \
    *(bf16x8*)(K_lds + (b) * SHM_K + KSWZ(sr, kc)) = ks0; *(bf16x8*)(K_lds + (b) * SHM_K + KSWZ(32 + sr, kc)) = ks1; \
    if constexpr (NQD > 8) *(bf16x8*)(R_lds + (b) * SHM_R + RSWZ(rr_, rc_ * 2)) = rs0; } while (0)
#define SWAIT() asm volatile("s_waitcnt vmcnt(0)" ::: "memory")
#define RESC(a) do { if (__any((a) < 1.f)) { if (hi == 0) al_l[r32] = (a); asm volatile("s_waitcnt lgkmcnt(0)" ::: "memory"); \
    _Pragma("unroll") for (int d = 0; d < 4; ++d) _Pragma("unroll") for (int r = 0; r < 16; ++r) o[d][r] *= al_l[crow(r, hi)]; } } while (0)
#define MASK(P0, P1, i) do { if constexpr (DIL) { const int relb = 64 * ((i) - 1) - (wid * 32 + r32); const int kpb = A.kb0 + 64 * (i); \
    _Pragma("unroll") for (int r = 0; r < 16; ++r) { const int key = crow(r, hi); \
      { const int rel = relb + key, kp = kpb + key; const bool ok = rel >= -64 && rel <= 64 && kp >= 0 && kp <= Lm1; const int ix = ok ? rel + 64 : 0; P0[r] = ok ? fmaf(P0[r], A.C, biasL[ix]) : -1e30f; } \
      { const int rel = relb + key + 32, kp = kpb + key + 32; const bool ok = rel >= -64 && rel <= 64 && kp >= 0 && kp <= Lm1; const int ix = ok ? rel + 64 : 0; P1[r] = ok ? fmaf(P1[r], A.C, biasL[ix]) : -1e30f; } } } } while (0)
  const float Csm = DIL ? 1.f : A.C; const float thr = A.thr;
  f32x16 pA0, pA1; float mnA, alA; bf16x8 pa0, pa1, pa2, pa3; const int NT = A.nt;
  {
    SLOAD(0); SWAIT(); SWRITE(0); __syncthreads();
    for (int i = 0; i < NT; ++i) {
      if constexpr (!DIL) { if (i + 1 < NT) SLOAD(i + 1); }
      SBAR();
      bool live = true;
      if constexpr (DIL) { const int k0 = 64 * (i - 1), q0 = wid * 32; live = (k0 - (q0 + 31) <= 64) && (q0 - (k0 + 63) <= 64) && (A.kb0 + 64 * i + 63 >= 0) && (A.kb0 + 64 * i <= Lm1); }
      if (live) {
      qkt<NQD>(pA0, pA1, K_lds + (i & 1) * SHM_K, R_lds + (i & 1) * SHM_R, qr, Qr_lds, wid * 32 + r32, r32, hi); MASK(pA0, pA1, i); partialSM(pA0, pA1, m_reg, mnA, alA, Csm, thr);
      RESC(alA);
      finishSM(pA0, pA1, alA, l_reg, pa0, pa1, pa2, pa3); SBAR();
      pv_d0(o, vb0 + (i & 1) * SHM_V, pa0, pa1, pa2, pa3);
      }
      if (i + 1 < NT) { if constexpr (DIL) SLOAD(i + 1); SWAIT(); SWRITE((i + 1) & 1); }
      __syncthreads();
    }
  }
  if (hi == 0) li_l[r32] = l_reg; asm volatile("s_waitcnt lgkmcnt(0)" ::: "memory");
  if constexpr (DIL) { if (hi == 0) A.lse[(long)(wid * QBLK + r32) * A.ldlse] = m_reg + __log2f(l_reg); }
  float rli[16];
#pragma unroll
  for (int r = 0; r < 16; ++r) rli[r] = __builtin_amdgcn_rcpf(li_l[crow(r, hi)]);
  bf16_t* Ow = A.O + (long)(wid * QBLK) * LDO;
#pragma unroll
  for (int r = 0; r < 16; ++r) { const int orow = crow(r, hi);
#pragma unroll
    for (int d0 = 0; d0 < 4; ++d0) { const float v = o[d0][r] * rli[r]; Ow[(long)orow * LDO + d0 * 32 + r32] = (bf16_t)(cvtpk(v, v) & 0xffffu); } }
  __syncthreads();
#undef SLOAD
#undef SWRITE
#undef SWAIT
#undef RESC
#undef MASK
}
}
using pg8::bf16_t; using pg8::bf16x8; using pg8::f32x4; using pg8::u32x4;
constexpr int T = 24576, DM = 2048, FH = 5632, NTHR = 512;
constexpr size_t MiB = 1048576;
constexpr size_t O_WM = 0, O_SM = 40 * MiB, O_RF = 104 * MiB, O_RA = 200 * MiB, O_RB = 296 * MiB, O_RC = 392 * MiB, O_RD = 488 * MiB, O_RE = 584 * MiB, O_RX = 680 * MiB,
                 O_RG = 776 * MiB, O_RH = 872 * MiB, WS_END = 968 * MiB;
constexpr size_t S_RINV = O_SM, S_RINVQ = S_RINV + 131072, S_RINVKV = S_RINVQ + 131072, S_LSE = S_RINVKV + 131072  , S_COS = S_LSE + 2359296  ,
                 S_SIN = S_COS + 2 * MiB, S_BIAS = S_SIN + 2 * MiB  , S_GL = S_BIAS + 16384  , S_WL = S_GL + 12 * MiB, S_AL = S_WL + 12 * MiB, S_END = S_AL + 12 * MiB;
static_assert(S_END <= O_RF, "small region overflow");
constexpr int LDS_BYTES = 131072;
static_assert(at::ATT_LDS <= LDS_BYTES, "attention LDS");

struct Params {
  const float *xp, *xs, *norm_g, *rel_bias, *w_in, *q_norm, *kv_norm, *w_uq, *w_ukv, *w_out, *mu, *w_r, *w_k, *w_v, *w_o, *w0, *w1, *w2, *a0, *a1, *a2, *g1, *g2, *k_k, *k_a, *r_k, *ln_w, *ln_b,
              *w_gate, *w_up, *w_down;
  float* out; unsigned char* ws; int ph_lo, ph_hi;
};

__device__ __forceinline__ float bf2f(bf16_t b) { return __uint_as_float(((unsigned)b) << 16); }
__device__ __forceinline__ bf16_t f2bf(float f) { unsigned u = __float_as_uint(f); u += 0x7FFFu + ((u >> 16) & 1u); return (bf16_t)(u >> 16); }
__device__ __forceinline__ float wave_sum(float x) {
#pragma unroll
  for (int o = 32; o >= 1; o >>= 1) x += __shfl_xor(x, o);
  return x;
}
template <int CTRL> __device__ __forceinline__ float dpp_f(float x) { return __int_as_float(__builtin_amdgcn_update_dpp(0, __float_as_int(x), CTRL, 0xF, 0xF, false)); }
__device__ __forceinline__ float row16_sum(float x) { x += dpp_f<0x128>(x); x += dpp_f<0x124>(x); x += dpp_f<0x122>(x); x += dpp_f<0x121>(x); return x; }

struct WMap { const float* s0; const float* s1; const float* gain; int ld; int mode; };
__device__ __forceinline__ int rope_dim(int p) { const int q = p >> 3, w = p & 7; return w < 4 ? 4 * q + w : 32 + 4 * q + (w - 4); }
__device__ __forceinline__ float wmap_get(const WMap& m, int k, int n) {
  float g = m.gain ? m.gain[k] : 1.f;
  switch (m.mode) {
    case 0: return m.s0[(size_t)k * m.ld + n] * g;
    case 1: { int col; if (n < 1024) col = n; else if (n < 4096) col = n + 64; else if (n < 4160) col = 1024 + rope_dim(n - 4096); else return 0.f; return m.s0[(size_t)k * 4160 + col] * g; }
    case 2: { const int h = n / 192, c = n - h * 192; const int col = c < 128 ? n : h * 192 + 128 + rope_dim(c - 128); return m.s0[(size_t)k * 1536 + col] * g; }
    case 3: { const int g8 = n >> 3, w = n & 7; return (w < 4 ? m.s0[(size_t)k * FH + g8 * 4 + w] : m.s1[(size_t)k * FH + g8 * 4 + w - 4]) * g; }
    case 4: { if (n < 96) return m.s0[(size_t)k * 96 + n]; if (n < 192) return m.s1[(size_t)k * 96 + n - 96]; return 0.f; }
    default: { const int d = n >> 11, kk = k - d * 96; if (kk < 0 || kk >= 96) return 0.f; return (d ? m.s1 : m.s0)[(size_t)kk * 2048 + (n & 2047)]; }
  }
}
__device__ __forceinline__ void convert_T(const WMap& m, bf16_t* dst, int N, int K, float* tile  ) {
  const int tid = tidx(), ntn = N >> 6, ntk = K >> 6, nt = ntn * ntk;
  for (int t = blockIdx.x; t < nt; t += gridDim.x) {
    const int n0 = (t % ntn) << 6, k0 = (t / ntn) << 6;
    { const int j = tid & 63, i0 = tid >> 6;
#pragma unroll
      for (int kk = 0; kk < 8; ++kk) { const int kl = i0 * 8 + kk; tile[kl * 65 + j] = wmap_get(m, k0 + kl, n0 + j); } }
    __syncthreads();
    { const int nl = tid >> 3, kc = (tid & 7) * 8; float v[8];
#pragma unroll
      for (int e = 0; e < 8; ++e) v[e] = tile[(kc + e) * 65 + nl];
      u32x4 w; w.x = pg8::cvt_pk_bf16(v[0], v[1]); w.y = pg8::cvt_pk_bf16(v[2], v[3]); w.z = pg8::cvt_pk_bf16(v[4], v[5]); w.w = pg8::cvt_pk_bf16(v[6], v[7]);
      *(u32x4*)(dst + (size_t)(n0 + nl) * K + k0 + kc) = w; }
    __syncthreads();
  }
}
__device__ __forceinline__ void convert_attn_weights(const Params& p, int i, int layer, float* tile) {
  bf16_t* W = (bf16_t*)(p.ws + O_WM);
  { WMap m{p.w_in + (size_t)i * 2048 * 4160, nullptr, p.norm_g + (size_t)(layer * 4 + 0) * DM, 4160, 1}; convert_T(m, W, 4352, 2048, tile); }
  { WMap m{p.w_uq + (size_t)i * 512 * 1536, nullptr, p.q_norm + (size_t)i * 512, 1536, 2}; convert_T(m, W + 8912896, 1536, 512, tile); }
  { WMap m{p.w_ukv + (size_t)i * 512 * 2048, nullptr, p.kv_norm + (size_t)i * 512, 2048, 0}; convert_T(m, W + 8912896 + 786432, 2048, 512, tile); }
  { WMap m{p.w_out + (size_t)i * 2048 * 2048, nullptr, nullptr, 2048, 0}; convert_T(m, W + 8912896 + 786432 + 1048576, 2048, 2048, tile); }
}
constexpr size_t WA_IN = 0, WA_UQ = 8912896, WA_UKV = WA_UQ + 786432, WA_OUT = WA_UKV + 1048576;
constexpr size_t WR_R = 0, WR_K = 4194304, WR_V = 2 * 4194304, WR_O = 3 * 4194304, WR_W1 = 4 * 4194304, WR_A1 = WR_W1 + 524288, WR_G1 = WR_A1 + 524288, WR_G2 = WR_G1 + 524288,
                 WR_W2 = WR_G2 + 524288, WR_A2 = WR_W2 + 1048576;
static_assert((WR_A2 + 1048576) * 2 == 40 * MiB, "rwkv weights size");
__device__ __forceinline__ void convert_rwkv_weights(const Params& p, int i, float* tile) {
  bf16_t* W = (bf16_t*)(p.ws + O_WM); const size_t DD = (size_t)DM * DM;
  { WMap m{p.w_r + i * DD, nullptr, nullptr, 2048, 0}; convert_T(m, W + WR_R, 2048, 2048, tile); }
  { WMap m{p.w_k + i * DD, nullptr, nullptr, 2048, 0}; convert_T(m, W + WR_K, 2048, 2048, tile); }
  { WMap m{p.w_v + i * DD, nullptr, nullptr, 2048, 0}; convert_T(m, W + WR_V, 2048, 2048, tile); }
  { WMap m{p.w_o + i * DD, nullptr, nullptr, 2048, 0}; convert_T(m, W + WR_O, 2048, 2048, tile); }
  { WMap m{p.w1 + (size_t)(i * 2) * 2048 * 96, p.w1 + (size_t)(i * 2 + 1) * 2048 * 96, nullptr, 96, 4}; convert_T(m, W + WR_W1, 256, 2048, tile); }
  { WMap m{p.a1 + (size_t)(i * 2) * 2048 * 96, p.a1 + (size_t)(i * 2 + 1) * 2048 * 96, nullptr, 96, 4}; convert_T(m, W + WR_A1, 256, 2048, tile); }
  { WMap m{p.g1 + (size_t)i * 2048 * 256, nullptr, nullptr, 256, 0}; convert_T(m, W + WR_G1, 256, 2048, tile); }
  { WMap m{p.g2 + (size_t)i * 256 * 2048, nullptr, nullptr, 2048, 0}; convert_T(m, W + WR_G2, 2048, 256, tile); }
  { WMap m{p.w2 + (size_t)(i * 2) * 96 * 2048, p.w2 + (size_t)(i * 2 + 1) * 96 * 2048, nullptr, 2048, 5}; convert_T(m, W + WR_W2, 4096, 256, tile); }
  { WMap m{p.a2 + (size_t)(i * 2) * 96 * 2048, p.a2 + (size_t)(i * 2 + 1) * 96 * 2048, nullptr, 2048, 5}; convert_T(m, W + WR_A2, 4096, 256, tile); }
}
constexpr size_t WF_GU = 0, WF_DN = (size_t)11264 * 2048;
__device__ __forceinline__ void convert_ffn_weights(const Params& p, int layer, float* tile) {
  bf16_t* W = (bf16_t*)(p.ws + O_RF); const size_t DF = (size_t)DM * FH;
  { WMap m{p.w_gate + layer * DF, p.w_up + layer * DF, p.norm_g + (size_t)(layer * 4 + 2) * DM, FH, 3}; convert_T(m, W + WF_GU, 11264, 2048, tile); }
  { WMap m{p.w_down + layer * DF, nullptr, nullptr, 2048, 0}; convert_T(m, W + WF_DN, 2048, 5632, tile); }
}
__device__ __forceinline__ void convert_mixer_weights(const Params& p, int layer, float* tile) { if (layer & 1) convert_rwkv_weights(p, layer >> 1, tile); else convert_attn_weights(p, layer >> 1, layer, tile); }

__device__ __forceinline__ void resid_phase(const Params& p, const bf16_t* mix, const float* g) {
  const int lane = tidx() & 63, gw = blockIdx.x * 8 + (tidx() >> 6), nw = gridDim.x * 8;
  bf16_t* xb = (bf16_t*)(p.ws + O_RC); float* rinv = (float*)(p.ws + S_RINV);
  for (int t = gw; t < T; t += nw) {
    float* xr = p.out + (size_t)t * DM; float xv[4][8];
    if (mix) {
      const bf16_t* mr = mix + (size_t)t * DM; float mv[4][8]; float ss = 0;
#pragma unroll
      for (int i = 0; i < 4; ++i) { const bf16x8 m8 = *(const bf16x8*)(mr + i * 512 + lane * 8);
#pragma unroll
        for (int e = 0; e < 8; ++e) { mv[i][e] = bf2f((bf16_t)m8[e]); ss += mv[i][e] * mv[i][e]; } }
      ss = wave_sum(ss); const float sc = rsqrtf(ss * (1.f / DM) + 1e-6f);
#pragma unroll
      for (int i = 0; i < 4; ++i) { const f32x4 g0 = *(const f32x4*)(g + i * 512 + lane * 8), g1 = *(const f32x4*)(g + i * 512 + lane * 8 + 4);
        const f32x4 x0 = *(const f32x4*)(xr + i * 512 + lane * 8), x1 = *(const f32x4*)(xr + i * 512 + lane * 8 + 4);
#pragma unroll
        for (int e = 0; e < 4; ++e) { xv[i][e] = x0[e] + mv[i][e] * sc * g0[e]; xv[i][4 + e] = x1[e] + mv[i][4 + e] * sc * g1[e]; } }
    } else {
      const float* src = t < 8192 ? p.xp + (size_t)t * DM : p.xs + (size_t)(t - 8192) * DM;
#pragma unroll
      for (int i = 0; i < 4; ++i) { const f32x4 x0 = *(const f32x4*)(src + i * 512 + lane * 8), x1 = *(const f32x4*)(src + i * 512 + lane * 8 + 4);
#pragma unroll
        for (int e = 0; e < 4; ++e) { xv[i][e] = x0[e]; xv[i][4 + e] = x1[e]; } }
    }
    float s2 = 0;
#pragma unroll
    for (int i = 0; i < 4; ++i) {
#pragma unroll
      for (int e = 0; e < 8; ++e) s2 += xv[i][e] * xv[i][e];
      *(f32x4*)(xr + i * 512 + lane * 8) = (f32x4){xv[i][0], xv[i][1], xv[i][2], xv[i][3]}; *(f32x4*)(xr + i * 512 + lane * 8 + 4) = (f32x4){xv[i][4], xv[i][5], xv[i][6], xv[i][7]};
      u32x4 w; w.x = pg8::cvt_pk_bf16(xv[i][0], xv[i][1]); w.y = pg8::cvt_pk_bf16(xv[i][2], xv[i][3]); w.z = pg8::cvt_pk_bf16(xv[i][4], xv[i][5]); w.w = pg8::cvt_pk_bf16(xv[i][6], xv[i][7]);
      *(u32x4*)(xb + (size_t)t * DM + i * 512 + lane * 8) = w; }
    s2 = wave_sum(s2); if (lane == 0) rinv[t] = rsqrtf(s2 * (1.f / DM) + 1e-6f);
  }
}
__device__ __forceinline__ void rownorm_phase(const Params& p) {
  const int lane = tidx() & 63, gw = blockIdx.x * 8 + (tidx() >> 6), nw = gridDim.x * 8;
  const bf16_t* cq = (const bf16_t*)(p.ws + O_RA); const bf16_t* ckv = cq + (size_t)T * 512;
  float* rq = (float*)(p.ws + S_RINVQ); float* rkv = (float*)(p.ws + S_RINVKV);
  for (int t = gw; t < 2 * T; t += nw) { const int tt = t >= T ? t - T : t; const bf16_t* src = (t >= T ? ckv : cq) + (size_t)tt * 512 + lane * 8;
    const bf16x8 v = *(const bf16x8*)src; float ss = 0;
#pragma unroll
    for (int e = 0; e < 8; ++e) { const float f = bf2f((bf16_t)v[e]); ss += f * f; }
    ss = wave_sum(ss); if (lane == 0) (t >= T ? rkv : rq)[tt] = rsqrtf(ss * (1.f / 512) + 1e-6f); }
}
__device__ __forceinline__ void mix_phase(const Params& p, const float* g0, const float* mu  , int sel0, int sel1, int sel2) {
  const int lane = tidx() & 63, gw = blockIdx.x * 8 + (tidx() >> 6), nw = gridDim.x * 8;
  const float* rinv = (const float*)(p.ws + S_RINV);
  bf16_t* m0 = (bf16_t*)(p.ws + O_RD); bf16_t* m1 = (bf16_t*)(p.ws + O_RE); bf16_t* m2 = (bf16_t*)(p.ws + O_RX);
  for (int t = gw; t < T; t += nw) {
    const int s0 = pg8::seq_start(t), len = s0 == 8192 ? 16384 : 4096; const bool hasp = t > s0, hasn = t < s0 + len - 1;
    const float rc = rinv[t], rp = hasp ? rinv[t - 1] : 0.f, rn = hasn ? rinv[t + 1] : 0.f;
    const float* xc = p.out + (size_t)t * DM; const float* xpv = hasp ? xc - DM : xc; const float* xnv = hasn ? xc + DM : xc;
#pragma unroll 2
    for (int i = 0; i < 8; ++i) { const int c = i * 256 + lane * 4;
      const f32x4 gv = *(const f32x4*)(g0 + c); const f32x4 h = *(const f32x4*)(xc + c) * rc * gv, hp = *(const f32x4*)(xpv + c) * rp * gv, hn = *(const f32x4*)(xnv + c) * rn * gv;
      const f32x4 xx = (hp + hn) * 0.5f - h;
      const f32x4 a = h + xx * *(const f32x4*)(mu + sel0 * DM + c), b = h + xx * *(const f32x4*)(mu + sel1 * DM + c), d = h + xx * *(const f32x4*)(mu + sel2 * DM + c);
      uint2 w; w.x = pg8::cvt_pk_bf16(a[0], a[1]); w.y = pg8::cvt_pk_bf16(a[2], a[3]); *(uint2*)(m0 + (size_t)t * DM + c) = w;
      w.x = pg8::cvt_pk_bf16(b[0], b[1]); w.y = pg8::cvt_pk_bf16(b[2], b[3]); *(uint2*)(m1 + (size_t)t * DM + c) = w;
      w.x = pg8::cvt_pk_bf16(d[0], d[1]); w.y = pg8::cvt_pk_bf16(d[2], d[3]); *(uint2*)(m2 + (size_t)t * DM + c) = w; }
  }
}
__device__ __forceinline__ float sum8(float x) { x += __shfl_xor(x, 1); x += __shfl_xor(x, 2); x += __shfl_xor(x, 4); return x; }
__device__ __forceinline__ void postscan_phase(const Params& p, int i) {
  const int lane = tidx() & 63, gw = blockIdx.x * 8 + (tidx() >> 6), nw = gridDim.x * 8;
  bf16_t* y0 = (bf16_t*)(p.ws + O_RH); const bf16_t* y1 = (const bf16_t*)(p.ws + O_RF);
  const bf16_t* r = (const bf16_t*)(p.ws + O_RA); const bf16_t* k = (const bf16_t*)(p.ws + O_RB); const bf16_t* v = (const bf16_t*)(p.ws + O_RC); const bf16_t* g = (const bf16_t*)(p.ws + O_RD);
  const float* lnw = p.ln_w + (size_t)i * DM; const float* lnb = p.ln_b + (size_t)i * DM; const float* rk = p.r_k + (size_t)i * DM;
  for (int t = gw; t < T; t += nw) {
#pragma unroll 2
    for (int hg = 0; hg < 4; ++hg) { const int c = hg * 512 + lane * 8; const size_t ix = (size_t)t * DM + c;
      const bf16x8 a0 = *(const bf16x8*)(y0 + ix), a1 = *(const bf16x8*)(y1 + ix), rv = *(const bf16x8*)(r + ix), kv = *(const bf16x8*)(k + ix), vv = *(const bf16x8*)(v + ix), gv = *(const bf16x8*)(g + ix);
      const f32x4 w0 = *(const f32x4*)(lnw + c), w1 = *(const f32x4*)(lnw + c + 4), b0 = *(const f32x4*)(lnb + c), b1 = *(const f32x4*)(lnb + c + 4), q0 = *(const f32x4*)(rk + c), q1 = *(const f32x4*)(rk + c + 4);
      float y[8]; float s = 0.f, bs = 0.f;
#pragma unroll
      for (int e = 0; e < 8; ++e) { y[e] = bf2f((bf16_t)a0[e]) + bf2f((bf16_t)a1[e]); s += y[e]; bs += bf2f((bf16_t)rv[e]) * bf2f((bf16_t)kv[e]) * (e < 4 ? q0[e & 3] : q1[e & 3]); }
      const float mean = sum8(s) * (1.f / 64); const float bonus = sum8(bs);
      float vs = 0.f;
#pragma unroll
      for (int e = 0; e < 8; ++e) { y[e] -= mean; vs += y[e] * y[e]; }
      const float rstd = rsqrtf(sum8(vs) * (1.f / 64) + 64e-5f);
      float o[8];
#pragma unroll
      for (int e = 0; e < 8; ++e) { const float wv = e < 4 ? w0[e & 3] : w1[e & 3], bv = e < 4 ? b0[e & 3] : b1[e & 3];
        o[e] = (y[e] * rstd * wv + bv + bonus * bf2f((bf16_t)vv[e])) * bf2f((bf16_t)gv[e]); }
      u32x4 w; w.x = pg8::cvt_pk_bf16(o[0], o[1]); w.y = pg8::cvt_pk_bf16(o[2], o[3]); w.z = pg8::cvt_pk_bf16(o[4], o[5]); w.w = pg8::cvt_pk_bf16(o[6], o[7]);
      *(u32x4*)(y0 + ix) = w; }
  }
}
__device__ __forceinline__ void combine_phase(const Params& p) {
  const bf16_t* Op = (const bf16_t*)(p.ws + O_RX); const float* lse = (const float*)(p.ws + S_LSE); bf16_t* cat = (bf16_t*)(p.ws + O_RF);
  const size_t n = (size_t)T * 128;
  for (size_t it = (size_t)blockIdx.x * NTHR + tidx(); it < n; it += (size_t)gridDim.x * NTHR) {
    const int t = (int)(it >> 7), c8 = (int)(it & 127) * 8, h = c8 >> 7;
    const float l0 = lse[((size_t)0 * T + t) * 8 + h], l1 = lse[((size_t)1 * T + t) * 8 + h], l2 = lse[((size_t)2 * T + t) * 8 + h];
    const float m = fmaxf(l0, fmaxf(l1, l2)); float w0 = __builtin_amdgcn_exp2f(l0 - m), w1 = __builtin_amdgcn_exp2f(l1 - m), w2 = __builtin_amdgcn_exp2f(l2 - m);
    const float inv = 1.f / (w0 + w1 + w2); w0 *= inv; w1 *= inv; w2 *= inv;
    const bf16x8 a = *(const bf16x8*)(Op + ((size_t)0 * T + t) * 1024 + c8), b = *(const bf16x8*)(Op + ((size_t)1 * T + t) * 1024 + c8), d = *(const bf16x8*)(Op + ((size_t)2 * T + t) * 1024 + c8);
    float o[8];
#pragma unroll
    for (int e = 0; e < 8; ++e) o[e] = w0 * bf2f((bf16_t)a[e]) + w1 * bf2f((bf16_t)b[e]) + w2 * bf2f((bf16_t)d[e]);
    u32x4 w; w.x = pg8::cvt_pk_bf16(o[0], o[1]); w.y = pg8::cvt_pk_bf16(o[2], o[3]); w.z = pg8::cvt_pk_bf16(o[4], o[5]); w.w = pg8::cvt_pk_bf16(o[6], o[7]);
    *(u32x4*)(cat + (size_t)t * DM + 1024 + c8) = w;
  }
}
__device__ __forceinline__ void tables_phase(const Params& p) {
  float* cs = (float*)(p.ws + S_COS); float* sn = (float*)(p.ws + S_SIN); float* bt = (float*)(p.ws + S_BIAS);
  for (int it = blockIdx.x * NTHR + tidx(); it < 16384 * 32; it += gridDim.x * NTHR) { const int pos = it >> 5, i = it & 31;
    const float inv = __builtin_amdgcn_exp2f(-(float)i * (13.287712379549449f / 32.f)); const float ang = (float)pos * inv;
    const double rev = (double)ang * 0.15915494309189535; const float fr = (float)(rev - __builtin_rint(rev));
    cs[it] = __builtin_amdgcn_cosf(fr); sn[it] = __builtin_amdgcn_sinf(fr); }
  for (int it = blockIdx.x * NTHR + tidx(); it < 3 * 8 * 129; it += gridDim.x * NTHR) { const int pat = it / (8 * 129), rem = it - pat * 8 * 129, h = rem / 129, rl = rem - h * 129 - 64;
    const int dil = pat == 0 ? 1 : (pat == 1 ? 4 : 16); const int rel = rl * dil; const int n = rel < 0 ? -rel : rel;
    int bucket = rel > 0 ? 16 : 0;
    if (n < 8) bucket += n; else { int lg = 8 + (int)(__log2f((float)n * 0.125f) * (8.f / 7.f)); bucket += lg < 15 ? lg : 15; }
    bt[it] = p.rel_bias[bucket * 8 + h] * 1.4426950408889634f; }
}
constexpr int SCH = 32;
constexpr int SC_AM = 0, SC_B = 8192, SC_W = 16384, SC_KD = 24576, SC_R = 32768, SC_V = 40960, SC_Y = 45056, SC_BUF = 49152;
static_assert(2 * SC_BUF <= LDS_BYTES, "scan LDS");
__device__ __forceinline__ void scan_phase(const Params& p, int i, unsigned char* lds) {
  const int tid = tidx(), wid = tid >> 6, lane = tid & 63;
  const bf16_t* rB = (const bf16_t*)(p.ws + O_RA); const bf16_t* kB = (const bf16_t*)(p.ws + O_RB); const bf16_t* vB = (const bf16_t*)(p.ws + O_RC);
  const bf16_t* eB = (const bf16_t*)(p.ws + O_RD); const bf16_t* aB = (const bf16_t*)(p.ws + O_RX);
  const float* kkw = p.k_k + (size_t)i * DM; const float* kaw = p.k_a + (size_t)i * DM;
  for (int wk = blockIdx.x; wk < 256; wk += gridDim.x) {
    for (int q = 0; q < 2; ++q) {
      int s0, len, head, dir, rowbase; const bool qm = (q == 0);
      const int xcd = wk & 7, slot = wk >> 3;
      if (qm) { const int u = (slot >> 2) * 8 + xcd; rowbase = (slot & 3) * 16; dir = u & 1; head = u >> 1; s0 = 8192; len = 16384; }
      else { const int u = (slot >> 1) * 8 + xcd; rowbase = (slot & 1) * 32; dir = u & 1; head = (u >> 1) & 31; s0 = (u >> 6) * 4096; len = 4096; }
      bf16_t* yB = (bf16_t*)(p.ws + (dir ? O_RF : O_RH));
      const int nch = len / SCH;
      const int rp = lane >> 4, kq = lane & 15;
      float S0[4] = {0.f, 0.f, 0.f, 0.f}, S1[4] = {0.f, 0.f, 0.f, 0.f};
      const int pw = wid - 4, st = lane >> 3, l8 = lane & 7, c8 = l8 * 8;
      f32x4 kkc[2], kac[2], w0c[2], a0c[2];
      if (wid >= 4) {
#pragma unroll
        for (int e = 0; e < 2; ++e) { const int cc = head * 64 + c8 + e * 4;
          kkc[e] = *(const f32x4*)(kkw + cc); kac[e] = *(const f32x4*)(kaw + cc);
          w0c[e] = *(const f32x4*)(p.w0 + (size_t)(i * 2 + dir) * DM + cc); a0c[e] = *(const f32x4*)(p.a0 + (size_t)(i * 2 + dir) * DM + cc); }
      }
      auto fill = [&](int c, int b) {
        unsigned char* B = lds + b * SC_BUF;
        const int sl = pw * 8 + st; const int s = c * SCH + sl; const int t = dir ? len - 1 - s : s; const size_t tok = (size_t)(s0 + t);
        const bf16x8 kv = *(const bf16x8*)(kB + tok * DM + head * 64 + c8), rv = *(const bf16x8*)(rB + tok * DM + head * 64 + c8);
        const bf16x8 ev = *(const bf16x8*)(eB + tok * 4096 + dir * 2048 + head * 64 + c8), av = *(const bf16x8*)(aB + tok * 4096 + dir * 2048 + head * 64 + c8);
        uint2 vv = make_uint2(0u, 0u); if (!qm || l8 < 4) vv = *(const uint2*)(vB + tok * DM + head * 64 + rowbase + l8 * 4);
        float kf[8], kk[8]; float ss = 0.f;
#pragma unroll
        for (int e = 0; e < 8; ++e) { kf[e] = bf2f((bf16_t)kv[e]); kk[e] = kf[e] * kkc[e >> 2][e & 3]; ss += kk[e] * kk[e]; }
        ss += __shfl_xor(ss, 1); ss += __shfl_xor(ss, 2); ss += __shfl_xor(ss, 4);
        const float inv = rsqrtf(ss + 1e-12f);
        f32x4 oam[2], ob[2], ow[2], okd[2], orr[2];
#pragma unroll
        for (int e = 0; e < 8; ++e) { const int q4 = e >> 2, j = e & 3;
          const float af = pg8::fsig(a0c[q4][j] + bf2f((bf16_t)av[e])); const float ef = 0.6065306597f * pg8::fsig(w0c[q4][j] + bf2f((bf16_t)ev[e]));
          const float kn = kk[e] * inv;
          oam[q4][j] = -kn; ob[q4][j] = kn * af; ow[q4][j] = __expf(-ef); okd[q4][j] = kf[e] * (1.f + (af - 1.f) * kac[q4][j]); orr[q4][j] = bf2f((bf16_t)rv[e]); }
        const int o4 = sl * 16 + l8 * 2;
#pragma unroll
        for (int e = 0; e < 2; ++e) { ((f32x4*)(B + SC_AM))[o4 + e] = oam[e]; ((f32x4*)(B + SC_B))[o4 + e] = ob[e]; ((f32x4*)(B + SC_W))[o4 + e] = ow[e];
          ((f32x4*)(B + SC_KD))[o4 + e] = okd[e]; ((f32x4*)(B + SC_R))[o4 + e] = orr[e]; }
        f32x4 vf; vf[0] = __uint_as_float(vv.x << 16); vf[1] = __uint_as_float(vv.x & 0xffff0000u); vf[2] = __uint_as_float(vv.y << 16); vf[3] = __uint_as_float(vv.y & 0xffff0000u);
        ((f32x4*)(B + SC_V))[sl * 8 + l8] = vf;
      };
      auto flush = [&](int c, int b) {
        const unsigned char* B = lds + b * SC_BUF;
        const int sl = pw * 8 + st; const int s = c * SCH + sl; const int t = dir ? len - 1 - s : s;
        const f32x4 y = ((const f32x4*)(B + SC_Y))[sl * 8 + l8];
        uint2 w; w.x = pg8::cvt_pk_bf16(y[0], y[1]); w.y = pg8::cvt_pk_bf16(y[2], y[3]);
        if (!qm || l8 < 4) *(uint2*)(yB + (size_t)(s0 + t) * DM + head * 64 + rowbase + l8 * 4) = w;
      };
      if (wid >= 4) fill(0, 0);
      __syncthreads();
      for (int c = 0; c < nch; ++c) {
        if (wid < 4) {
          const unsigned char* B = lds + (c & 1) * SC_BUF;
          const f32x4* pAM = (const f32x4*)(B + SC_AM) + kq; const f32x4* pB = (const f32x4*)(B + SC_B) + kq; const f32x4* pW = (const f32x4*)(B + SC_W) + kq;
          const f32x4* pKD = (const f32x4*)(B + SC_KD) + kq; const f32x4* pR = (const f32x4*)(B + SC_R) + kq;
          const float2* pV = (const float2*)(B + SC_V) + wid * 4 + rp; float2* pY = (float2*)(B + SC_Y) + wid * 4 + rp;
          if (!qm) {
          f32x4 am = pAM[0], bb = pB[0], ww = pW[0], kd = pKD[0], rr = pR[0]; float2 vv = pV[0]; float yq0 = 0.f, yq1 = 0.f, yk0 = 0.f, yk1 = 0.f;
#pragma unroll 4
          for (int s = 0; s < SCH; ++s) {
            const int sn = (s + 1 < SCH ? s + 1 : s) * 16;
            const f32x4 am_n = pAM[sn], bb_n = pB[sn], ww_n = pW[sn], kd_n = pKD[sn], rr_n = pR[sn]; const float2 vv_n = pV[sn];
            float sa0 = (S0[0] * am[0] + S0[1] * am[1]) + (S0[2] * am[2] + S0[3] * am[3]);
            float sa1 = (S1[0] * am[0] + S1[1] * am[1]) + (S1[2] * am[2] + S1[3] * am[3]);
            float u0[4], u1[4];
#pragma unroll
            for (int j = 0; j < 4; ++j) { u0[j] = fmaf(S0[j], ww[j], vv.x * kd[j]); u1[j] = fmaf(S1[j], ww[j], vv.y * kd[j]); }
            sa0 += dpp_f<0x128>(sa0); sa1 += dpp_f<0x128>(sa1); yq0 += dpp_f<0x128>(yq0); yq1 += dpp_f<0x128>(yq1);
            sa0 += dpp_f<0x124>(sa0); sa1 += dpp_f<0x124>(sa1); yq0 += dpp_f<0x124>(yq0); yq1 += dpp_f<0x124>(yq1);
            sa0 += dpp_f<0x122>(sa0); sa1 += dpp_f<0x122>(sa1); yq0 += dpp_f<0x122>(yq0); yq1 += dpp_f<0x122>(yq1);
            sa0 += dpp_f<0x121>(sa0); sa1 += dpp_f<0x121>(sa1); yq0 += dpp_f<0x121>(yq0); yq1 += dpp_f<0x121>(yq1);
            { const bool me = kq == ((s - 1) & 15); yk0 = me ? yq0 : yk0; yk1 = me ? yq1 : yk1; }
            if (s == 16) pY[kq * 16] = make_float2(yk0, yk1);
#pragma unroll
            for (int j = 0; j < 4; ++j) { S0[j] = fmaf(sa0, bb[j], u0[j]); S1[j] = fmaf(sa1, bb[j], u1[j]); }
            yq0 = (S0[0] * rr[0] + S0[1] * rr[1]) + (S0[2] * rr[2] + S0[3] * rr[3]);
            yq1 = (S1[0] * rr[0] + S1[1] * rr[1]) + (S1[2] * rr[2] + S1[3] * rr[3]);
            am = am_n; bb = bb_n; ww = ww_n; kd = kd_n; rr = rr_n; vv = vv_n;
          }
          yq0 = row16_sum(yq0); yq1 = row16_sum(yq1);
          if (kq == 15) { yk0 = yq0; yk1 = yq1; }
          pY[(16 + kq) * 16] = make_float2(yk0, yk1);
          } else {
          const float* pV1 = (const float*)(B + SC_V) + wid * 4 + rp; float* pY1 = (float*)(B + SC_Y) + wid * 4 + rp;
          f32x4 am = pAM[0], bb = pB[0], ww = pW[0], kd = pKD[0], rr = pR[0]; float vv = pV1[0]; float yq = 0.f, yk = 0.f;
#pragma unroll 4
          for (int s = 0; s < SCH; ++s) {
            const int sn = (s + 1 < SCH ? s + 1 : s);
            const f32x4 am_n = pAM[sn * 16], bb_n = pB[sn * 16], ww_n = pW[sn * 16], kd_n = pKD[sn * 16], rr_n = pR[sn * 16]; const float vv_n = pV1[sn * 32];
            float sa0 = (S0[0] * am[0] + S0[1] * am[1]) + (S0[2] * am[2] + S0[3] * am[3]);
            float u0[4];
#pragma unroll
            for (int j = 0; j < 4; ++j) u0[j] = fmaf(S0[j], ww[j], vv * kd[j]);
            sa0 += dpp_f<0x128>(sa0); yq += dpp_f<0x128>(yq);
            sa0 += dpp_f<0x124>(sa0); yq += dpp_f<0x124>(yq);
            sa0 += dpp_f<0x122>(sa0); yq += dpp_f<0x122>(yq);
            sa0 += dpp_f<0x121>(sa0); yq += dpp_f<0x121>(yq);
            yk = (kq == ((s - 1) & 15)) ? yq : yk;
            if (s == 16) pY1[kq * 32] = yk;
#pragma unroll
            for (int j = 0; j < 4; ++j) S0[j] = fmaf(sa0, bb[j], u0[j]);
            yq = (S0[0] * rr[0] + S0[1] * rr[1]) + (S0[2] * rr[2] + S0[3] * rr[3]);
            am = am_n; bb = bb_n; ww = ww_n; kd = kd_n; rr = rr_n; vv = vv_n;
          }
          yq = row16_sum(yq);
          if (kq == 15) yk = yq;
          pY1[(16 + kq) * 32] = yk;
          }
        } else {
          if (c + 1 < nch) fill(c + 1, (c + 1) & 1);
          if (c >= 1) flush(c - 1, (c - 1) & 1);
        }
        __syncthreads();
      }
      if (wid >= 4) flush(nch - 1, (nch - 1) & 1);
      __syncthreads();
    }
  }
}

__device__ __forceinline__ void dilated_phase(const Params& p, char* lds) {
  const bf16_t* qb = (const bf16_t*)(p.ws + O_RD); const bf16_t* kb = qb + (size_t)T * 1024; const bf16_t* vb = kb + (size_t)T * 1024;
  bf16_t* Op = (bf16_t*)(p.ws + O_RX); float* lse = (float*)(p.ws + S_LSE); const float* bt = (const float*)(p.ws + S_BIAS);
  for (int it = blockIdx.x; it < 3 * 8 * 96; it += gridDim.x) {
    const int pat = it / 768, rem = it - pat * 768, h = rem / 96, blk = rem - h * 96;
    const int dil = pat == 0 ? 1 : (pat == 1 ? 4 : 16);
    int s0, len, b = blk;
    if (b < 16) { s0 = 0; len = 4096; } else if (b < 32) { s0 = 4096; len = 4096; b -= 16; } else { s0 = 8192; len = 16384; b -= 32; }
    const int L = len / dil, nbl = L / 256; const int res = b / nbl, j0 = (b - res * nbl) * 256;
    const size_t tok0 = (size_t)(s0 + res);
    at::Args A;
    A.Q = qb + (tok0 + (size_t)j0 * dil) * 1024 + h * 128;
    A.K = kb + tok0 * 1024 + h * 128; A.Kr = nullptr;
    A.V = vb + tok0 * 1024 + h * 128;
    A.O = Op + ((size_t)pat * T + tok0 + (size_t)j0 * dil) * 1024 + h * 128;
    A.lse = lse + ((size_t)pat * T + tok0 + (size_t)j0 * dil) * 8 + h; A.ldlse = (long)dil * 8;
    A.nt = 6; A.kb0 = j0 - 64; A.L = L; A.biasG = bt + (pat * 8 + h) * 129;
    A.C = 0.08838834764831845f * 1.4426950408889634f; A.thr = 11.5f;
    if (pat == 0) at::attn_body<8, true, 1024, 1024, 1024>(A, lds);
    else if (pat == 1) at::attn_body<8, true, 4096, 4096, 4096>(A, lds);
    else at::attn_body<8, true, 16384, 16384, 16384>(A, lds);
  }
}
__device__ __forceinline__ void mla_phase(const Params& p, char* lds) {
  const bf16_t* Qp = (const bf16_t*)(p.ws + O_RB); const bf16_t* kv = (const bf16_t*)(p.ws + O_RH); const bf16_t* kr = (const bf16_t*)(p.ws + O_RA) + (size_t)T * 1024;
  bf16_t* cat = (bf16_t*)(p.ws + O_RF);
  for (int it = blockIdx.x; it < 512 + 256; it += gridDim.x) {
    int s0, len, h, qb_;
    { const int rnd = it >> 8, v = it & 255, slot = v >> 3; h = v & 7;
      if (rnd < 2) { s0 = 8192; len = 16384; qb_ = rnd * 32 + slot; }
      else { s0 = (slot >> 4) * 4096; len = 4096; qb_ = slot & 15; } }
    at::Args A;
    A.Q = Qp + (size_t)(s0 + qb_ * 256) * 1536 + h * 192;
    A.K = kv + (size_t)s0 * 2048 + h * 256; A.Kr = kr + (size_t)s0 * 64;
    A.V = A.K + 128;
    A.O = cat + (size_t)(s0 + qb_ * 256) * 2048 + h * 128;
    A.lse = nullptr; A.ldlse = 0; A.nt = len / 64; A.kb0 = 0; A.L = len; A.biasG = nullptr;
    A.C = 0.07216878364870322f * 1.4426950408889634f; A.thr = 8.f / 0.07216878364870322f;
    at::attn_body<12, false, 1536, 2048, 2048>(A, lds);
  }
}

template <class Epi>
__device__ __forceinline__ void gemm_simple(unsigned char* lds, const pg8::Gemm g, const pg8::StaticOrder& S, const Epi& E) {
  using namespace pg8;
  const int tid = tidx(), wid = tid >> 6, lane = tid & 63, wr = wid >> 2, wc = wid & 3, fr = lane & 15, fq = lane >> 4;
  const int K = g.K, nt = K / BK;
  unsigned offA[2], offB[2];
#pragma unroll
  for (int i = 0; i < 2; ++i) { int R, C; stage_rc(tid * 16 + i * 8192, R, C); const int Rb = Epi::PERM ? ((R & ~31) + perm32(R & 31)) : R;
    offA[i] = (unsigned)(R * K + C); offB[i] = (unsigned)(Rb * K + C); }
  const int aoff = lds_byte(wr * 64 + fr, fq * 8), boff = lds_byte(wc * 32 + fr, fq * 8);
  unsigned char* myst = lds + tid * 16;
  Unit u;
  for (int ui = 0; S.next(ui, u); ++ui) {
    f32x4 acc[2][2][4][2];
#pragma unroll
    for (int a = 0; a < 2; ++a)
#pragma unroll
      for (int b = 0; b < 2; ++b)
#pragma unroll
        for (int m = 0; m < 4; ++m)
#pragma unroll
          for (int n = 0; n < 2; ++n) acc[a][b][m][n] = (f32x4){0.f, 0.f, 0.f, 0.f};
    const bf16_t* Ab = g.A + (size_t)u.pm * 256 * K; const bf16_t* Bb = g.Bt + (size_t)u.pn * 256 * K;
    const size_t hK = (size_t)128 * K;
    bf16x8 sg[2][2];
#define GLOADX(P, off, kt) do { _Pragma("unroll") for (int h = 0; h < 2; ++h) _Pragma("unroll") for (int i = 0; i < 2; ++i) \
      sg[h][i] = *(const bf16x8*)((P) + h * hK + (off)[i] + (size_t)(kt) * BK); } while (0)
#define SWRITEX(base, b) do { _Pragma("unroll") for (int h = 0; h < 2; ++h) _Pragma("unroll") for (int i = 0; i < 2; ++i) \
      *(bf16x8*)(myst + ((base) + (b) * 2 + h) * HTB + i * 8192) = sg[h][i]; } while (0)
    GLOADX(Ab, offA, 0); SWRITEX(0, 0); GLOADX(Bb, offB, 0); SWRITEX(4, 0); __syncthreads();
    for (int kt = 0; kt < nt; ++kt) {
      const int b = kt & 1; const bool more = kt + 1 < nt;
#pragma unroll
      for (int k = 0; k < 2; ++k) {
        if (more) { if (k == 0) GLOADX(Ab, offA, kt + 1); else GLOADX(Bb, offB, kt + 1); }
        __builtin_amdgcn_sched_barrier(0);
        bf16x8 B0[2], B1[2];
#pragma unroll
        for (int n = 0; n < 2; ++n) { B0[n] = *(const bf16x8*)(lds + (4 + b * 2 + 0) * HTB + boff + n * 2048 + k * 1024); B1[n] = *(const bf16x8*)(lds + (4 + b * 2 + 1) * HTB + boff + n * 2048 + k * 1024); }
#pragma unroll
        for (int ai = 0; ai < 2; ++ai) {
#pragma unroll
          for (int m = 0; m < 4; ++m) {
            const bf16x8 At = *(const bf16x8*)(lds + (b * 2 + ai) * HTB + aoff + m * 2048 + k * 1024);
#pragma unroll
            for (int n = 0; n < 2; ++n) {
              acc[ai][0][m][n] = __builtin_amdgcn_mfma_f32_16x16x32_bf16(B0[n], At, acc[ai][0][m][n], 0, 0, 0);
              acc[ai][1][m][n] = __builtin_amdgcn_mfma_f32_16x16x32_bf16(B1[n], At, acc[ai][1][m][n], 0, 0, 0); }
          }
          __builtin_amdgcn_sched_barrier(0);
        }
        if (more) { if (k == 0) SWRITEX(0, b ^ 1); else SWRITEX(4, b ^ 1); }
      }
      __syncthreads();
    }
#undef GLOADX
#undef SWRITEX
    E(acc, u, wr, wc, fr, fq);
  }
}
template <class Epi> __device__ __forceinline__ void run_gemm(unsigned char* lds, const bf16_t* A, const bf16_t* Bt, int N, int K, const Epi& E) {
  pg8::Gemm g{A, Bt, T, N, K}; pg8::StaticOrder S;
  S.init(T, N, (int)gridDim.x, (int)blockIdx.x);
  pg8::gemm_phase<Epi, pg8::StaticOrder, false>((PG8_LAS unsigned char*)lds, g, S, E, nullptr);
  __syncthreads();
}
template <class Epi> __device__ __forceinline__ void run_gemm_small(unsigned char* lds, const bf16_t* A, const bf16_t* Bt, int N, int K, const Epi& E) {
  pg8::Gemm g{A, Bt, T, N, K}; pg8::StaticOrder S;
  S.init(T, N, (int)gridDim.x, (int)blockIdx.x);
  gemm_simple<Epi>(lds, g, S, E);
  __syncthreads();
}

__device__ __forceinline__ Params ldp() { auto k = __builtin_amdgcn_kernarg_segment_ptr(); asm volatile("" : "+s"(k)); Params q; __builtin_memcpy(&q, k, sizeof(Params)); return q; }
__device__ __forceinline__ void gbar(unsigned* ctr, unsigned target) {
  __syncthreads();
  if (threadIdx.x == 0) {
    __builtin_amdgcn_fence(__ATOMIC_RELEASE, "agent");
    __hip_atomic_fetch_add(ctr, 1u, __ATOMIC_RELAXED, __HIP_MEMORY_SCOPE_AGENT);
    while (__hip_atomic_load(ctr, __ATOMIC_RELAXED, __HIP_MEMORY_SCOPE_AGENT) < target) __builtin_amdgcn_s_sleep(2);
    __builtin_amdgcn_fence(__ATOMIC_ACQUIRE, "agent");
  }
  __syncthreads();
}
#define PHASE(...) do { if (ph >= pk.ph_lo && ph < pk.ph_hi) { const Params p = ldp(); unsigned char* ws = p.ws; WSPTRS; __VA_ARGS__; } ++ph; \
    if (ph > pk.ph_lo && ph < pk.ph_hi) { gbar((unsigned*)(pk.ws + WS_END), (unsigned)ph * gridDim.x); } } while (0)
#define WSPTRS bf16_t* WM = (bf16_t*)(ws + O_WM); bf16_t* WF = (bf16_t*)(ws + O_RF); \
  float* rinv = (float*)(ws + S_RINV); float* rinvq = (float*)(ws + S_RINVQ); float* rinvkv = (float*)(ws + S_RINVKV); \
  const float* cs = (const float*)(ws + S_COS); const float* sn = (const float*)(ws + S_SIN); \
  bf16_t* mix = (bf16_t*)(ws + O_RA); bf16_t* xb = (bf16_t*)(ws + O_RC); bf16_t* act = (bf16_t*)(ws + O_RD); \
  const int i = layer >> 1; const float* ng = p.norm_g + (size_t)layer * 4 * DM; const float* mu = p.mu + (size_t)i * 6 * DM; \
  bf16_t* cq = (bf16_t*)(ws + O_RA); bf16_t* ckv = cq + (size_t)T * 512; bf16_t* kr = cq + (size_t)T * 1024; \
  bf16_t* qb = (bf16_t*)(ws + O_RD); bf16_t* kb = qb + (size_t)T * 1024; bf16_t* vb = kb + (size_t)T * 1024; \
  bf16_t* Qp = (bf16_t*)(ws + O_RB); bf16_t* kv = (bf16_t*)(ws + O_RH); bf16_t* cat = (bf16_t*)(ws + O_RF); \
  bf16_t* m0 = (bf16_t*)(ws + O_RD); bf16_t* m1 = (bf16_t*)(ws + O_RE); bf16_t* m2 = (bf16_t*)(ws + O_RX); \
  bf16_t* rB = (bf16_t*)(ws + O_RA); bf16_t* kB = (bf16_t*)(ws + O_RB); bf16_t* vB = (bf16_t*)(ws + O_RC); \
  bf16_t* gl = (bf16_t*)(ws + S_GL); bf16_t* wl = (bf16_t*)(ws + S_WL); bf16_t* al = (bf16_t*)(ws + S_AL); \
  bf16_t* eB = (bf16_t*)(ws + O_RD); bf16_t* aB = (bf16_t*)(ws + O_RX); bf16_t* gB = (bf16_t*)(ws + O_RD); bf16_t* yg = (bf16_t*)(ws + O_RH); \
  (void)WM; (void)WF; (void)rinv; (void)rinvq; (void)rinvkv; (void)cs; (void)sn; (void)mix; (void)xb; (void)act; (void)i; (void)ng; (void)mu; (void)cq; (void)ckv; (void)kr; (void)qb; (void)kb; (void)vb; \
  (void)Qp; (void)kv; (void)cat; (void)m0; (void)m1; (void)m2; (void)rB; (void)kB; (void)vB; (void)gl; (void)wl; (void)al; (void)eB; (void)aB; (void)gB; (void)yg
template <int layer> __device__ __forceinline__ void layer_fn(const Params& pk, unsigned char* lds, cg::grid_group& grid, int& ph) {
    if constexpr ((layer & 1) == 0) {
      PHASE(pg8::EpiIn E{cq, ckv, qb, kb, vb, kr, rinv, cs, sn}; run_gemm(lds, xb, WM + WA_IN, 4352, 2048, E));
      PHASE(rownorm_phase(p); dilated_phase(p, (char*)lds));
      PHASE(pg8::EpiUQ E1{Qp, rinvq, cs, sn}; run_gemm(lds, cq, WM + WA_UQ, 1536, 512, E1);
            pg8::EpiB<0> E2{kv, 2048, nullptr, rinvkv}; run_gemm(lds, ckv, WM + WA_UKV, 2048, 512, E2));
      PHASE(mla_phase(p, (char*)lds); combine_phase(p));
      PHASE(pg8::EpiB<0> E{mix, 2048, nullptr, nullptr}; run_gemm(lds, cat, WM + WA_OUT, 2048, 2048, E));
    } else {
      PHASE(mix_phase(p, ng, mu, 1, 4, 5));
      PHASE(pg8::EpiLora E{wl, al, gl}; pg8::Gemm g3{m0, WM + WR_W1, 3 * T, 768, 2048}; pg8::LoraOrder S3{(int)blockIdx.x};
            pg8::gemm_phase<pg8::EpiLora, pg8::LoraOrder, false>((PG8_LAS unsigned char*)lds, g3, S3, E, nullptr); __syncthreads());
      PHASE(mix_phase(p, ng, mu, 0, 2, 3));
      PHASE(pg8::EpiB<0> E1{rB, 2048, nullptr, nullptr}; run_gemm(lds, m0, WM + WR_R, 2048, 2048, E1);
            pg8::EpiB<0> E2{kB, 2048, nullptr, nullptr}; run_gemm(lds, m1, WM + WR_K, 2048, 2048, E2);
            pg8::EpiB<0> E3{vB, 2048, nullptr, nullptr}; run_gemm(lds, m2, WM + WR_V, 2048, 2048, E3));
      PHASE(pg8::EpiB<0> E1{eB, 4096, nullptr, nullptr}; run_gemm(lds, wl, WM + WR_W2, 4096, 256, E1);
            pg8::EpiB<0> E2{aB, 4096, nullptr, nullptr}; run_gemm(lds, al, WM + WR_A2, 4096, 256, E2));
      PHASE(scan_phase(p, i, lds));
      PHASE(pg8::EpiB<0> E{gB, 2048, nullptr, nullptr}; run_gemm(lds, gl, WM + WR_G2, 2048, 256, E));
      PHASE(postscan_phase(p, i));
      PHASE(pg8::EpiB<0> E{mix, 2048, nullptr, nullptr}; run_gemm(lds, yg, WM + WR_O, 2048, 2048, E));
    }
    PHASE(resid_phase(p, mix, ng + DM); convert_ffn_weights(p, layer, (float*)lds));
    PHASE(pg8::EpiSwi E{act, rinv}; run_gemm(lds, xb, WF + WF_GU, 11264, 2048, E));
    PHASE(pg8::EpiB<0> E{mix, 2048, nullptr, nullptr}; run_gemm(lds, act, WF + WF_DN, 2048, 5632, E));
    PHASE(resid_phase(p, mix, ng + 3 * DM); if (layer < 3) convert_mixer_weights(p, layer + 1, (float*)lds));
  }
__global__ void __launch_bounds__(512, 2) mega(Params pk) {
  constexpr int layer = 0;
  extern __shared__ __attribute__((aligned(16))) unsigned char lds[];
  cg::grid_group grid = cg::this_grid();
  int ph = 0;
  grid.sync();
  PHASE(resid_phase(p, nullptr, nullptr); tables_phase(p); convert_mixer_weights(p, 0, (float*)lds));
  layer_fn<0>(pk, lds, grid, ph); layer_fn<1>(pk, lds, grid, ph); layer_fn<2>(pk, lds, grid, ph); layer_fn<3>(pk, lds, grid, ph);
}
#undef PHASE
#undef WSPTRS

extern "C" void kernel_launch(void* const* d_in, const int* in_sizes, int n_in, void* d_out, int out_size, void* d_ws, size_t ws_size, hipStream_t stream) {
  static int grid_blocks = 0;
  if (!grid_blocks) {
    int dev = 0, cus = 0, per_cu = 0;
    (void)hipGetDevice(&dev);
    (void)hipDeviceGetAttribute(&cus, hipDeviceAttributeMultiprocessorCount, dev);
    (void)hipFuncSetAttribute((const void*)mega, hipFuncAttributeMaxDynamicSharedMemorySize, LDS_BYTES);
    (void)hipOccupancyMaxActiveBlocksPerMultiprocessor(&per_cu, mega, 512, LDS_BYTES);
    if (per_cu < 1) { fprintf(stderr, "occupancy query returned %d\n", per_cu); per_cu = 1; }
    grid_blocks = cus;
  }
  if (n_in != 31 || ws_size < WS_END + 256) { fprintf(stderr, "kernel_launch: unexpected n_in %d / ws_size %zu\n", n_in, ws_size); return; }
  Params p{};
  const float** f = (const float**)&p;
  for (int k = 0; k < 31; ++k) f[k] = (const float*)d_in[k];
  p.out = (float*)d_out; p.ws = (unsigned char*)d_ws; p.ph_lo = 0; p.ph_hi = 1000;
#ifdef MULTI_LAUNCH
  for (int ph = 0; ph < NPH_RUN; ++ph) { p.ph_lo = ph; p.ph_hi = ph + 1; hipLaunchKernelGGL(mega, dim3(grid_blocks), dim3(512), LDS_BYTES, stream, p); }
#else
  (void)hipMemsetAsync((unsigned char*)d_ws + WS_END, 0, 256, stream);
  void* args[] = {&p};
  hipError_t e = hipLaunchCooperativeKernel((void*)mega, dim3(grid_blocks), dim3(512), args, LDS_BYTES, stream);
  if (e != hipSuccess) fprintf(stderr, "cooperative launch failed: %s (grid %d)\n", hipGetErrorString(e), grid_blocks);
#endif
}
```
